# Optimizing an MI355X kernel written in HIP

```python
import math
import jax, jax.numpy as jnp
from jax import lax
import numpy as np

D_MODEL = 4096
BATCH = 2
SEQ = 8192
DEPTH = 2

HEAD_DIM = 128
N_TOTAL_HEADS = D_MODEL // HEAD_DIM
GRID_W = 64
N_MEM = 256
A_Q_HEADS = 3 * N_TOTAL_HEADS // 8
A_KV_HEADS = A_Q_HEADS // 3
A_WINDOW = 128
A_BLOCK = 128
B_HEADS = N_TOTAL_HEADS // 4
B_WIN_ROWS = 8
B_WIN_COLS = 16
B_QCOLS = 16
B_KCOLS = 32
C_HEADS = N_TOTAL_HEADS - A_Q_HEADS - B_HEADS
C_Q_RANK = 1024
C_KV_RANK = 512
C_NOPE = 128
C_ROPE = 64
C_V = HEAD_DIM
C_BLOCK = 128
ROPE_BASE = 10000.0
X_HEADS = 4
X_DIM = X_HEADS * HEAD_DIM
D_FF = -(-8 * D_MODEL // 768) * 256

IN_WIDTHS = (A_Q_HEADS * HEAD_DIM, A_KV_HEADS * HEAD_DIM, A_KV_HEADS * HEAD_DIM,
             B_HEADS * HEAD_DIM, B_HEADS * HEAD_DIM, B_HEADS * HEAD_DIM,
             C_Q_RANK, C_KV_RANK, C_ROPE)
D_IN = sum(IN_WIDTHS)
MIX_W = (A_Q_HEADS + B_HEADS + C_HEADS) * HEAD_DIM
NORM_EPS = 1e-6
NEG_INF = -1e30

kernel_name = 'hybrid_parallel_heads_encoder'


def rms_norm(x, g):
    xf = x.astype(jnp.float32)
    y = xf * lax.rsqrt(jnp.mean(xf * xf, axis=-1, keepdims=True) + NORM_EPS)
    return (y * g.astype(jnp.float32)).astype(x.dtype)


def alibi_slopes(n):
    return 2.0 ** (-8.0 * jnp.arange(1, n + 1, dtype=jnp.float32) / n)


def rope_tables(s):
    inv = 1.0 / (ROPE_BASE ** (jnp.arange(0, C_ROPE, 2, dtype=jnp.float32) / C_ROPE))
    ang = jnp.arange(s, dtype=jnp.float32)[:, None] * inv[None, :]
    return jnp.cos(ang), jnp.sin(ang)


def apply_rope(x, cos, sin):
    x1, x2 = jnp.split(x.astype(jnp.float32), 2, axis=-1)
    c = cos[None, :, None, :]
    sn = sin[None, :, None, :]
    return jnp.concatenate([x1 * c - x2 * sn, x1 * sn + x2 * c], axis=-1).astype(x.dtype)


def windowed_gqa_alibi(q, k, v, sink):
    b, s, hq, d = q.shape
    hkv = k.shape[2]
    rep = hq // hkv
    nb = s // A_BLOCK
    qb = q.reshape(b, nb, A_BLOCK, hkv, rep, d)

    def band(t):
        tp = jnp.pad(t, ((0, 0), (A_BLOCK, A_BLOCK), (0, 0), (0, 0))).reshape(b, nb + 2, A_BLOCK, hkv, d)
        return jnp.concatenate([tp[:, :-2], tp[:, 1:-1], tp[:, 2:]], axis=2)

    kb, vb = band(k), band(v)
    scores = jnp.einsum('bnqgrd,bnkgd->bngrqk', qb, kb).astype(jnp.float32) * (1.0 / math.sqrt(d))
    qi = jnp.arange(A_BLOCK)[:, None]
    kj = jnp.arange(3 * A_BLOCK)[None, :]
    rel = kj - A_BLOCK - qi
    kpos = jnp.arange(nb)[:, None, None] * A_BLOCK - A_BLOCK + kj[None]
    valid = (jnp.abs(rel) <= A_WINDOW)[None] & (kpos >= 0) & (kpos < s)
    slopes = alibi_slopes(hq).reshape(hkv, rep)
    scores = scores - slopes[None, None, :, :, None, None] * jnp.abs(rel).astype(jnp.float32)
    scores = jnp.where(valid[None, :, None, None], scores, NEG_INF)
    sink_l = sink.astype(jnp.float32).reshape(hkv, rep)[None, None, :, :, None, None]
    m = jnp.maximum(jnp.max(scores, axis=-1, keepdims=True), sink_l)
    p = jnp.exp(scores - m)
    denom = jnp.sum(p, axis=-1, keepdims=True) + jnp.exp(sink_l - m)
    out = jnp.einsum('bngrqk,bnkgd->bnqgrd', (p / denom).astype(v.dtype), vb)
    return out.reshape(b, s, hq * d)


def neighbourhood_attn_2d(q, k, v, rpb):
    b, s, h, d = q.shape
    rows = s // GRID_W
    wr = min(B_WIN_ROWS, rows)
    qg = q.reshape(b, rows, GRID_W, h, d)
    kg = k.reshape(b, rows, GRID_W, h, d)
    vg = v.reshape(b, rows, GRID_W, h, d)
    nj = GRID_W // B_QCOLS
    qcol = np.arange(GRID_W).reshape(nj, B_QCOLS)
    kstart = np.clip(np.arange(nj) * B_QCOLS - B_WIN_COLS // 2, 0, GRID_W - B_KCOLS)
    kcol = kstart[:, None] + np.arange(B_KCOLS)[None, :]
    cstart = np.clip(qcol - B_WIN_COLS // 2, 0, GRID_W - B_WIN_COLS)
    col_mask = (kcol[:, None, :] >= cstart[..., None]) & (kcol[:, None, :] < cstart[..., None] + B_WIN_COLS)
    dc_idx = np.clip(kcol[:, None, :] - qcol[..., None] + B_WIN_COLS - 1, 0, 2 * B_WIN_COLS - 2)
    rpb_c = rpb.astype(jnp.float32)[:, :, dc_idx]
    col_mask = jnp.asarray(col_mask)
    scale = 1.0 / math.sqrt(d)

    def row_block(r):
        rs = jnp.clip(r - wr // 2, 0, rows - wr)
        qr = lax.dynamic_index_in_dim(qg, r, axis=1, keepdims=False).reshape(b, nj, B_QCOLS, h, d)
        kr = lax.dynamic_slice_in_dim(kg, rs, wr, axis=1)[:, :, kcol]
        vr = lax.dynamic_slice_in_dim(vg, rs, wr, axis=1)[:, :, kcol]
        sc = jnp.einsum('bjqhd,bwjchd->bhjqwc', qr, kr).astype(jnp.float32) * scale
        dr_idx = rs + jnp.arange(wr) - r + B_WIN_ROWS - 1
        bias = jnp.take(rpb_c, dr_idx, axis=1)
        sc = sc + bias.transpose(0, 2, 3, 1, 4)[None]
        sc = jnp.where(col_mask[None, None, :, :, None, :], sc, NEG_INF)
        p = jax.nn.softmax(sc.reshape(b, h, nj, B_QCOLS, wr * B_KCOLS), axis=-1)
        p = p.reshape(b, h, nj, B_QCOLS, wr, B_KCOLS).astype(vr.dtype)
        out = jnp.einsum('bhjqwc,bwjchd->bjqhd', p, vr)
        return out.reshape(b, GRID_W, h * d)

    out = lax.map(row_block, jnp.arange(rows))
    return out.transpose(1, 0, 2, 3).reshape(b, s, h * d)


def mla(c_q, c_kv, k_rope_in, q_norm, w_q_b, kv_norm, w_kv_b, cos, sin):
    b, s, _ = c_q.shape
    q = (rms_norm(c_q, q_norm) @ w_q_b).reshape(b, s, C_HEADS, C_NOPE + C_ROPE)
    q_nope, q_rope = q[..., :C_NOPE], apply_rope(q[..., C_NOPE:], cos, sin)
    kv = (rms_norm(c_kv, kv_norm) @ w_kv_b).reshape(b, s, C_HEADS, C_NOPE + C_V)
    k_nope, vv = kv[..., :C_NOPE], kv[..., C_NOPE:]
    k_rope = apply_rope(k_rope_in[:, :, None, :], cos, sin)[:, :, 0]
    scale = 1.0 / math.sqrt(C_NOPE + C_ROPE)
    nb = s // C_BLOCK
    qn_b = q_nope.reshape(b, nb, C_BLOCK, C_HEADS, C_NOPE).transpose(1, 0, 2, 3, 4)
    qr_b = q_rope.reshape(b, nb, C_BLOCK, C_HEADS, C_ROPE).transpose(1, 0, 2, 3, 4)

    def blk(args):
        qn, qr = args
        sc = (jnp.einsum('bqhd,bkhd->bhqk', qn, k_nope).astype(jnp.float32)
              + jnp.einsum('bqhr,bkr->bhqk', qr, k_rope).astype(jnp.float32)) * scale
        p = jax.nn.softmax(sc, axis=-1).astype(vv.dtype)
        return jnp.einsum('bhqk,bkhd->bqhd', p, vv)

    out = lax.map(blk, (qn_b, qr_b))
    return out.transpose(1, 0, 2, 3, 4).reshape(b, s, C_HEADS * C_V)


def memory_xattn(h, mem_n, w_q, w_k, w_v, w_o):
    b, s, _ = h.shape
    m = mem_n.shape[1]
    q = (h @ w_q).reshape(b, s, X_HEADS, HEAD_DIM)
    k = (mem_n @ w_k).reshape(b, m, X_HEADS, HEAD_DIM)
    v = (mem_n @ w_v).reshape(b, m, X_HEADS, HEAD_DIM)
    sc = jnp.einsum('bshd,bmhd->bhsm', q, k).astype(jnp.float32) * (1.0 / math.sqrt(HEAD_DIM))
    p = jax.nn.softmax(sc, axis=-1).astype(v.dtype)
    o = jnp.einsum('bhsm,bmhd->bshd', p, v).reshape(b, s, X_DIM)
    return o @ w_o


def swiglu(h, w_gate, w_up, w_down):
    return (jax.nn.silu(h @ w_gate) * (h @ w_up)) @ w_down


def _w(key, shape, fan_in):
    return jax.random.normal(key, shape, jnp.float32) * (fan_in ** -0.5)


def _gain(key, shape):
    return 1.0 + 0.02 * jax.random.normal(key, shape, jnp.float32)


def setup_inputs(seed: int = 0) -> dict:
    key = jax.random.key(seed)
    ks = jax.random.split(key, 24)
    L = DEPTH
    return {
        'x': jax.random.normal(ks[0], (BATCH, SEQ, D_MODEL), jnp.float32),
        'mem': jax.random.normal(ks[1], (BATCH, N_MEM, D_MODEL), jnp.float32),
        'ln_mix': _gain(ks[2], (L, D_MODEL)),
        'w_in': _w(ks[3], (L, D_MODEL, D_IN), D_MODEL),
        'a_sink': 0.5 * jax.random.normal(ks[4], (L, A_Q_HEADS), jnp.float32),
        'b_rpb': 0.1 * jax.random.normal(ks[5], (L, B_HEADS, 2 * B_WIN_ROWS - 1, 2 * B_WIN_COLS - 1), jnp.float32),
        'c_q_norm': _gain(ks[6], (L, C_Q_RANK)),
        'c_w_q_b': _w(ks[7], (L, C_Q_RANK, C_HEADS * (C_NOPE + C_ROPE)), C_Q_RANK),
        'c_kv_norm': _gain(ks[8], (L, C_KV_RANK)),
        'c_w_kv_b': _w(ks[9], (L, C_KV_RANK, C_HEADS * (C_NOPE + C_V)), C_KV_RANK),
        'w_out': _w(ks[10], (L, MIX_W, D_MODEL), MIX_W),
        'ln_xattn': _gain(ks[11], (L, D_MODEL)),
        'ln_mem': _gain(ks[12], (L, D_MODEL)),
        'x_w_q': _w(ks[13], (L, D_MODEL, X_DIM), D_MODEL),
        'x_w_k': _w(ks[14], (L, D_MODEL, X_DIM), D_MODEL),
        'x_w_v': _w(ks[15], (L, D_MODEL, X_DIM), D_MODEL),
        'x_w_o': _w(ks[16], (L, X_DIM, D_MODEL), X_DIM),
        'ln_ffn': _gain(ks[17], (L, D_MODEL)),
        'w_gate': _w(ks[18], (L, D_MODEL, D_FF), D_MODEL),
        'w_up': _w(ks[19], (L, D_MODEL, D_FF), D_MODEL),
        'w_down': _w(ks[20], (L, D_FF, D_MODEL), D_FF),
        'ln_final': _gain(ks[21], (D_MODEL,)),
    }


def reference(x, mem, ln_mix, w_in, a_sink, b_rpb, c_q_norm, c_w_q_b, c_kv_norm, c_w_kv_b, w_out,
              ln_xattn, ln_mem, x_w_q, x_w_k, x_w_v, x_w_o, ln_ffn, w_gate, w_up, w_down, ln_final):
    b, s, _ = x.shape
    cos, sin = rope_tables(s)
    split_at = np.cumsum(IN_WIDTHS)[:-1].tolist()
    for l in range(DEPTH):
        h = rms_norm(x, ln_mix[l])
        aq, ak, av, bq, bk, bv, cq, ckv, ckr = jnp.split(h @ w_in[l], split_at, axis=-1)
        ya = windowed_gqa_alibi(aq.reshape(b, s, A_Q_HEADS, HEAD_DIM),
                                ak.reshape(b, s, A_KV_HEADS, HEAD_DIM),
                                av.reshape(b, s, A_KV_HEADS, HEAD_DIM), a_sink[l])
        yb = neighbourhood_attn_2d(bq.reshape(b, s, B_HEADS, HEAD_DIM),
                                   bk.reshape(b, s, B_HEADS, HEAD_DIM),
                                   bv.reshape(b, s, B_HEADS, HEAD_DIM), b_rpb[l])
        yc = mla(cq, ckv, ckr, c_q_norm[l], c_w_q_b[l], c_kv_norm[l], c_w_kv_b[l], cos, sin)
        x = x + jnp.concatenate([ya, yb, yc], axis=-1) @ w_out[l]
        x = x + memory_xattn(rms_norm(x, ln_xattn[l]), rms_norm(mem, ln_mem[l]),
                             x_w_q[l], x_w_k[l], x_w_v[l], x_w_o[l])
        x = x + swiglu(rms_norm(x, ln_ffn[l]), w_gate[l], w_up[l], w_down[l])
    return rms_norm(x, ln_final)
```

```cpp
#include <hip/hip_runtime.h>
#include <cstdio>
#include <cstdint>
#include <cmath>

#ifndef DBG
#define DBG 0
#endif

constexpr int BATCH = 2, SEQ = 8192, DM = 4096, MTOK = BATCH * SEQ, DEPTH = 2;
constexpr int NMEM = 256, MEMROWS = BATCH * NMEM;
constexpr int D_IN = 7232, D_INP = 7424;
constexpr int OFF_AQ = 0, OFF_AK = 1536, OFF_AV = 2048, OFF_BQ = 2560, OFF_BK = 3584, OFF_BV = 4608, OFF_CQ = 5632, OFF_CKV = 6656, OFF_CKR = 7168;
constexpr int QRANK = 1024, KVRANK = 512, CH = 12, CQK = 192, QCW = CH * CQK, KVW = CH * 256, VCW = CH * 128;
constexpr int XD = 512, DFF = 11008, GUW = 2 * DFF;
constexpr int AH = 12, BH = 8;
constexpr int MIX_A = 0, MIX_B = 1536, MIX_C = 2560;
constexpr float NORM_EPS = 1e-6f;
constexpr float QSC_C = 0.07216878364870322f * 1.4426950408889634f;

constexpr size_t MiB = 1u << 20;
constexpr size_t WS_CTL = 0, CTL_ZERO_BYTES = 1 * MiB;
constexpr size_t WS_COS = 1 * MiB, WS_SIN = 2 * MiB;
constexpr size_t WS_MEMN = 3 * MiB;
constexpr size_t WS_MEMKV = 7 * MiB;
constexpr size_t WS_XQ = 8 * MiB, WS_XO = 24 * MiB;
constexpr size_t WS_H = 40 * MiB;
constexpr size_t WS_PROJ = 168 * MiB;
constexpr size_t WS_CQN = 400 * MiB;
constexpr size_t WS_CKVN = 432 * MiB;
constexpr size_t WS_QC = 448 * MiB;
constexpr size_t WS_KC = 520 * MiB;
constexpr size_t WS_VC = 592 * MiB;
constexpr size_t WS_MIX = 640 * MiB;
constexpr size_t WS_ACT = 168 * MiB;
constexpr size_t WS_W = 768 * MiB;
constexpr size_t WO_IN = 0, WO_QB = WO_IN + (size_t)D_INP * DM * 2, WO_KVB = WO_QB + (size_t)QCW * QRANK * 2, WO_OUT = WO_KVB + (size_t)KVW * KVRANK * 2,
                 WO_XQ = WO_OUT + (size_t)DM * DM * 2, WO_XKV = WO_XQ + (size_t)XD * DM * 2, WO_XO = WO_XKV + (size_t)2 * XD * DM * 2, WO_GU = WO_XO + (size_t)DM * XD * 2,
                 WO_DOWN = WO_GU + (size_t)GUW * DM * 2, W_LAYER = WO_DOWN + (size_t)DM * DFF * 2;
constexpr size_t WS_SSQ = WS_W + 2 * W_LAYER;
constexpr size_t WS_SSQ2 = WS_SSQ + 4 * MiB;
constexpr size_t WS_CKR = WS_SSQ2 + 2 * MiB;
constexpr size_t WS_DBG = WS_CKR + 16 * MiB;
constexpr size_t WS_END = WS_DBG + 1 * MiB;
static_assert((2 * W_LAYER) % MiB == 0, "SSQ alignment");
static_assert(WS_ACT + (size_t)MTOK * DFF * 2 <= WS_MIX, "ACT overlay");
static_assert(WS_PROJ + (size_t)MTOK * D_INP * 2 <= WS_CQN, "PROJ");
static_assert(W_LAYER % 256 == 0, "weights aligned");

constexpr int CW_BAR = 4096;

constexpr int RING_BYTES = 131072;
constexpr int LDSCTL_OFF = RING_BYTES, MISC_OFF = LDSCTL_OFF + 320;
constexpr int RSTD_OFF = LDSCTL_OFF + 1024;
constexpr int LDS_BYTES = 147456;
static_assert(RSTD_OFF + 8192 <= LDS_BYTES, "LDS map");

typedef unsigned short bf16_t;
#define LAS __attribute__((address_space(3)))
#define GAS __attribute__((address_space(1)))
typedef GAS unsigned gu32;
#define RLX_AGENT __ATOMIC_RELAXED, __HIP_MEMORY_SCOPE_AGENT

__device__ __forceinline__ float bf2f(bf16_t b) { return __uint_as_float(((unsigned)b) << 16); }
__device__ __forceinline__ unsigned cvt_pk_bf16(float lo, float hi) { unsigned r; asm volatile("v_cvt_pk_bf16_f32 %0, %1, %2" : "=v"(r) : "v"(lo), "v"(hi)); return r; }
__device__ __forceinline__ float wave_sum(float v) {
#pragma unroll
    for (int o = 1; o < 64; o <<= 1) v += __shfl_xor(v, o);
    return v;
}

namespace pg8 {
#define PG8_LAS __attribute__((address_space(3)))
typedef short bf16x8 __attribute__((ext_vector_type(8)));
typedef float f32x4 __attribute__((ext_vector_type(4)));
typedef float f32x2 __attribute__((ext_vector_type(2)));
typedef unsigned u32x4 __attribute__((ext_vector_type(4)));
constexpr int BM = 256, BK = 64, HALF = 128, HTB = HALF * BK * 2, STAGE_BYTES = 8 * HTB, NXCD = 8, WGM = 8;

__host__ __device__ __forceinline__ int lds_byte(int r, int c) { const int st = (r >> 4) * 2 + (c >> 5), rr = r & 15, cc = c & 31, ob = rr * 64 + cc * 2; return st * 1024 + (ob ^ (((ob >> 9) & 1) << 5)); }
__host__ __device__ __forceinline__ void stage_rc(int b, int& R, int& C) { const int st = b / 1024, sb = b % 1024, swz = sb ^ (((sb >> 9) & 1) << 5); R = (st >> 1) * 16 + swz / 64; C = (st & 1) * 32 + (swz % 64) / 2; }
__host__ __device__ __forceinline__ int perm32(int rho) { const int n = rho >> 4, i = rho & 15; return 8 * (i >> 2) + 4 * n + (i & 3); }

struct Unit { int pm, pn; };
struct Gemm { const bf16_t* A; const bf16_t* Bt; int M, N, K, lda, ldb, nNc; unsigned ksplit_bytes; };

struct StaticOrder {
    int nM, nN, nwg, G, c, wgm;
    __host__ __device__ void init(int M, int N, int G_, int c_, int wgm_ = WGM) { nM = M / BM; nN = N / BM; nwg = nM * nN; G = G_; c = c_; wgm = wgm_; }
    __host__ __device__ bool next(int i, Unit& u) const {
        const long L = (long)i * G + c; if (L >= nwg) return false;
        int wgid = (int)L; { const int q = nwg / NXCD, r = nwg % NXCD, xcd = wgid % NXCD, off = wgid / NXCD; wgid = (xcd < r ? xcd * (q + 1) : r * (q + 1) + (xcd - r) * q) + off; }
        const int nig = wgm * nN, gid = wgid / nig, fm = gid * wgm, gsz = (nM - fm) < wgm ? (nM - fm) : wgm;
        u.pm = fm + ((wgid % nig) % gsz); u.pn = (wgid % nig) / gsz; return true;
    }
    __device__ __forceinline__ void a_ready(const Unit&) const {}
    __device__ __forceinline__ void done(const Unit&) const {}
};


template <int NS> __device__ __forceinline__ void rows_rstd(float (&rs)[2][4], const float* slots, int pitch, int row0, int fq, float inv_n) {
#pragma unroll
    for (int ai = 0; ai < 2; ++ai)
#pragma unroll
        for (int m = 0; m < 4; ++m) { const float* p = slots + (size_t)(row0 + ai * HALF + m * 16) * pitch; float t;
            if constexpr (NS == 64) { const f32x4 a = *(const f32x4*)(p + fq * 16), b = *(const f32x4*)(p + fq * 16 + 4), c = *(const f32x4*)(p + fq * 16 + 8), d = *(const f32x4*)(p + fq * 16 + 12);
                t = ((a[0] + a[1]) + (a[2] + a[3])) + ((b[0] + b[1]) + (b[2] + b[3])) + ((c[0] + c[1]) + (c[2] + c[3])) + ((d[0] + d[1]) + (d[2] + d[3])); }
            else if constexpr (NS == 16) { const f32x4 a = *(const f32x4*)(p + fq * 4); t = (a[0] + a[1]) + (a[2] + a[3]); }
            else { const f32x2 a = *(const f32x2*)(p + fq * 2); t = a[0] + a[1]; }
            t += __shfl_xor(t, 16); t += __shfl_xor(t, 32);
            rs[ai][m] = rsqrtf(t * inv_n + NORM_EPS); }
}
__device__ __forceinline__ void rows_rstd_tab(float (&rs)[2][4], const PG8_LAS float* tab, int tab_row0, int row0) {
#pragma unroll
    for (int ai = 0; ai < 2; ++ai)
#pragma unroll
        for (int m = 0; m < 4; ++m) rs[ai][m] = tab[row0 + ai * HALF + m * 16 - tab_row0];
}
__device__ __forceinline__ u32x4 pack8(const f32x4 v0, const f32x4 v1) { u32x4 w; w.x = cvt_pk_bf16(v0[0], v0[1]); w.y = cvt_pk_bf16(v0[2], v0[3]); w.z = cvt_pk_bf16(v1[0], v1[1]); w.w = cvt_pk_bf16(v1[2], v1[3]); return w; }

struct EpiStore {
    static constexpr bool PERM = true, AFTER_DRAIN = false, INPLACE = false, B0ONLY = false;
    bf16_t* O; int ldc;
    __device__ __forceinline__ void operator()(const f32x4 (&acc)[2][2][4][2], const Unit& u, int wr, int wc, int fr, int fq) const {
        const int row0 = u.pm * BM + wr * 64 + fr, col0 = u.pn * BM + wc * 32 + 8 * fq;
#pragma unroll
        for (int ai = 0; ai < 2; ++ai)
#pragma unroll
            for (int m = 0; m < 4; ++m) { bf16_t* rowp = O + (size_t)(row0 + ai * HALF + m * 16) * ldc + col0;
#pragma unroll
                for (int bj = 0; bj < 2; ++bj) *(u32x4*)(rowp + bj * HALF) = pack8(acc[ai][bj][m][0], acc[ai][bj][m][1]); }
    }
};
struct EpiStoreScaled {
    static constexpr bool PERM = true, AFTER_DRAIN = false, INPLACE = false, B0ONLY = false;
    bf16_t* O; int ldc; const PG8_LAS float* tab; int tab_row0;
    __device__ __forceinline__ void operator()(const f32x4 (&acc)[2][2][4][2], const Unit& u, int wr, int wc, int fr, int fq) const {
        const int row0 = u.pm * BM + wr * 64 + fr, col0 = u.pn * BM + wc * 32 + 8 * fq;
        float rs[2][4]; rows_rstd_tab(rs, tab, tab_row0, row0);
#pragma unroll
        for (int ai = 0; ai < 2; ++ai)
#pragma unroll
            for (int m = 0; m < 4; ++m) { bf16_t* rowp = O + (size_t)(row0 + ai * HALF + m * 16) * ldc + col0;
#pragma unroll
                for (int bj = 0; bj < 2; ++bj) *(u32x4*)(rowp + bj * HALF) = pack8(acc[ai][bj][m][0] * rs[ai][m], acc[ai][bj][m][1] * rs[ai][m]); }
    }
};
struct EpiG1 {
    static constexpr bool PERM = true, AFTER_DRAIN = false, INPLACE = false, B0ONLY = false;
    bf16_t* PROJ; const PG8_LAS float* tab; int tab_row0; float* ssq2;
    __device__ __forceinline__ void operator()(const f32x4 (&acc)[2][2][4][2], const Unit& u, int wr, int wc, int fr, int fq) const {
        const int row0 = u.pm * BM + wr * 64 + fr, col0 = u.pn * BM + wc * 32 + 8 * fq;
        float rs[2][4]; rows_rstd_tab(rs, tab, tab_row0, row0);
        const bool stats = u.pn >= 22; const int slot = (u.pn < 26 ? (u.pn - 22) * 4 : 16 + (u.pn - 26) * 4) + wc;
#pragma unroll
        for (int ai = 0; ai < 2; ++ai)
#pragma unroll
            for (int m = 0; m < 4; ++m) { const int row = row0 + ai * HALF + m * 16; bf16_t* rowp = PROJ + (size_t)row * D_INP + col0; float q = 0.f;
#pragma unroll
                for (int bj = 0; bj < 2; ++bj) { const f32x4 v0 = acc[ai][bj][m][0] * rs[ai][m], v1 = acc[ai][bj][m][1] * rs[ai][m];
                    q += ((v0[0] * v0[0] + v0[1] * v0[1]) + (v0[2] * v0[2] + v0[3] * v0[3])) + ((v1[0] * v1[0] + v1[1] * v1[1]) + (v1[2] * v1[2] + v1[3] * v1[3]));
                    *(u32x4*)(rowp + bj * HALF) = pack8(v0, v1); }
                if (stats) { q += __shfl_xor(q, 16); q += __shfl_xor(q, 32); if (fq == 0) ssq2[(size_t)row * 24 + slot] = q; } }
    }
};
struct EpiCkr {
    static constexpr bool PERM = true, AFTER_DRAIN = false, INPLACE = false, B0ONLY = true;
    float* slab;
    __device__ __forceinline__ void operator()(const f32x4 (&acc)[2][2][4][2], const Unit& u, int wr, int wc, int fr, int fq) const {
        if (wc >= 2) return;
        const int row0 = u.pm * BM + wr * 64 + fr; float* base = slab + (size_t)u.pn * MTOK * 64 + 32 * wc + 8 * fq;
#pragma unroll
        for (int ai = 0; ai < 2; ++ai)
#pragma unroll
            for (int m = 0; m < 4; ++m) { float* p = base + (size_t)(row0 + ai * HALF + m * 16) * 64; *(f32x4*)p = acc[ai][0][m][0]; *(f32x4*)(p + 4) = acc[ai][0][m][1]; }
    }
};
struct EpiQRope {
    static constexpr bool PERM = true, AFTER_DRAIN = false, INPLACE = false, B0ONLY = false;
    bf16_t* O; const float* cs; const float* sn; const float* ssq2;
    __device__ __forceinline__ void operator()(const f32x4 (&acc)[2][2][4][2], const Unit& u, int wr, int wc, int fr, int fq) const {
        const int row0 = u.pm * BM + wr * 64 + fr;
        float rs[2][4]; rows_rstd<16>(rs, ssq2, 24, row0, fq, 1.f / QRANK);
#pragma unroll
        for (int bj = 0; bj < 2; ++bj) {
            const int cg = u.pn * BM + bj * HALF + wc * 32;
            const int hc = cg % CQK;
            const bool rope = hc >= 128;
            const int i0 = ((hc - 128) >> 1) + 4 * fq;
#pragma unroll
            for (int ai = 0; ai < 2; ++ai)
#pragma unroll
                for (int m = 0; m < 4; ++m) { const int row = row0 + ai * HALF + m * 16;
                    f32x4 v0 = acc[ai][bj][m][0] * (rs[ai][m] * QSC_C), v1 = acc[ai][bj][m][1] * (rs[ai][m] * QSC_C);
                    if (rope) { const int pos = row & (SEQ - 1); const f32x4 c = *(const f32x4*)(cs + pos * 32 + i0), s = *(const f32x4*)(sn + pos * 32 + i0);
                        const f32x4 a0 = v0, a1 = v1;
                        v0[0] = a0[0] * c[0] - a0[1] * s[0]; v0[1] = a0[0] * s[0] + a0[1] * c[0];
                        v0[2] = a0[2] * c[1] - a0[3] * s[1]; v0[3] = a0[2] * s[1] + a0[3] * c[1];
                        v1[0] = a1[0] * c[2] - a1[1] * s[2]; v1[1] = a1[0] * s[2] + a1[1] * c[2];
                        v1[2] = a1[2] * c[3] - a1[3] * s[3]; v1[3] = a1[2] * s[3] + a1[3] * c[3]; }
                    *(u32x4*)(O + (size_t)row * QCW + cg + 8 * fq) = pack8(v0, v1); }
        }
    }
};
struct EpiKV {
    static constexpr bool PERM = true, AFTER_DRAIN = false, INPLACE = false, B0ONLY = false;
    bf16_t* KC; bf16_t* VC; const float* ssq2;
    __device__ __forceinline__ void operator()(const f32x4 (&acc)[2][2][4][2], const Unit& u, int wr, int wc, int fr, int fq) const {
        const int row0 = u.pm * BM + wr * 64 + fr, cl = wc * 32 + 8 * fq;
        float rs[2][4]; rows_rstd<8>(rs, ssq2 + 16, 24, row0, fq, 1.f / KVRANK);
#pragma unroll
        for (int ai = 0; ai < 2; ++ai)
#pragma unroll
            for (int m = 0; m < 4; ++m) { const int row = row0 + ai * HALF + m * 16;
#pragma unroll
                for (int bj = 0; bj < 2; ++bj) {
                    bf16_t* dst = bj == 0 ? KC + (size_t)row * QCW + u.pn * CQK + cl : VC + (size_t)row * VCW + u.pn * 128 + cl;
                    *(u32x4*)dst = pack8(acc[ai][bj][m][0] * rs[ai][m], acc[ai][bj][m][1] * rs[ai][m]); } }
    }
};
struct EpiRes {
    static constexpr bool PERM = true, AFTER_DRAIN = false, INPLACE = true, B0ONLY = false;
    const bf16_t* base; bf16_t* out; float* ssq;
    __device__ __forceinline__ void operator()(const f32x4 (&acc)[2][2][4][2], const Unit& u, int wr, int wc, int fr, int fq) const {
        const int row0 = u.pm * BM + wr * 64 + fr, col0 = u.pn * BM + wc * 32 + 8 * fq;
#pragma unroll
        for (int ai = 0; ai < 2; ++ai) {
            u32x4 b[4][2];
#pragma unroll
            for (int m = 0; m < 4; ++m) { const size_t off = (size_t)(row0 + ai * HALF + m * 16) * DM + col0;
#pragma unroll
                for (int bj = 0; bj < 2; ++bj) b[m][bj] = *(const u32x4*)(base + off + bj * HALF); }
            asm volatile("" ::: "memory");
#pragma unroll
            for (int m = 0; m < 4; ++m) { const int row = row0 + ai * HALF + m * 16; const size_t off = (size_t)row * DM + col0;
                f32x4 q4 = {0.f, 0.f, 0.f, 0.f};
#pragma unroll
                for (int bj = 0; bj < 2; ++bj) { const u32x4 w = b[m][bj];
                    const f32x4 r0 = {__uint_as_float(w.x << 16), __uint_as_float(w.x & 0xffff0000u), __uint_as_float(w.y << 16), __uint_as_float(w.y & 0xffff0000u)};
                    const f32x4 r1 = {__uint_as_float(w.z << 16), __uint_as_float(w.z & 0xffff0000u), __uint_as_float(w.w << 16), __uint_as_float(w.w & 0xffff0000u)};
                    const f32x4 v0 = r0 + acc[ai][bj][m][0], v1 = r1 + acc[ai][bj][m][1];
                    q4 += v0 * v0; q4 += v1 * v1;
                    *(u32x4*)(out + off + bj * HALF) = pack8(v0, v1); }
                float q = (q4[0] + q4[1]) + (q4[2] + q4[3]);
                q += __shfl_xor(q, 16); q += __shfl_xor(q, 32); if (fq == 0) ssq[(size_t)row * 64 + u.pn * 4 + wc] = q; }
            asm volatile("" ::: "memory"); }
    }
};
struct EpiSwiglu {
    static constexpr bool PERM = true, AFTER_DRAIN = false, INPLACE = false, B0ONLY = false;
    bf16_t* O; int ldc; const PG8_LAS float* tab; int tab_row0;
    __device__ __forceinline__ f32x4 sw4(const f32x4 g, const f32x4 u, float k1, float r2) const {
        f32x4 e = g * k1;
#pragma unroll
        for (int c = 0; c < 4; ++c) e[c] = __builtin_amdgcn_exp2f(e[c]);
        f32x4 d = e + 1.0f;
#pragma unroll
        for (int c = 0; c < 4; ++c) d[c] = __builtin_amdgcn_rcpf(d[c]);
        return ((g * u) * r2) * d;
    }
    __device__ __forceinline__ void operator()(const f32x4 (&acc)[2][2][4][2], const Unit& u, int wr, int wc, int fr, int fq) const {
        const int row0 = u.pm * BM + wr * 64 + fr, col0 = u.pn * HALF + wc * 32 + 8 * fq;
        float rs[2][4]; rows_rstd_tab(rs, tab, tab_row0, row0);
#pragma unroll
        for (int ai = 0; ai < 2; ++ai)
#pragma unroll
            for (int m = 0; m < 4; ++m) { const float r = rs[ai][m], r2 = r * r, k1 = -1.4426950408889634f * r;
                const f32x4 o0 = sw4(acc[ai][0][m][0], acc[ai][1][m][0], k1, r2), o1 = sw4(acc[ai][0][m][1], acc[ai][1][m][1], k1, r2);
                *(u32x4*)(O + (size_t)(row0 + ai * HALF + m * 16) * ldc + col0) = pack8(o0, o1); }
    }
};

template <class Epi, class Sched, bool ALIGN_EPI = false, bool SP2 = false>
__device__ __forceinline__ void gemm_phase(PG8_LAS unsigned char* lds, const Gemm g, const Sched& S, const Epi& E) {
    int tid_o = threadIdx.x; asm volatile("" : "+v"(tid_o));
    const int tid = tid_o, wid = __builtin_amdgcn_readfirstlane(tid >> 6), lane = tid & 63, wr = wid >> 2, wc = wid & 3, fr = lane & 15, fq = lane >> 4;
    const int K = g.K, nt = K / BK;
    unsigned voffA[2], voffB[2];
#pragma unroll
    for (int i = 0; i < 2; ++i) { int R, C; stage_rc(tid * 16 + i * 8192, R, C); const int Rb = Epi::PERM ? ((R & ~31) + perm32(R & 31)) : R;
        voffA[i] = (unsigned)(R * g.lda + C) * 2u; voffB[i] = (unsigned)(Rb * g.ldb + C) * 2u; }
    const size_t kstep = (size_t)(BK * 2);
    const size_t hstepA = (size_t)HALF * g.lda * 2, hstepB = (size_t)HALF * g.ldb * 2;
    const size_t tstepA = 2 * hstepA, tstepB = 2 * hstepB;
    const unsigned ldsw = (unsigned)wid * 1024u;
    const int aoff = lds_byte(wr * 64 + fr, fq * 8), boff = lds_byte(wc * 32 + fr, fq * 8);
#define PG8_SA(b, h) (((b) * 2 + (h)) * HTB)
#define PG8_SB(b, h) ((4 + (b) * 2 + (h)) * HTB)
#define PG8_STAGE(bufoff, gbase, voff) do { _Pragma("unroll") for (int _i = 0; _i < 2; ++_i) \
        __builtin_amdgcn_global_load_lds((const unsigned*)((const char*)(gbase) + (voff)[_i]), (PG8_LAS unsigned*)(lds + (bufoff) + ldsw + _i * 8192), 16, 0, 0); } while (0)
#define PG8_LDA(dst, b, h) do { _Pragma("unroll") for (int m = 0; m < 4; ++m) _Pragma("unroll") for (int k = 0; k < 2; ++k) dst[m][k] = *(const PG8_LAS bf16x8*)(lds + PG8_SA(b, h) + aoff + m * 2048 + k * 1024); } while (0)
#define PG8_LDB(dst, b, h) do { _Pragma("unroll") for (int n = 0; n < 2; ++n) _Pragma("unroll") for (int k = 0; k < 2; ++k) dst[n][k] = *(const PG8_LAS bf16x8*)(lds + PG8_SB(b, h) + boff + n * 2048 + k * 1024); } while (0)
#define PG8_MMA(ai, bj, At, Bt) do { __builtin_amdgcn_s_setprio(3); _Pragma("unroll") for (int m = 0; m < 4; ++m) _Pragma("unroll") for (int n = 0; n < 2; ++n) _Pragma("unroll") for (int k = 0; k < 2; ++k) \
        acc[ai][bj][m][n] = __builtin_amdgcn_mfma_f32_16x16x32_bf16(Bt[n][k], At[m][k], acc[ai][bj][m][n], 0, 0, 0); __builtin_amdgcn_s_setprio(0); } while (0)
#define PG8_WAIT_V(n) asm volatile("s_waitcnt vmcnt(" #n ")" ::: "memory")
#define PG8_WAIT_L(n) asm volatile("s_waitcnt lgkmcnt(" #n ")" ::: "memory")
#define PG8_BAR __builtin_amdgcn_s_barrier()
#define PG8_SCHED __builtin_amdgcn_sched_barrier(0)
    Unit cur, nxt; int ui = 0;
    if (!S.next(0, cur)) return;
    f32x4 acc[2][2][4][2];
#pragma unroll
    for (int a = 0; a < 2; ++a)
#pragma unroll
        for (int b = 0; b < 2; ++b)
#pragma unroll
            for (int m = 0; m < 4; ++m)
#pragma unroll
                for (int n = 0; n < 2; ++n) acc[a][b][m][n] = (f32x4){0.f, 0.f, 0.f, 0.f};
    bf16x8 At[4][2], B0[2][2], B1[2][2];
#define PG8_UA(u) ((const char*)g.A + (size_t)(u).pm * tstepA + (size_t)((u).pn / g.nNc) * g.ksplit_bytes)
#define PG8_UB(u) ((const char*)g.Bt + (size_t)((u).pn % g.nNc) * tstepB + (size_t)((u).pn / g.nNc) * g.ksplit_bytes)
    const char* cA = PG8_UA(cur); const char* cB = PG8_UB(cur);
    S.a_ready(cur);
    if constexpr (SP2) {
        PG8_STAGE(PG8_SB(0, 0), cB, voffB); PG8_STAGE(PG8_SB(0, 1), cB + hstepB, voffB); PG8_STAGE(PG8_SA(0, 0), cA, voffA); PG8_STAGE(PG8_SA(0, 1), cA + hstepA, voffA);
        if (wr == 1) PG8_BAR;
        PG8_WAIT_V(2); PG8_BAR;
        PG8_STAGE(PG8_SB(1, 0), cB + kstep, voffB); PG8_STAGE(PG8_SA(1, 0), cA + kstep, voffA); PG8_STAGE(PG8_SB(1, 1), cB + hstepB + kstep, voffB);
        PG8_WAIT_V(6); PG8_BAR;
    } else {
        PG8_STAGE(PG8_SB(0, 0), cB, voffB); PG8_STAGE(PG8_SA(0, 0), cA, voffA); PG8_STAGE(PG8_SB(0, 1), cB + hstepB, voffB); PG8_STAGE(PG8_SA(0, 1), cA + hstepA, voffA);
        if (wr == 1) PG8_BAR;
        PG8_WAIT_V(4); PG8_BAR;
        PG8_STAGE(PG8_SB(1, 0), cB + kstep, voffB); PG8_STAGE(PG8_SA(1, 0), cA + kstep, voffA); PG8_STAGE(PG8_SB(1, 1), cB + hstepB + kstep, voffB);
        PG8_WAIT_V(6); PG8_BAR;
    }
    for (;;) {
        const bool has_next = S.next(ui + 1, nxt);
        const char* nA = has_next ? PG8_UA(nxt) : cA; const char* nB = has_next ? PG8_UB(nxt) : cB;
        for (int t = 0; t < nt; t += 2) {
            const bool last = (t == nt - 2);
            const char* a1 = cA + (size_t)(t + 1) * kstep;
            const char* a2 = last ? nA : cA + (size_t)(t + 2) * kstep; const char* b2 = last ? nB : cB + (size_t)(t + 2) * kstep;
            const char* a3 = a2 + kstep; const char* b3 = b2 + kstep;
            if (last && has_next) S.a_ready(nxt);
            if constexpr (SP2) {
#define PG8_MM(ai) do { if constexpr (Epi::B0ONLY) { if (wc < 2) PG8_MMA(ai, 0, At, B0); } else { PG8_MMA(ai, 0, At, B0); PG8_MMA(ai, 1, At, B1); } } while (0)
#define PG8_LB1(b) do { if constexpr (!Epi::B0ONLY) PG8_LDB(B1, b, 1); } while (0)
            PG8_LDB(B0, 0, 0); PG8_LB1(0); PG8_SCHED; PG8_LDA(At, 0, 0); PG8_STAGE(PG8_SA(1, 1), a1 + hstepA, voffA);
            PG8_WAIT_V(8); PG8_WAIT_L(0); PG8_BAR; PG8_MM(0); PG8_BAR; PG8_SCHED;
            PG8_LDA(At, 0, 1); PG8_STAGE(PG8_SB(0, 0), b2, voffB); PG8_STAGE(PG8_SB(0, 1), b2 + hstepB, voffB); PG8_STAGE(PG8_SA(0, 0), a2, voffA);
            PG8_WAIT_V(8); PG8_WAIT_L(0); PG8_BAR; PG8_MM(1); PG8_BAR; PG8_SCHED;
            PG8_LDB(B0, 1, 0); PG8_LB1(1); PG8_SCHED; PG8_LDA(At, 1, 0); PG8_STAGE(PG8_SA(0, 1), a2 + hstepA, voffA);
            PG8_WAIT_V(8); PG8_WAIT_L(0); PG8_BAR; PG8_MM(0); PG8_BAR; PG8_SCHED;
            PG8_LDA(At, 1, 1); PG8_STAGE(PG8_SB(1, 0), b3, voffB); PG8_STAGE(PG8_SB(1, 1), b3 + hstepB, voffB); PG8_STAGE(PG8_SA(1, 0), a3, voffA);
            PG8_WAIT_V(8); PG8_WAIT_L(0); PG8_BAR; PG8_MM(1); PG8_BAR; PG8_SCHED;
#undef PG8_MM
#undef PG8_LB1
            } else {
            PG8_LDB(B0, 0, 0); PG8_SCHED; PG8_LDA(At, 0, 0); PG8_STAGE(PG8_SA(1, 1), a1 + hstepA, voffA);
            PG8_WAIT_L(8); PG8_BAR; PG8_WAIT_L(0); PG8_MMA(0, 0, At, B0); PG8_BAR; PG8_SCHED;
            PG8_LDB(B1, 0, 1); PG8_STAGE(PG8_SB(0, 0), b2, voffB);
            PG8_BAR; PG8_WAIT_L(0); PG8_MMA(0, 1, At, B1); PG8_BAR;
            PG8_LDA(At, 0, 1); PG8_STAGE(PG8_SA(0, 0), a2, voffA);
            PG8_BAR; PG8_WAIT_L(0); PG8_MMA(1, 0, At, B0); PG8_BAR; PG8_SCHED;
            PG8_STAGE(PG8_SB(0, 1), b2 + hstepB, voffB);
            PG8_WAIT_V(6); PG8_BAR; PG8_MMA(1, 1, At, B1); PG8_BAR;
            PG8_LDB(B0, 1, 0); PG8_SCHED; PG8_LDA(At, 1, 0); PG8_STAGE(PG8_SA(0, 1), a2 + hstepA, voffA);
            PG8_WAIT_L(8); PG8_BAR; PG8_WAIT_L(0); PG8_MMA(0, 0, At, B0); PG8_BAR; PG8_SCHED;
            PG8_LDB(B1, 1, 1); PG8_STAGE(PG8_SB(1, 0), b3, voffB);
            PG8_BAR; PG8_WAIT_L(0); PG8_MMA(0, 1, At, B1); PG8_BAR;
            PG8_LDA(At, 1, 1); PG8_STAGE(PG8_SA(1, 0), a3, voffA);
            PG8_BAR; PG8_WAIT_L(0); PG8_MMA(1, 0, At, B0); PG8_BAR; PG8_SCHED;
            PG8_STAGE(PG8_SB(1, 1), b3 + hstepB, voffB);
            PG8_WAIT_V(6); PG8_BAR; PG8_MMA(1, 1, At, B1); PG8_BAR;
            }
        }
        if constexpr (ALIGN_EPI) { if (wr == 0) PG8_BAR; }
#ifndef EPIX
#define EPIX 0
#endif
        if constexpr (!Epi::AFTER_DRAIN) { E(acc, cur, wr, wc, fr, fq); if constexpr (EPIX && !Epi::INPLACE) { asm volatile("" ::: "memory"); E(acc, cur, wr, wc, fr, fq); } S.done(cur); }
        if (!has_next) break;
#pragma unroll
        for (int a = 0; a < 2; ++a)
#pragma unroll
            for (int b = 0; b < 2; ++b)
#pragma unroll
                for (int m = 0; m < 4; ++m)
#pragma unroll
                    for (int n = 0; n < 2; ++n) acc[a][b][m][n] = (f32x4){0.f, 0.f, 0.f, 0.f};
        cur = nxt; cA = nA; cB = nB; ++ui;
        if constexpr (ALIGN_EPI) { if (wr == 1) PG8_BAR; }
    }
    PG8_WAIT_V(0);
    if constexpr (!ALIGN_EPI) { if (wr == 0) PG8_BAR; }
    PG8_BAR;
#undef PG8_UA
#undef PG8_UB
#undef PG8_SA
#undef PG8_SB
#undef PG8_STAGE
#undef PG8_LDA
#undef PG8_LDB
#undef PG8_MMA
#undef PG8_WAIT_V
#undef PG8_WAIT_L
#undef PG8_BAR
#undef PG8_SCHED
}
}

namespace att {
using bf16x8 = __attribute__((ext_vector_type(8))) short;
using s16x4 = __attribute__((ext_vector_type(4))) short;
using f32x16 = __attribute__((ext_vector_type(16))) float;
using u32x4 = __attribute__((ext_vector_type(4))) unsigned;
constexpr int NW = 8, QBLK = 32, KVBLK = 64;
constexpr float THR = 8.f;
constexpr int L_V = 0, SHM_V = 16384, L_K = 32768, SHM_KMAX = 24576, L_WS = 81920, L_TAB = 83968, L_QS = 86016, L_END = L_QS + 8 * 4096;
static_assert(L_END <= 131072, "attention LDS fits the ring region");
constexpr int OST_PITCH = 272, OST_WAVE = 32 * OST_PITCH;
static_assert(NW * OST_WAVE <= L_WS, "O staging fits under the scratch");
#define SBAR() __builtin_amdgcn_sched_barrier(0)
__device__ __forceinline__ int crow(int r, int hi) { return (r & 3) + 8 * (r >> 2) + 4 * hi; }
__device__ __forceinline__ unsigned cvtpk(float lo, float hi) { unsigned r; asm volatile("v_cvt_pk_bf16_f32 %0, %1, %2" : "=v"(r) : "v"(lo), "v"(hi)); return r; }

__device__ __forceinline__ void partialSM(f32x16& p0, f32x16& p1, float& m_reg, float& mn, float& alpha, const float C, const float thr_raw) {
  float pmax = p0[0];
#pragma unroll
  for (int r = 1; r < 16; ++r) pmax = fmaxf(pmax, p0[r]);
#pragma unroll
  for (int r = 0; r < 16; ++r) pmax = fmaxf(pmax, p1[r]);
  { auto rr = __builtin_amdgcn_permlane32_swap(__float_as_uint(pmax), __float_as_uint(pmax), false, false);
    pmax = fmaxf(__uint_as_float(rr[0]), __uint_as_float(rr[1])); }
  if (__builtin_expect(__all(pmax - m_reg <= thr_raw), 1)) { mn = m_reg; alpha = 1.f; }
  else { mn = fmaxf(m_reg, pmax); alpha = __builtin_amdgcn_exp2f((m_reg - mn) * C); m_reg = mn; }
  const float mnC = -mn * C;
#pragma unroll
  for (int r = 0; r < 16; ++r) p0[r] = fmaf(p0[r], C, mnC);
#pragma unroll
  for (int r = 0; r < 16; ++r) p1[r] = fmaf(p1[r], C, mnC);
#pragma unroll
  for (int r = 0; r < 16; ++r) p0[r] = __builtin_amdgcn_exp2f(p0[r]);
}
__device__ __forceinline__ void finishSM(f32x16& p0, f32x16& p1, float alpha, float& l_reg, bf16x8& pa0, bf16x8& pa1, bf16x8& pa2, bf16x8& pa3) {
#pragma unroll
  for (int r = 0; r < 16; ++r) p1[r] = __builtin_amdgcn_exp2f(p1[r]);
  float ps = 0;
#pragma unroll
  for (int r = 0; r < 16; ++r) ps += p0[r];
#pragma unroll
  for (int r = 0; r < 16; ++r) ps += p1[r];
  { auto rr = __builtin_amdgcn_permlane32_swap(__float_as_uint(ps), __float_as_uint(ps), false, false);
    ps = __uint_as_float(rr[0]) + __uint_as_float(rr[1]); }
  l_reg = l_reg * alpha + ps;
#define PK4(P, BASE, OUT) do { unsigned a0 = cvtpk(P[BASE + 0], P[BASE + 1]), a1 = cvtpk(P[BASE + 2], P[BASE + 3]);   \
    unsigned b0 = cvtpk(P[BASE + 4], P[BASE + 5]), b1 = cvtpk(P[BASE + 6], P[BASE + 7]);                              \
    auto r0 = __builtin_amdgcn_permlane32_swap(a0, b0, false, false); auto r1 = __builtin_amdgcn_permlane32_swap(a1, b1, false, false); \
    u32x4 w = {r0[0], r1[0], r0[1], r1[1]}; OUT = *reinterpret_cast<bf16x8*>(&w); } while (0)
  PK4(p0, 0, pa0); PK4(p0, 8, pa1); PK4(p1, 0, pa2); PK4(p1, 8, pa3);
#undef PK4
}
template <int DQK, int NQR> __device__ __forceinline__ void qkt(f32x16& p0, f32x16& p1, const char* Ks, const int (&kb)[4], const bf16x8* qr, const char* qs, int r32, int hi) {
  p0 = f32x16{}; p1 = f32x16{};
  constexpr int ROWB = DQK * 2;
#pragma unroll
  for (int d0 = 0; d0 < DQK / 16; ++d0) {
    bf16x8 b0 = *reinterpret_cast<const bf16x8*>(Ks + kb[d0 & 3] + (d0 >> 2) * 128);
    bf16x8 b1 = *reinterpret_cast<const bf16x8*>(Ks + kb[d0 & 3] + (d0 >> 2) * 128 + 32 * ROWB);
    bf16x8 qf; if (d0 < NQR) qf = qr[d0]; else qf = *reinterpret_cast<const bf16x8*>(qs + ((d0 - NQR) * 2 + hi) * 512 + r32 * 16);
    p0 = __builtin_amdgcn_mfma_f32_32x32x16_bf16(b0, qf, p0, 0, 0, 0);
    p1 = __builtin_amdgcn_mfma_f32_32x32x16_bf16(b1, qf, p1, 0, 0, 0); }
}
template <int DQK, int NQR> __device__ __forceinline__ void qkt_acc(f32x16& p0, f32x16& p1, const char* Ks, const int (&kb)[4], const bf16x8* qr, int r32, int hi) {
  constexpr int ROWB = DQK * 2; (void)r32; (void)hi;
#pragma unroll
  for (int d0 = 0; d0 < DQK / 16; ++d0) {
    bf16x8 b0 = *reinterpret_cast<const bf16x8*>(Ks + kb[d0 & 3] + (d0 >> 2) * 128);
    bf16x8 b1 = *reinterpret_cast<const bf16x8*>(Ks + kb[d0 & 3] + (d0 >> 2) * 128 + 32 * ROWB);
    p0 = __builtin_amdgcn_mfma_f32_32x32x16_bf16(b0, qr[d0], p0, 0, 0, 0);
    p1 = __builtin_amdgcn_mfma_f32_32x32x16_bf16(b1, qr[d0], p1, 0, 0, 0); }
}
__device__ __forceinline__ int v_st(int k, int c) { const int kk = (k & ~0xC) | ((k & 4) << 1) | ((k & 8) >> 1); return ((kk >> 3) * 4 + (c >> 5)) * 512 + ((kk & 7) * 32 + (c & 31)) * 2; }
__device__ __forceinline__ int v_rd_base(int lane) { return ((lane & 3) << 3) | (((lane >> 2) & 3) << 6) | (((lane >> 4) & 1) << 5) | (((lane >> 5) & 1) << 8); }
constexpr int v_rd_off(int d0, int ks, int half) { return d0 * 512 + ks * 4096 + half * 2048; }
template <int OFF> __device__ __forceinline__ s16x4 tr_read(int vb) {
  s16x4 r; asm volatile("ds_read_b64_tr_b16 %0, %1 offset:%2" : "=&v"(r) : "v"(vb), "i"(OFF) : "memory"); return r;
}
template <int D0> __device__ __forceinline__ void pv_one(f32x16& od, int vb, bf16x8 pa0, bf16x8 pa1, bf16x8 pa2, bf16x8 pa3) {
  const s16x4 l0 = tr_read<v_rd_off(D0, 0, 0)>(vb), h0 = tr_read<v_rd_off(D0, 0, 1)>(vb), l1 = tr_read<v_rd_off(D0, 1, 0)>(vb), h1 = tr_read<v_rd_off(D0, 1, 1)>(vb);
  const s16x4 l2 = tr_read<v_rd_off(D0, 2, 0)>(vb), h2 = tr_read<v_rd_off(D0, 2, 1)>(vb), l3 = tr_read<v_rd_off(D0, 3, 0)>(vb), h3 = tr_read<v_rd_off(D0, 3, 1)>(vb);
  asm volatile("s_waitcnt lgkmcnt(0)" ::: "memory"); SBAR();
#define PK(L, H) (bf16x8){L[0], L[1], L[2], L[3], H[0], H[1], H[2], H[3]}
  od = __builtin_amdgcn_mfma_f32_32x32x16_bf16(pa0, PK(l0, h0), od, 0, 0, 0);
  od = __builtin_amdgcn_mfma_f32_32x32x16_bf16(pa1, PK(l1, h1), od, 0, 0, 0);
  od = __builtin_amdgcn_mfma_f32_32x32x16_bf16(pa2, PK(l2, h2), od, 0, 0, 0);
  od = __builtin_amdgcn_mfma_f32_32x32x16_bf16(pa3, PK(l3, h3), od, 0, 0, 0);
#undef PK
}
__device__ __forceinline__ void pv_d0(f32x16* o, int vb, bf16x8 pa0, bf16x8 pa1, bf16x8 pa2, bf16x8 pa3) {
  pv_one<0>(o[0], vb, pa0, pa1, pa2, pa3); pv_one<1>(o[1], vb, pa0, pa1, pa2, pa3); pv_one<2>(o[2], vb, pa0, pa1, pa2, pa3); pv_one<3>(o[3], vb, pa0, pa1, pa2, pa3);
}

struct MaskNone { __device__ __forceinline__ void apply(f32x16&, f32x16&, int, int) const {} __device__ __forceinline__ bool active(int, int) const { return true; } };
struct MaskA {
  int qoff, lo, hi_; float sl;
  __device__ __forceinline__ bool active(int t, int w) const { return 64 * t + 63 >= 32 * w && 64 * t <= 32 * w + 287; }
  __device__ __forceinline__ void apply(f32x16& p0, f32x16& p1, int kt, int hi) const {
    int base = qoff + 64 * kt + 4 * hi; asm volatile("" : "+v"(base));
    const float bf = (float)base, bm = bf - 0.5f * (float)(lo + hi_), hw = 0.5f * (float)(hi_ - lo);
#pragma unroll
    for (int r = 0; r < 16; ++r) { const float c0 = (float)((r & 3) + 8 * (r >> 2)), c1 = c0 + 32.f;
      const float v0 = __builtin_fmaf(-sl, __builtin_fabsf(bf + c0), p0[r]), v1 = __builtin_fmaf(-sl, __builtin_fabsf(bf + c1), p1[r]);
      p0[r] = __builtin_fabsf(bm + c0) <= hw ? v0 : -1e30f; p1[r] = __builtin_fabsf(bm + c1) <= hw ? v1 : -1e30f; }
  }
};
struct MaskB {
  int qr, qc, kr0, rs, cs; const float* tab;
  __device__ __forceinline__ bool active(int t, int) const { const int kr = kr0 + t; return __builtin_amdgcn_readfirstlane((int)(kr >= rs && kr <= rs + 7)) != 0; }
  __device__ __forceinline__ void apply(f32x16& p0, f32x16& p1, int kt, int hi) const {
    const int dr = kr0 + kt - qr + 7;
    int dbase = 4 * hi - qc + 15; asm volatile("" : "+v"(dbase));
    int cb = 4 * hi - cs; asm volatile("" : "+v"(cb));
    const float* tp = tab + dr * 31 + dbase;
    float t0[16], t1[16];
#pragma unroll
    for (int r = 0; r < 16; ++r) { const int c = (r & 3) + 8 * (r >> 2); t0[r] = tp[c]; t1[r] = tp[c + 32]; }
#pragma unroll
    for (int r = 0; r < 16; ++r) asm volatile("" : "+v"(t0[r]), "+v"(t1[r]));
#pragma unroll
    for (int r = 0; r < 16; ++r) { const int c = (r & 3) + 8 * (r >> 2);
      p0[r] = (unsigned)(cb + c) < 16u ? p0[r] + t0[r] : -1e30f; p1[r] = (unsigned)(cb + c + 32) < 16u ? p1[r] + t1[r] : -1e30f; }
  }
};

template <int DQK, class MK>
__device__ __forceinline__ void attn_unit(const bf16_t* __restrict__ Q, long q_row0, int ldq, const bf16_t* __restrict__ K, int ldk, const bf16_t* __restrict__ V, int ldv,
                                          long k_row0, long kmin, long kmax, int NT, bf16_t* __restrict__ O, int ldo, const float Cs, const float m0, const float l0, const MK& mk, char* lds) {
  int tid_o = threadIdx.x; asm volatile("" : "+v"(tid_o));
  const int tid = tid_o, wid = tid >> 6, lane = tid & 63, r32 = lane & 31, hi = lane >> 5;
  constexpr int ROWB = DQK * 2, SHM_K = 64 * ROWB, KN = DQK / 64, CPR = DQK / 8;
  char* V_lds = lds + L_V; char* K_lds = lds + L_K;
  float* ws = (float*)(lds + L_WS) + wid * 64; float* li_l = ws; float* al_l = ws + 32;
  const float thr_raw = THR / (Cs * 0.6931471805599453f);
  constexpr int NQR = DQK / 16;
  float m_reg = m0, l_reg = l0; f32x16 o[4] = {}; bf16x8 qr[NQR];
  char* qs = lds + L_QS + wid * 4096;
  const bf16_t* Qw = Q + (q_row0 + wid * QBLK + r32) * ldq + hi * 8;
#pragma unroll
  for (int d0 = 0; d0 < NQR; ++d0) qr[d0] = *reinterpret_cast<const bf16x8*>(Qw + d0 * 16);
  if constexpr (NQR < DQK / 16) {
#pragma unroll
    for (int d0 = NQR; d0 < DQK / 16; ++d0) *reinterpret_cast<bf16x8*>(qs + ((d0 - NQR) * 2 + hi) * 512 + r32 * 16) = *reinterpret_cast<const bf16x8*>(Qw + d0 * 16);
  }
  const int sr = tid >> 4, sc = (tid & 15) * 8, vst0 = v_st(sr, sc), vst1 = v_st(32 + sr, sc);
  const int voff0 = sr * ldv + sc, voff1 = (32 + sr) * ldv + sc;
  int koff[KN], kst[KN];
#pragma unroll
  for (int i = 0; i < KN; ++i) { const int id = tid + 512 * i, kr = id / CPR, kc = (id % CPR) * 8; koff[i] = kr * ldk + kc; kst[i] = kr * ROWB + ((kc * 2) ^ ((kr & 7) << 4)); }
  const int vb0 = (int)(uintptr_t)V_lds + v_rd_base(lane);
  int kb[4];
#pragma unroll
  for (int e = 0; e < 4; ++e) { kb[e] = r32 * ROWB + ((e * 32 + hi * 16) ^ ((r32 & 7) << 4)); asm volatile("" : "+v"(kb[e])); }
  bf16x8 vs0, vs1, ks[KN];
#define SLOAD(t) do { long _r0 = k_row0 + (long)(t) * KVBLK; _r0 = _r0 < kmin ? kmin : (_r0 > kmax - 63 ? kmax - 63 : _r0); \
    const bf16_t* _Vt = V + _r0 * ldv; const bf16_t* _Kt = K + _r0 * ldk; \
    vs0 = *reinterpret_cast<const bf16x8*>(_Vt + voff0); vs1 = *reinterpret_cast<const bf16x8*>(_Vt + voff1); \
    _Pragma("unroll") for (int _k = 0; _k < KN; ++_k) ks[_k] = *reinterpret_cast<const bf16x8*>(_Kt + koff[_k]); } while (0)
#define SWRITE(b) do { *(bf16x8*)(V_lds + (b) * SHM_V + vst0) = vs0; *(bf16x8*)(V_lds + (b) * SHM_V + vst1) = vs1; \
    _Pragma("unroll") for (int _k = 0; _k < KN; ++_k) *(bf16x8*)(K_lds + (b) * SHM_K + kst[_k]) = ks[_k]; } while (0)
  SLOAD(0); SWRITE(0); __syncthreads();
  for (int t = 0; t < NT; ++t) {
    const int cb = t & 1;
    if (t + 1 < NT) SLOAD(t + 1);
    if (mk.active(t, __builtin_amdgcn_readfirstlane(wid))) {
    f32x16 p0, p1;
    qkt<DQK, NQR>(p0, p1, K_lds + cb * SHM_K, kb, qr, qs, r32, hi);
    mk.apply(p0, p1, t, hi);
    float pmax = p0[0];
#pragma unroll
    for (int r = 1; r < 16; ++r) pmax = fmaxf(pmax, p0[r]);
#pragma unroll
    for (int r = 0; r < 16; ++r) pmax = fmaxf(pmax, p1[r]);
    { auto rr = __builtin_amdgcn_permlane32_swap(__float_as_uint(pmax), __float_as_uint(pmax), false, false);
      pmax = fmaxf(__uint_as_float(rr[0]), __uint_as_float(rr[1])); }
    if (!__all(pmax - m_reg <= thr_raw)) {
      const float mn = fmaxf(m_reg, pmax); const float alpha = __builtin_amdgcn_exp2f((m_reg - mn) * Cs); m_reg = mn; l_reg *= alpha;
      if (hi == 0) al_l[r32] = alpha; asm volatile("s_waitcnt lgkmcnt(0)" ::: "memory");
#pragma unroll
      for (int d = 0; d < 4; ++d)
#pragma unroll
        for (int r = 0; r < 16; ++r) o[d][r] *= al_l[crow(r, hi)];
    }
    const float mnC = -m_reg * Cs;
#pragma unroll
    for (int r = 0; r < 16; ++r) { p0[r] = __builtin_amdgcn_exp2f(fmaf(p0[r], Cs, mnC)); p1[r] = __builtin_amdgcn_exp2f(fmaf(p1[r], Cs, mnC)); }
    float ps = 0;
#pragma unroll
    for (int r = 0; r < 16; ++r) ps += p0[r] + p1[r];
    { auto rr = __builtin_amdgcn_permlane32_swap(__float_as_uint(ps), __float_as_uint(ps), false, false);
      ps = __uint_as_float(rr[0]) + __uint_as_float(rr[1]); }
    l_reg += ps;
    bf16x8 pa0, pa1, pa2, pa3;
#define PK4(P, BASE, OUT) do { unsigned a0 = cvtpk(P[BASE + 0], P[BASE + 1]), a1 = cvtpk(P[BASE + 2], P[BASE + 3]);   \
    unsigned b0 = cvtpk(P[BASE + 4], P[BASE + 5]), b1 = cvtpk(P[BASE + 6], P[BASE + 7]);                              \
    auto r0 = __builtin_amdgcn_permlane32_swap(a0, b0, false, false); auto r1 = __builtin_amdgcn_permlane32_swap(a1, b1, false, false); \
    u32x4 w = {r0[0], r1[0], r0[1], r1[1]}; OUT = *reinterpret_cast<bf16x8*>(&w); } while (0)
    PK4(p0, 0, pa0); PK4(p0, 8, pa1); PK4(p1, 0, pa2); PK4(p1, 8, pa3);
#undef PK4
    pv_d0(o, vb0 + cb * SHM_V, pa0, pa1, pa2, pa3);
    }
    if (t + 1 < NT) SWRITE(cb ^ 1);
    __syncthreads();
  }
  if (hi == 0) li_l[r32] = l_reg; asm volatile("s_waitcnt lgkmcnt(0)" ::: "memory");
  float rli[16];
#pragma unroll
  for (int r = 0; r < 16; ++r) rli[r] = __builtin_amdgcn_rcpf(li_l[crow(r, hi)]);
  char* ost = lds + wid * OST_WAVE;
  const bool odd = lane & 1;
#pragma unroll
  for (int d0 = 0; d0 < 4; ++d0)
#pragma unroll
    for (int r = 0; r < 16; r += 2) {
      const float a = o[d0][r] * rli[r], b = o[d0][r + 1] * rli[r + 1];
      const float snd = odd ? a : b; const float rcv = __builtin_bit_cast(float, __builtin_amdgcn_mov_dpp(__builtin_bit_cast(int, snd), 0xB1, 0xF, 0xF, true));
      const float wlo = odd ? rcv : a, whi = odd ? b : rcv;
      const unsigned w = cvtpk(wlo, whi);
      const int row = crow(r, hi) + (odd ? 1 : 0), col = d0 * 32 + (r32 & ~1);
      *(unsigned*)(ost + row * OST_PITCH + col * 2) = w; }
  asm volatile("s_waitcnt lgkmcnt(0)" ::: "memory");
  bf16_t* Ow = O + (q_row0 + wid * QBLK) * ldo;
#pragma unroll
  for (int it = 0; it < 8; ++it) { const int id = it * 64 + lane, row = id >> 4, c16 = id & 15;
    const u32x4 v = *(const u32x4*)(ost + row * OST_PITCH + c16 * 16);
    *(u32x4*)(Ow + (long)row * ldo + c16 * 8) = v; }
  __syncthreads();
#undef SLOAD
#undef SWRITE
}

__device__ __forceinline__ void glds16_asm(const void* gsrc, unsigned lds_dst) { unsigned keep;
  asm volatile("s_mov_b32 %0, m0\n\ts_mov_b32 m0, %2\n\ts_nop 0\n\tglobal_load_lds_dwordx4 %1, off\n\ts_mov_b32 m0, %0" : "=&s"(keep) : "v"(gsrc), "s"(lds_dst) : "memory"); }
template <int DQK, class MK>
__device__ __forceinline__ void attn_unit_dma(const bf16_t* __restrict__ Q, long q_row0, int ldq, const bf16_t* __restrict__ K, int ldk, const bf16_t* __restrict__ V, int ldv,
                                              long k_row0, long kmin, long kmax, int NT, bf16_t* __restrict__ O, int ldo, const float Cs, const float m0, const float l0, const MK& mk, char* lds, LAS unsigned char* ldsl) {
  int tid_o = threadIdx.x; asm volatile("" : "+v"(tid_o));
  const int tid = tid_o, wid = tid >> 6, lane = tid & 63, r32 = lane & 31, hi = lane >> 5;
  const int widu = __builtin_amdgcn_readfirstlane(wid);
  constexpr int ROWB = DQK * 2, SHM_K = 64 * ROWB, KN = SHM_K / 8192, CPR = DQK / 8;
  constexpr int D_V = 0, D_K = 3 * SHM_V, D_WS = 122880;
  static_assert(D_K + 3 * SHM_K <= D_WS, "rings fit");
  char* V_lds = lds + D_V; char* K_lds = lds + D_K; const unsigned lds0 = (unsigned)(uintptr_t)ldsl;
  float* ws = (float*)(lds + D_WS) + wid * 64; float* li_l = ws; float* al_l = ws + 32;
  const float thr_raw = THR / (Cs * 0.6931471805599453f);
  constexpr int NQR = DQK / 16;
  float m_reg = m0, l_reg = l0; f32x16 o[4] = {}; bf16x8 qr[NQR];
  int ksrc[KN], vsrc[2];
#pragma unroll
  for (int i = 0; i < KN; ++i) { const int c = (wid * KN + i) * 64 + lane, row = c / CPR, ccd = c % CPR, cc = (ccd & ~7) | ((ccd & 7) ^ (row & 7)); ksrc[i] = row * ldk + cc * 8; }
#pragma unroll
  for (int i = 0; i < 2; ++i) { const int ci = (wid * 2 + i) * 64 + lane, sub = ci >> 5, within = ci & 31, kk = (sub >> 2) * 8 + (within >> 2), k = (kk & ~0xC) | ((kk & 4) << 1) | ((kk & 8) >> 1), c = (sub & 3) * 32 + (within & 3) * 8;
    vsrc[i] = k * ldv + c; }
#define DMA(t, b) do { long _r0 = k_row0 + (long)(t) * KVBLK; _r0 = _r0 < kmin ? kmin : (_r0 > kmax - 63 ? kmax - 63 : _r0); \
    const bf16_t* _Vt = V + _r0 * ldv; const bf16_t* _Kt = K + _r0 * ldk; \
    _Pragma("unroll") for (int _k = 0; _k < KN; ++_k) glds16_asm(_Kt + ksrc[_k], (unsigned)__builtin_amdgcn_readfirstlane((int)(lds0 + D_K + (b) * SHM_K + (widu * KN + _k) * 1024))); \
    _Pragma("unroll") for (int _k = 0; _k < 2; ++_k) glds16_asm(_Vt + vsrc[_k], (unsigned)__builtin_amdgcn_readfirstlane((int)(lds0 + D_V + (b) * SHM_V + (widu * 2 + _k) * 1024))); } while (0)
  DMA(0, 0); DMA(1, 1);
  const bf16_t* Qw = Q + (q_row0 + wid * QBLK + r32) * ldq + hi * 8;
#pragma unroll
  for (int d0 = 0; d0 < NQR; ++d0) qr[d0] = *reinterpret_cast<const bf16x8*>(Qw + d0 * 16);
  const int vb0 = (int)(uintptr_t)V_lds + v_rd_base(lane);
  int kb[4];
#pragma unroll
  for (int e = 0; e < 4; ++e) { kb[e] = r32 * ROWB + ((e * 32 + hi * 16) ^ ((r32 & 7) << 4)); asm volatile("" : "+v"(kb[e])); }
#pragma unroll
  for (int d0 = 0; d0 < NQR; ++d0) asm volatile("" : "+v"(qr[d0]));
  asm volatile("s_waitcnt vmcnt(0) lgkmcnt(0)" ::: "memory"); __builtin_amdgcn_s_barrier(); asm volatile("" ::: "memory");
  if (widu >= 4) __builtin_amdgcn_s_setprio(1);
  int cb = 0;
  for (int t = 0; t < NT; ++t) {
    const bool more = t + 2 < NT; int nb = cb + 2; nb = nb >= 3 ? nb - 3 : nb;
    if (more) DMA(t + 2, nb);
    if (mk.active(t, widu)) {
    f32x16 p0, p1;
    qkt<DQK, NQR>(p0, p1, K_lds + cb * SHM_K, kb, qr, nullptr, r32, hi);
    mk.apply(p0, p1, t, hi);
    float pmax = p0[0];
#pragma unroll
    for (int r = 1; r < 16; ++r) pmax = fmaxf(pmax, p0[r]);
#pragma unroll
    for (int r = 0; r < 16; ++r) pmax = fmaxf(pmax, p1[r]);
    { auto rr = __builtin_amdgcn_permlane32_swap(__float_as_uint(pmax), __float_as_uint(pmax), false, false);
      pmax = fmaxf(__uint_as_float(rr[0]), __uint_as_float(rr[1])); }
    if (!__all(pmax - m_reg <= thr_raw)) {
      const float mn = fmaxf(m_reg, pmax); const float alpha = __builtin_amdgcn_exp2f((m_reg - mn) * Cs); m_reg = mn; l_reg *= alpha;
      if (hi == 0) al_l[r32] = alpha; asm volatile("s_waitcnt lgkmcnt(0)" ::: "memory");
#pragma unroll
      for (int d = 0; d < 4; ++d)
#pragma unroll
        for (int r = 0; r < 16; ++r) o[d][r] *= al_l[crow(r, hi)];
    }
    const float mnC = -m_reg * Cs;
#pragma unroll
    for (int r = 0; r < 16; ++r) { p0[r] = __builtin_amdgcn_exp2f(fmaf(p0[r], Cs, mnC)); p1[r] = __builtin_amdgcn_exp2f(fmaf(p1[r], Cs, mnC)); }
    float ps = 0;
#pragma unroll
    for (int r = 0; r < 16; ++r) ps += p0[r] + p1[r];
    { auto rr = __builtin_amdgcn_permlane32_swap(__float_as_uint(ps), __float_as_uint(ps), false, false);
      ps = __uint_as_float(rr[0]) + __uint_as_float(rr[1]); }
    l_reg += ps;
    bf16x8 pa0, pa1, pa2, pa3;
#define PK4(P, BASE, OUT) do { unsigned a0 = cvtpk(P[BASE + 0], P[BASE + 1]), a1 = cvtpk(P[BASE + 2], P[BASE + 3]);   \
    unsigned b0 = cvtpk(P[BASE + 4], P[BASE + 5]), b1 = cvtpk(P[BASE + 6], P[BASE + 7]);                              \
    auto r0 = __builtin_amdgcn_permlane32_swap(a0, b0, false, false); auto r1 = __builtin_amdgcn_permlane32_swap(a1, b1, false, false); \
    u32x4 w = {r0[0], r1[0], r0[1], r1[1]}; OUT = *reinterpret_cast<bf16x8*>(&w); } while (0)
    PK4(p0, 0, pa0); PK4(p0, 8, pa1); PK4(p1, 0, pa2); PK4(p1, 8, pa3);
#undef PK4
    pv_d0(o, vb0 + cb * SHM_V, pa0, pa1, pa2, pa3);
    }
    if (more) { if constexpr (KN == 3) asm volatile("s_waitcnt vmcnt(5)" ::: "memory"); else asm volatile("s_waitcnt vmcnt(4)" ::: "memory"); }
    else asm volatile("s_waitcnt vmcnt(0)" ::: "memory");
    asm volatile("s_waitcnt lgkmcnt(0)" ::: "memory"); __builtin_amdgcn_s_barrier(); asm volatile("" ::: "memory");
    cb = cb == 2 ? 0 : cb + 1;
  }
  __builtin_amdgcn_s_setprio(0);
  if (hi == 0) li_l[r32] = l_reg; asm volatile("s_waitcnt lgkmcnt(0)" ::: "memory");
  float rli[16];
#pragma unroll
  for (int r = 0; r < 16; ++r) rli[r] = __builtin_amdgcn_rcpf(li_l[crow(r, hi)]);
  char* ost = lds + wid * OST_WAVE;
  const bool odd = lane & 1;
#pragma unroll
  for (int d0 = 0; d0 < 4; ++d0)
#pragma unroll
    for (int r = 0; r < 16; r += 2) {
      const float a = o[d0][r] * rli[r], b = o[d0][r + 1] * rli[r + 1];
      const float snd = odd ? a : b; const float rcv = __builtin_bit_cast(float, __builtin_amdgcn_mov_dpp(__builtin_bit_cast(int, snd), 0xB1, 0xF, 0xF, true));
      const float wlo = odd ? rcv : a, whi = odd ? b : rcv;
      const unsigned w = cvtpk(wlo, whi);
      const int row = crow(r, hi) + (odd ? 1 : 0), col = d0 * 32 + (r32 & ~1);
      *(unsigned*)(ost + row * OST_PITCH + col * 2) = w; }
  asm volatile("s_waitcnt lgkmcnt(0)" ::: "memory");
  bf16_t* Ow = O + (q_row0 + wid * QBLK) * ldo;
#pragma unroll
  for (int it = 0; it < 8; ++it) { const int id = it * 64 + lane, row = id >> 4, c16 = id & 15;
    const u32x4 v = *(const u32x4*)(ost + row * OST_PITCH + c16 * 16);
    *(u32x4*)(Ow + (long)row * ldo + c16 * 8) = v; }
  asm volatile("s_waitcnt lgkmcnt(0)" ::: "memory"); __builtin_amdgcn_s_barrier(); asm volatile("" ::: "memory");
#undef DMA
}

typedef short v4i16_t __attribute__((ext_vector_type(4)));
typedef __bf16 bf16x2_t __attribute__((ext_vector_type(2)));
typedef float f32x2_t __attribute__((ext_vector_type(2)));
__device__ __forceinline__ unsigned cvtpk_v(float lo, float hi) { f32x2_t v = {lo, hi}; bf16x2_t b = __builtin_convertvector(v, bf16x2_t); return __builtin_bit_cast(unsigned, b); }
__device__ __forceinline__ s16x4 vtr(LAS const unsigned char* p) { return __builtin_bit_cast(s16x4, __builtin_amdgcn_ds_read_tr16_b64_v4i16((LAS v4i16_t*)p)); }
#define PINV(x) asm volatile("" : "+v"(x))
#define MX3(a, b, c) __builtin_fmaxf(__builtin_fmaxf((a), (b)), (c))
template <int DQK, class MK>
__device__ __forceinline__ void attn_unit_c(const bf16_t* __restrict__ Q, long q_row0, int ldq, const bf16_t* __restrict__ K, int ldk, const bf16_t* __restrict__ V, int ldv,
                                              long k_row0, long kmin, long kmax, int NT, bf16_t* __restrict__ O, int ldo, const float Cs, const float m0, const float l0, const MK& mk, char* lds, LAS unsigned char* ldsl) {
  int tid_o = threadIdx.x; asm volatile("" : "+v"(tid_o));
  const int tid = tid_o, wid = tid >> 6, lane = tid & 63, r32 = lane & 31, hi = lane >> 5;
  const int widu = __builtin_amdgcn_readfirstlane(wid);
  constexpr int ROWB = DQK * 2, SHM_K = 64 * ROWB, KN = SHM_K / 8192, CPR = DQK / 8;
  constexpr int D_V = 0, D_K = 3 * SHM_V, D_WS = 122880;
  static_assert(D_K + 3 * SHM_K <= D_WS, "rings fit"); static_assert(DQK == 192, "the gap schedule below is written for 12 Q fragments");
  char* K_lds = lds + D_K; const unsigned lds0 = (unsigned)(uintptr_t)ldsl;
  float* ws = (float*)(lds + D_WS) + wid * 64; float* li_l = ws; float* al_l = ws + 32;
  constexpr int NQR = DQK / 16;
  (void)m0; (void)l0; (void)Cs; (void)mk; float m_reg = 0.f, l_reg = 0.f; f32x16 o[4] = {}; f32x16 negm = {}; bf16x8 qr[NQR];
  const float thr2 = THR * 1.4426950408889634f;
  int ksrc[KN], vsrc[2];
#pragma unroll
  for (int i = 0; i < KN; ++i) { const int c = (wid * KN + i) * 64 + lane, row = c / CPR, ccd = c % CPR, cc = (ccd & ~7) | ((ccd & 7) ^ (row & 7)); ksrc[i] = row * ldk + cc * 8; }
#pragma unroll
  for (int i = 0; i < 2; ++i) { const int ci = (wid * 2 + i) * 64 + lane, sub = ci >> 5, within = ci & 31, kk = (sub >> 2) * 8 + (within >> 2), k = (kk & ~0xC) | ((kk & 4) << 1) | ((kk & 8) >> 1), c = (sub & 3) * 32 + (within & 3) * 8;
    vsrc[i] = k * ldv + c; }
#define DMA(t, b) do { long _r0 = k_row0 + (long)(t) * KVBLK; _r0 = _r0 < kmin ? kmin : (_r0 > kmax - 63 ? kmax - 63 : _r0); \
    const bf16_t* _Vt = V + _r0 * ldv; const bf16_t* _Kt = K + _r0 * ldk; \
    _Pragma("unroll") for (int _k = 0; _k < KN; ++_k) glds16_asm(_Kt + ksrc[_k], (unsigned)__builtin_amdgcn_readfirstlane((int)(lds0 + D_K + (b) * SHM_K + (widu * KN + _k) * 1024))); \
    _Pragma("unroll") for (int _k = 0; _k < 2; ++_k) glds16_asm(_Vt + vsrc[_k], (unsigned)__builtin_amdgcn_readfirstlane((int)(lds0 + D_V + (b) * SHM_V + (widu * 2 + _k) * 1024))); } while (0)
  DMA(0, 0); DMA(1, 1);
  const bf16_t* Qw = Q + (q_row0 + wid * QBLK + r32) * ldq + hi * 8;
#pragma unroll
  for (int d0 = 0; d0 < NQR; ++d0) qr[d0] = *reinterpret_cast<const bf16x8*>(Qw + d0 * 16);
  LAS const unsigned char* vp0 = ldsl + D_V + v_rd_base(lane);
  int kb[4];
#pragma unroll
  for (int e = 0; e < 4; ++e) { kb[e] = r32 * ROWB + ((e * 32 + hi * 16) ^ ((r32 & 7) << 4)); asm volatile("" : "+v"(kb[e])); }
#pragma unroll
  for (int d0 = 0; d0 < NQR; ++d0) asm volatile("" : "+v"(qr[d0]));
  asm volatile("s_waitcnt vmcnt(0) lgkmcnt(0)" ::: "memory"); __builtin_amdgcn_s_barrier(); asm volatile("" ::: "memory");
#define MF(a, b, c) __builtin_amdgcn_mfma_f32_32x32x16_bf16(a, b, c, 0, 0, 0)
#define KFR(i) (*reinterpret_cast<const bf16x8*>(Kc + kb[((i) % 12) & 3] + (((i) % 12) >> 2) * 128 + ((i) >= 12 ? 32 * ROWB : 0)))
#define KFRN(i) (*reinterpret_cast<const bf16x8*>(Kn + kb[(i) & 3]))
#define GQ(i, CH, CIN, FILL) do { if ((i) + 3 < 24) kf[((i) + 3) & 3] = KFR((i) + 3); CH = MF(kf[(i) & 3], qr[(i) % 12], CIN); FILL; SBAR(); } while (0)
#define VFR(s) (bf16x8){vl[s][0], vl[s][1], vl[s][2], vl[s][3], vh[s][0], vh[s][1], vh[s][2], vh[s][3]}
#define VRD(j) do { vl[(j) % 3] = vtr(vpc + v_rd_off((j) & 3, (j) >> 2, 0)); vh[(j) % 3] = vtr(vpc + v_rd_off((j) & 3, (j) >> 2, 1)); } while (0)
#define GP(j, PA, FILL) do { if ((j) + 2 < 16) VRD((j) + 2); o[(j) & 3] = MF(PA, VFR((j) % 3), o[(j) & 3]); FILL; SBAR(); } while (0)
#define EX2(x) __builtin_amdgcn_exp2f(x)
#define PREP(P, B, W) do { P[B] = EX2(P[B]); P[(B) + 1] = EX2(P[(B) + 1]); rs += P[B]; rs += P[(B) + 1]; W = cvtpk_v(P[B], P[(B) + 1]); PINV(rs); PINV(W); } while (0)
#define PKSW(OUT) do { auto r0_ = __builtin_amdgcn_permlane32_swap(wa0, wb0, false, false); auto r1_ = __builtin_amdgcn_permlane32_swap(wa1, wb1, false, false); \
    u32x4 w_ = {r0_[0], r1_[0], r0_[1], r1_[1]}; OUT = *reinterpret_cast<bf16x8*>(&w_); PINV(OUT); } while (0)
  if (widu >= 4) __builtin_amdgcn_s_setprio(1);
  int cb = 0;
  bf16x8 kf[4];
  { const char* Kc = K_lds; kf[0] = KFR(0); kf[1] = KFR(1); kf[2] = KFR(2); }
  for (int t = 0; t < NT; ++t) {
    const bool more = t + 2 < NT; int nb = cb + 2; nb = nb >= 3 ? nb - 3 : nb; int n1 = cb + 1; n1 = n1 >= 3 ? n1 - 3 : n1;
    if (more) DMA(t + 2, nb);
    const char* Kc = K_lds + cb * SHM_K; const char* Kn = K_lds + n1 * SHM_K; LAS const unsigned char* vpc = vp0 + cb * SHM_V;
    f32x16 p0, p1; s16x4 vl[3], vh[3]; float mx;
    SBAR();
    GQ(0, p0, negm, ); GQ(1, p0, p0, ); GQ(2, p0, p0, ); GQ(3, p0, p0, ); GQ(4, p0, p0, ); GQ(5, p0, p0, );
    GQ(6, p0, p0, ); GQ(7, p0, p0, ); GQ(8, p0, p0, ); GQ(9, p0, p0, ); GQ(10, p0, p0, ); GQ(11, p0, p0, );
    GQ(12, p1, negm, );
    GQ(13, p1, p1, mx = MX3(p0[0], p0[1], p0[2]); PINV(mx));
    GQ(14, p1, p1, mx = MX3(mx, p0[3], p0[4]); PINV(mx));   GQ(15, p1, p1, mx = MX3(mx, p0[5], p0[6]); PINV(mx));
    GQ(16, p1, p1, mx = MX3(mx, p0[7], p0[8]); PINV(mx));   GQ(17, p1, p1, mx = MX3(mx, p0[9], p0[10]); PINV(mx));
    GQ(18, p1, p1, mx = MX3(mx, p0[11], p0[12]); PINV(mx)); GQ(19, p1, p1, mx = MX3(mx, p0[13], p0[14]); PINV(mx));
    GQ(20, p1, p1, mx = __builtin_fmaxf(mx, p0[15]); PINV(mx));
    GQ(21, p1, p1, ); GQ(22, p1, p1, );
    GQ(23, p1, p1, VRD(0); VRD(1));
    float pmax = MX3(mx, p1[0], p1[1]);
#pragma unroll
    for (int r = 2; r < 16; r += 2) pmax = MX3(pmax, p1[r], p1[r + 1]);
    { auto rr = __builtin_amdgcn_permlane32_swap(__float_as_uint(pmax), __float_as_uint(pmax), false, false);
      pmax = fmaxf(__uint_as_float(rr[0]), __uint_as_float(rr[1])); }
    const bool first = (t == 0);
    if (first || !__all(pmax <= thr2)) {
      const float d = first ? pmax : fmaxf(pmax, 0.f); const float alpha = first ? 1.f : __builtin_amdgcn_exp2f(-d); m_reg += d; l_reg *= alpha;
      if (hi == 0) al_l[r32] = alpha; asm volatile("s_waitcnt lgkmcnt(0)" ::: "memory");
#pragma unroll
      for (int r = 0; r < 16; ++r) { const float a = al_l[crow(r, hi)]; o[0][r] *= a; o[1][r] *= a; o[2][r] *= a; o[3][r] *= a; p0[r] -= d; p1[r] -= d; }
#pragma unroll
      for (int r = 0; r < 16; ++r) negm[r] = -m_reg;
    }
    SBAR();
    float rs = 0.f; unsigned wa0, wa1, wb0, wb1; bf16x8 pa0, pa1, pa2, pa3;
    PREP(p0, 0, wa0); PREP(p0, 2, wa1); PREP(p0, 4, wb0); PREP(p0, 6, wb1); PKSW(pa0); SBAR();
    GP(0, pa0, PREP(p0, 8, wa0));   GP(1, pa0, PREP(p0, 10, wa1)); GP(2, pa0, PREP(p0, 12, wb0));  GP(3, pa0, PREP(p0, 14, wb1); PKSW(pa1));
    GP(4, pa1, PREP(p1, 0, wa0));   GP(5, pa1, PREP(p1, 2, wa1));  GP(6, pa1, PREP(p1, 4, wb0));   GP(7, pa1, PREP(p1, 6, wb1); PKSW(pa2));
    GP(8, pa2, PREP(p1, 8, wa0));   GP(9, pa2, PREP(p1, 10, wa1)); GP(10, pa2, PREP(p1, 12, wb0)); GP(11, pa2, PREP(p1, 14, wb1); PKSW(pa3));
    GP(12, pa3, kf[0] = KFRN(0)); GP(13, pa3, kf[1] = KFRN(1)); GP(14, pa3, kf[2] = KFRN(2)); GP(15, pa3, );
    l_reg += rs;
    if (more) asm volatile("s_waitcnt vmcnt(2)" ::: "memory"); else asm volatile("s_waitcnt vmcnt(0)" ::: "memory");
    asm volatile("s_waitcnt lgkmcnt(0)" ::: "memory"); __builtin_amdgcn_s_barrier(); asm volatile("" ::: "memory");
    cb = cb == 2 ? 0 : cb + 1;
  }
  __builtin_amdgcn_s_setprio(0);
#undef MF
#undef KFR
#undef KFRN
#undef GQ
#undef VFR
#undef VRD
#undef GP
#undef EX2
#undef PREP
#undef PKSW
#undef DMA
  { auto rr = __builtin_amdgcn_permlane32_swap(__float_as_uint(l_reg), __float_as_uint(l_reg), false, false); l_reg = __uint_as_float(rr[0]) + __uint_as_float(rr[1]); }
  if (hi == 0) li_l[r32] = l_reg; asm volatile("s_waitcnt lgkmcnt(0)" ::: "memory");
  float rli[16];
#pragma unroll
  for (int r = 0; r < 16; ++r) rli[r] = __builtin_amdgcn_rcpf(li_l[crow(r, hi)]);
  char* ost = lds + wid * OST_WAVE;
  const bool odd = lane & 1;
#pragma unroll
  for (int d0 = 0; d0 < 4; ++d0)
#pragma unroll
    for (int r = 0; r < 16; r += 2) {
      const float a = o[d0][r] * rli[r], b = o[d0][r + 1] * rli[r + 1];
      const float snd = odd ? a : b; const float rcv = __builtin_bit_cast(float, __builtin_amdgcn_mov_dpp(__builtin_bit_cast(int, snd), 0xB1, 0xF, 0xF, true));
      const float wlo = odd ? rcv : a, whi = odd ? b : rcv;
      const unsigned w = cvtpk(wlo, whi);
      const int row = crow(r, hi) + (odd ? 1 : 0), col = d0 * 32 + (r32 & ~1);
      *(unsigned*)(ost + row * OST_PITCH + col * 2) = w; }
  asm volatile("s_waitcnt lgkmcnt(0)" ::: "memory");
  bf16_t* Ow = O + (q_row0 + wid * QBLK) * ldo;
#pragma unroll
  for (int it = 0; it < 8; ++it) { const int id = it * 64 + lane, row = id >> 4, c16 = id & 15;
    const u32x4 v = *(const u32x4*)(ost + row * OST_PITCH + c16 * 16);
    *(u32x4*)(Ow + (long)row * ldo + c16 * 8) = v; }
  asm volatile("s_waitcnt lgkmcnt(0)" ::: "memory"); __builtin_amdgcn_s_barrier(); asm volatile("" ::: "memory");
}
}

#define XB_TMO      128
#define XB_XCNT(j)  (256  + 64 * (j))
#define XB_XSUB(j)  (1280 + 64 * (j))
#define XB_XGEN(j)  (2304 + 64 * (j))
#define XB_TOP      3328
#define XB_TOPGEN   3392
#define XCD_BAR_WORDS 3456
#define XB_SPIN_CAP (1u << 18)

__device__ __forceinline__ unsigned xb_ld(unsigned* p)              { return __hip_atomic_load(p, __ATOMIC_RELAXED, __HIP_MEMORY_SCOPE_AGENT); }
__device__ __forceinline__ unsigned xb_add(unsigned* p, unsigned v) { return __hip_atomic_fetch_add(p, v, __ATOMIC_RELAXED, __HIP_MEMORY_SCOPE_AGENT); }
__device__ __forceinline__ unsigned xb_xcc_id() { return (unsigned)__builtin_amdgcn_s_getreg((3 << 11) | 20) & 0xFu; }
#define XB_SPIN(cond, bar) do { unsigned _sp = 0; while (cond) { __builtin_amdgcn_s_sleep(1); \
    if ((++_sp & 255u) == 0u) { if (xb_ld(&(bar)[XB_TMO])) break; if (_sp > XB_SPIN_CAP) { atomicAdd(&(bar)[XB_TMO], 1u); break; } } } } while (0)

struct XcdBarrier {
    unsigned* bar; unsigned x;
    volatile LAS unsigned* st;
};
__device__ __forceinline__ XcdBarrier xcd_barrier_post(unsigned* bar, volatile LAS unsigned* st) {
    XcdBarrier b; b.bar = bar; b.x = xb_xcc_id(); b.st = st;
    if (threadIdx.x == 0) (void)xb_add(&bar[XB_XCNT(b.x)], 1u);
    return b;
}
__device__ __forceinline__ void xcd_barrier_complete(unsigned* bar, unsigned x, unsigned& nloc, unsigned& nx) {
    const unsigned G = gridDim.x * gridDim.y * gridDim.z;
    unsigned sum, cnt, mine, sp = 0u;
    for (;;) {
        sum = 0u; cnt = 0u; mine = 0u;
#pragma unroll
        for (unsigned j = 0; j < 16; ++j) { const unsigned c = xb_ld(&bar[XB_XCNT(j)]); sum += c; cnt += (c > 0u) ? 1u : 0u; mine = (j == x) ? c : mine; }
        if (sum == G) break;
        __builtin_amdgcn_s_sleep(1);
        if ((++sp & 255u) == 0u) { if (xb_ld(&bar[XB_TMO])) break; if (sp > XB_SPIN_CAP) { atomicAdd(&bar[XB_TMO], 1u); break; } }
    }
    nloc = mine > 0u ? mine : 1u; nx = cnt > 0u ? cnt : 1u;
}
__device__ __forceinline__ void xcd_barrier(const XcdBarrier& b) {
    asm volatile("s_waitcnt vmcnt(0)" ::: "memory");
    __syncthreads();
    if (threadIdx.x == 0) {
        unsigned* bar = b.bar;
        __builtin_amdgcn_s_waitcnt(0);
        unsigned nloc = b.st[0], nx = b.st[1];
        if (nloc == 0u) { xcd_barrier_complete(bar, b.x, nloc, nx); b.st[0] = nloc; b.st[1] = nx; }
        const unsigned old = xb_add(&bar[XB_XSUB(b.x)], 1u);
        const unsigned gen = old / nloc;
        if (old + 1u == (gen + 1u) * nloc) {
            __builtin_amdgcn_fence(__ATOMIC_RELEASE, "agent");
            asm volatile("s_waitcnt vmcnt(0)" ::: "memory");
            const unsigned og = xb_add(&bar[XB_TOP], 1u);
            const unsigned tg = og / nx;
            if (og + 1u == (tg + 1u) * nx) xb_add(&bar[XB_TOPGEN], 1u);
            else XB_SPIN(xb_ld(&bar[XB_TOPGEN]) == tg, bar);
            __builtin_amdgcn_fence(__ATOMIC_ACQUIRE, "agent");
            xb_add(&bar[XB_XGEN(b.x)], 1u);
            asm volatile("s_waitcnt vmcnt(0)" ::: "memory");
        } else {
            XB_SPIN(xb_ld(&bar[XB_XGEN(b.x)]) == gen, bar);
            __builtin_amdgcn_fence(__ATOMIC_ACQUIRE, "agent");
            asm volatile("s_waitcnt vmcnt(0)" ::: "memory");
        }
    }
    __syncthreads();
}

#ifndef WGM_G7
#define WGM_G7 4
#endif
constexpr int NWAVES = 8;
constexpr int N_PHASES = 20;
struct Args { const float* in[22]; float* out; unsigned char* ws; float inv[32]; int ph_lo, ph_hi, use_bar, pad; };

typedef float f32x4 __attribute__((ext_vector_type(4)));
typedef unsigned u32x4v __attribute__((ext_vector_type(4)));
typedef unsigned u32x2v __attribute__((ext_vector_type(2)));

template <bool HASG> __device__ __forceinline__ void transpose_item(const float* W, const float* gain, int K, int Nsrc, int k0, int srccol_lane, bf16_t* WTrow0, LAS float* scr, int lane) {
    const int c = lane & 7;
    f32x4 g0 = {1.f, 1.f, 1.f, 1.f}, g1 = {1.f, 1.f, 1.f, 1.f};
    if constexpr (HASG) { g0 = *(const f32x4*)(gain + k0 + 8 * c); g1 = *(const f32x4*)(gain + k0 + 8 * c + 4); }
#pragma unroll 8
    for (int i = 0; i < 32; ++i) { const int kk = 2 * i + (lane >> 5); scr[kk * 33 + (lane & 31)] = W[(size_t)(k0 + kk) * Nsrc + srccol_lane]; }
    asm volatile("s_waitcnt lgkmcnt(0)" ::: "memory");
#pragma unroll
    for (int j = 0; j < 4; ++j) { const int n = (lane >> 3) + 8 * j; const LAS float* s = scr + (8 * c) * 33 + n;
        u32x4v o; o.x = cvt_pk_bf16(s[0 * 33] * g0[0], s[1 * 33] * g0[1]); o.y = cvt_pk_bf16(s[2 * 33] * g0[2], s[3 * 33] * g0[3]); o.z = cvt_pk_bf16(s[4 * 33] * g1[0], s[5 * 33] * g1[1]); o.w = cvt_pk_bf16(s[6 * 33] * g1[2], s[7 * 33] * g1[3]);
        *(u32x4v*)(WTrow0 + (size_t)n * K + k0 + 8 * c) = o; }
    asm volatile("s_waitcnt lgkmcnt(0)" ::: "memory");
}
template <int MAP, bool HASG> __device__ __forceinline__ bool tr_job(int& r, const float* W, const float* W2, const float* gain, int K, int Nsrc, int ndst, bf16_t* WT, LAS float* scr, int lane) {
    const int nblk = ndst / 32, items = (K / 64) * nblk;
    if (r >= items) { r -= items; return false; }
    const int kb = r / nblk, nb = r % nblk, n0 = nb * 32, nl = n0 + (lane & 31);
    int sc = nl; const float* Ws = W;
    if (MAP == 1) { const int h = nl / CQK, hc = nl % CQK; if (hc >= 128) { const int p = hc - 128, i = p >> 1; sc = h * CQK + 128 + ((p & 1) ? i + 32 : i); } }
    if (MAP == 2) { const int pn = nl >> 8, rr = nl & 255; sc = pn * 128 + (rr & 127); if (rr >= 128) Ws = W2; }
    if (MAP == 3) { if (nl >= OFF_CKR) { const int p = nl - OFF_CKR, i = p >> 1; sc = OFF_CKR + ((p & 1) ? i + 32 : i); } }
    transpose_item<HASG>(Ws, gain, K, Nsrc, kb * 64, sc, WT + (size_t)n0 * K, scr, lane);
    return true;
}

template <bool RAW> __device__ __forceinline__ void row_to_bf16(const float* xrow, bf16_t* orow, float* ssq_row, int lane) {
    const f32x4* xr = (const f32x4*)xrow + lane; f32x4 v[16]; float s = 0.f;
#pragma unroll
    for (int j = 0; j < 16; ++j) { v[j] = xr[64 * j]; s += (v[j].x * v[j].x + v[j].y * v[j].y) + (v[j].z * v[j].z + v[j].w * v[j].w); }
    float sc = 1.f;
    if (RAW) ssq_row[lane] = s; else sc = rsqrtf(wave_sum(s) * (1.f / DM) + NORM_EPS);
    u32x2v* o8 = (u32x2v*)orow + lane;
#pragma unroll
    for (int j = 0; j < 16; ++j) { u32x2v w; w.x = cvt_pk_bf16(v[j].x * sc, v[j].y * sc); w.y = cvt_pk_bf16(v[j].z * sc, v[j].w * sc); o8[64 * j] = w; }
}
__device__ __forceinline__ void rms_row_4096_bf(const bf16_t* xrow, const float* g, float* orow, int lane) {
    const u32x4v* xr = (const u32x4v*)xrow + lane; float v[8][8]; float s = 0.f;
#pragma unroll
    for (int j = 0; j < 8; ++j) { const u32x4v w = xr[64 * j];
#pragma unroll
        for (int e = 0; e < 4; ++e) { v[j][2 * e] = __uint_as_float(w[e] << 16); v[j][2 * e + 1] = __uint_as_float(w[e] & 0xffff0000u); s += v[j][2 * e] * v[j][2 * e] + v[j][2 * e + 1] * v[j][2 * e + 1]; } }
    const float rstd = rsqrtf(wave_sum(s) * (1.f / DM) + NORM_EPS);
#pragma unroll
    for (int j = 0; j < 8; ++j) { const int c0 = (64 * j + lane) * 8; const f32x4 g0 = *(const f32x4*)(g + c0), g1 = *(const f32x4*)(g + c0 + 4);
        f32x4 o0, o1;
#pragma unroll
        for (int e = 0; e < 4; ++e) { o0[e] = v[j][e] * rstd * g0[e]; o1[e] = v[j][4 + e] * rstd * g1[e]; }
        *(f32x4*)(orow + c0) = o0; *(f32x4*)(orow + c0 + 4) = o1; }
}

template <class Sched> __device__ __forceinline__ void build_rstd_table(const Sched& S, const float* ssq, int row0, LAS float* tab) {
    int tid = threadIdx.x; asm volatile("" : "+v"(tid)); const int lane = tid & 63, wave = tid >> 6, sub = lane >> 4, piece = lane & 15;
    int lo = 1 << 30, hi = -1; { pg8::Unit u; for (int i = 0; S.next(i, u); ++i) { lo = u.pm < lo ? u.pm : lo; hi = u.pm > hi ? u.pm : hi; } }
    for (int pm = lo; pm <= hi; ++pm) {
#pragma unroll
        for (int j = 0; j < 8; ++j) { const int r = pm * pg8::BM + wave * 32 + j * 4 + sub;
            const f32x4 a = *(const f32x4*)(ssq + (size_t)r * 64 + piece * 4);
            float t = (a[0] + a[1]) + (a[2] + a[3]); t += __shfl_xor(t, 1); t += __shfl_xor(t, 2); t += __shfl_xor(t, 4); t += __shfl_xor(t, 8);
            if (piece == 0) tab[r - row0] = rsqrtf(t * (1.f / DM) + NORM_EPS); } }
    __syncthreads();
}

__global__ void __launch_bounds__(NWAVES * 64, 2) fwd_kernel(Args args) {
    extern __shared__ __attribute__((aligned(16))) unsigned char lds[];
    LAS unsigned char* ldsl = (LAS unsigned char*)lds;
    volatile LAS unsigned* MISC = (volatile LAS unsigned*)(ldsl + MISC_OFF);
    const int G = gridDim.x, bid = blockIdx.x;
#define PH_TID() int tid = threadIdx.x; asm volatile("" : "+v"(tid)); const int lane = tid & 63, wave = __builtin_amdgcn_readfirstlane(tid >> 6); const int gw = bid * NWAVES + wave, NGW = G * NWAVES; (void)lane; (void)gw; (void)NGW
    unsigned char* ws = args.ws;
    gu32* ctl = (gu32*)(ws + WS_CTL);
    for (int u = threadIdx.x; u < (LDS_BYTES - LDSCTL_OFF) / 4; u += NWAVES * 64) ((LAS unsigned*)(ldsl + LDSCTL_OFF))[u] = 0u;
    __syncthreads();
    XcdBarrier bar; bar.bar = (unsigned*)ctl + CW_BAR; bar.x = 0; bar.st = nullptr;
    if (args.use_bar) bar = xcd_barrier_post((unsigned*)ctl + CW_BAR, MISC + 8);
#ifndef BARX
#define BARX 0
#endif
#define GRID_BAR() do { if (args.use_bar) { xcd_barrier(bar); if (BARX) xcd_barrier(bar); } } while (0)
    const int lo = args.ph_lo, hi = args.ph_hi;
#ifndef PHM
#define PHM 0xFFFFFFFFu
#endif
#define IN(k) (lo <= (k) && (k) < hi)
#define PH(j) ((PHM >> (j)) & 1)
#ifndef REPM
#define REPM 0u
#endif
#define NREP(j) (1 + (int)((REPM >> (j)) & 1u))
#define REPLOOP(j) _Pragma("unroll") for (int rep = 0; rep < NREP(j); ++rep)
#define BOTH(k) (IN(k) && IN((k) + 1))

    float* cosT = (float*)(ws + WS_COS); float* sinT = (float*)(ws + WS_SIN);
    bf16_t* MEMN = (bf16_t*)(ws + WS_MEMN); bf16_t* MEMKV = (bf16_t*)(ws + WS_MEMKV);
    bf16_t* XQ = (bf16_t*)(ws + WS_XQ); bf16_t* XO = (bf16_t*)(ws + WS_XO);
    bf16_t* XB = (bf16_t*)(ws + WS_H); bf16_t* PROJ = (bf16_t*)(ws + WS_PROJ);
    bf16_t* QC = (bf16_t*)(ws + WS_QC); bf16_t* KC = (bf16_t*)(ws + WS_KC); bf16_t* VC = (bf16_t*)(ws + WS_VC);
    bf16_t* MIX = (bf16_t*)(ws + WS_MIX); bf16_t* ACT = (bf16_t*)(ws + WS_ACT);
    float* SSQ = (float*)(ws + WS_SSQ); float* SSQ2 = (float*)(ws + WS_SSQ2); float* CKRS = (float*)(ws + WS_CKR);

#ifndef NPASS
#define NPASS 1
#endif
    for (int pass = 0; pass < NPASS; ++pass) {
    if (PH(13) && IN(0)) { PH_TID(); REPLOOP(13) {
        LAS float* scr = (LAS float*)(ldsl + wave * 16384);
        constexpr int I_IN = (DM / 64) * (D_IN / 32), I_QB = (QRANK / 64) * (QCW / 32), I_KVB = (KVRANK / 64) * (KVW / 32), I_OUT = (DM / 64) * (DM / 32), I_XQ = (DM / 64) * (XD / 32),
                      I_XO = (XD / 64) * (DM / 32), I_GU = (DM / 64) * (GUW / 32), I_DOWN = (DFF / 64) * (DM / 32);
        constexpr int I_LAYER = I_IN + I_QB + I_KVB + I_OUT + 3 * I_XQ + I_XO + I_GU + I_DOWN;
        for (int it = gw; it < DEPTH * I_LAYER; it += NGW) {
            const int l = it / I_LAYER; int r = it % I_LAYER;
            unsigned char* wl = ws + WS_W + (size_t)l * W_LAYER;
            if (tr_job<3, true>(r, args.in[3] + (size_t)l * DM * D_IN, nullptr, args.in[2] + (size_t)l * DM, DM, D_IN, D_IN, (bf16_t*)(wl + WO_IN), scr, lane)) continue;
            if (tr_job<1, true>(r, args.in[7] + (size_t)l * QRANK * QCW, nullptr, args.in[6] + (size_t)l * QRANK, QRANK, QCW, QCW, (bf16_t*)(wl + WO_QB), scr, lane)) continue;
            if (tr_job<0, true>(r, args.in[9] + (size_t)l * KVRANK * KVW, nullptr, args.in[8] + (size_t)l * KVRANK, KVRANK, KVW, KVW, (bf16_t*)(wl + WO_KVB), scr, lane)) continue;
            if (tr_job<0, false>(r, args.in[10] + (size_t)l * DM * DM, nullptr, nullptr, DM, DM, DM, (bf16_t*)(wl + WO_OUT), scr, lane)) continue;
            if (tr_job<0, true>(r, args.in[13] + (size_t)l * DM * XD, nullptr, args.in[11] + (size_t)l * DM, DM, XD, XD, (bf16_t*)(wl + WO_XQ), scr, lane)) continue;
            if (tr_job<0, true>(r, args.in[14] + (size_t)l * DM * XD, nullptr, args.in[12] + (size_t)l * DM, DM, XD, XD, (bf16_t*)(wl + WO_XKV), scr, lane)) continue;
            if (tr_job<0, true>(r, args.in[15] + (size_t)l * DM * XD, nullptr, args.in[12] + (size_t)l * DM, DM, XD, XD, (bf16_t*)(wl + WO_XKV) + (size_t)XD * DM, scr, lane)) continue;
            if (tr_job<0, false>(r, args.in[16] + (size_t)l * XD * DM, nullptr, nullptr, XD, DM, DM, (bf16_t*)(wl + WO_XO), scr, lane)) continue;
            if (tr_job<2, true>(r, args.in[18] + (size_t)l * DM * DFF, args.in[19] + (size_t)l * DM * DFF, args.in[17] + (size_t)l * DM, DM, DFF, GUW, (bf16_t*)(wl + WO_GU), scr, lane)) continue;
            tr_job<0, false>(r, args.in[20] + (size_t)l * DFF * DM, nullptr, nullptr, DFF, DM, DM, (bf16_t*)(wl + WO_DOWN), scr, lane);
        }
        for (int e = bid * 512 + tid; e < SEQ * 32; e += G * 512) { const int pos = e >> 5, i = e & 31; const float ang = (float)pos * args.inv[i];
            double rev = (double)ang * 0.15915494309189533577; rev -= __builtin_rint(rev); const float rf = (float)rev;
            cosT[e] = __builtin_amdgcn_cosf(rf); sinT[e] = __builtin_amdgcn_sinf(rf); }
        for (int m = gw; m < MTOK + MEMROWS; m += NGW) {
            if (m < MTOK) row_to_bf16<true>(args.in[0] + (size_t)m * DM, XB + (size_t)m * DM, SSQ + (size_t)m * 64, lane);
            else row_to_bf16<false>(args.in[1] + (size_t)(m - MTOK) * DM, MEMN + (size_t)(m - MTOK) * DM, nullptr, lane);
        }
            }
        if (BOTH(0)) GRID_BAR();
    }

    for (int l = 0; l < DEPTH; ++l) {
        const int pb = 1 + 9 * l;
        unsigned char* wl = ws + WS_W + (size_t)l * W_LAYER;

        if (PH(1) && IN(pb + 0)) { REPLOOP(1) {
            LAS float* tab = (LAS float*)(ldsl + RSTD_OFF); const int trow0 = (bid & 7) * 2048;
            { pg8::Gemm g{XB, (const bf16_t*)(wl + WO_IN), MTOK, OFF_CKR, DM, DM, DM, OFF_CKR / 256, 0u}; pg8::StaticOrder S; S.init(MTOK, OFF_CKR, G, bid); build_rstd_table(S, SSQ, trow0, tab);
              pg8::EpiG1 E{PROJ, tab, trow0, SSQ2};
              pg8::gemm_phase<pg8::EpiG1, pg8::StaticOrder, true, true>(ldsl, g, S, E); }
            { pg8::Gemm g{XB, (const bf16_t*)(wl + WO_IN) + (size_t)OFF_CKR * DM, MTOK, 4 * 256, DM / 4, DM, DM, 1, (unsigned)(DM / 4 * 2)}; pg8::StaticOrder S; S.init(MTOK, 4 * 256, G, bid);
              pg8::EpiCkr E{CKRS};
              pg8::gemm_phase<pg8::EpiCkr, pg8::StaticOrder, true, true>(ldsl, g, S, E); }
            }
            if (BOTH(pb + 0)) GRID_BAR();
        }
        if (PH(3) && IN(pb + 1)) { REPLOOP(3) {
            { PH_TID();
              for (int m = gw; m < MTOK; m += NGW) {
                  const float rstd = rsqrtf(wave_sum(SSQ[(size_t)m * 64 + lane]) * (1.f / DM) + NORM_EPS);
                  const float* p = CKRS + (size_t)m * 64 + lane; const float v = ((p[0] + p[(size_t)MTOK * 64]) + (p[(size_t)2 * MTOK * 64] + p[(size_t)3 * MTOK * 64])) * rstd;
                  const float o = __shfl_xor(v, 1); const int pos = m & (SEQ - 1), i = lane >> 1; const float c = cosT[pos * 32 + i], sn = sinT[pos * 32 + i];
                  const float r = (lane & 1) ? (o * sn + v * c) : (v * c - o * sn);
                  const unsigned short w = (unsigned short)(cvt_pk_bf16(r, r) & 0xffffu); bf16_t* dst = KC + (size_t)m * QCW + 128 + lane;
#pragma unroll
                  for (int h = 0; h < CH; ++h) dst[h * CQK] = w; } }
            { pg8::Gemm g{PROJ + OFF_CQ, (const bf16_t*)(wl + WO_QB), MTOK, QCW, QRANK, D_INP, QRANK, (QCW) / 256, 0u}; pg8::StaticOrder S; S.init(MTOK, QCW, G, bid);
              pg8::EpiQRope E{QC, cosT, sinT, SSQ2};
              pg8::gemm_phase<pg8::EpiQRope, pg8::StaticOrder, true, true>(ldsl, g, S, E); }
            { pg8::Gemm g{PROJ + OFF_CKV, (const bf16_t*)(wl + WO_KVB), MTOK, KVW, KVRANK, D_INP, KVRANK, (KVW) / 256, 0u}; pg8::StaticOrder S; S.init(MTOK, KVW, G, bid);
              pg8::EpiKV E{KC, VC, SSQ2};
              pg8::gemm_phase<pg8::EpiKV, pg8::StaticOrder, true, true>(ldsl, g, S, E); }
            }
            if (BOTH(pb + 1)) GRID_BAR();
        }
        if (PH(4) && IN(pb + 2)) { PH_TID(); REPLOOP(4) {
#ifndef REPS
#define REPS 7
#endif
            if (PH(16) && (rep == NREP(4) - 1 || (REPS & 1))) for (int u = bid; u < BATCH * CH * 32; u += G) {
                const int x = u & 7, qb = (u >> 3) & 31, bh = (u >> 8) * 8 + x, b = bh / CH, h = bh % CH;
                att::MaskNone mk;
                att::attn_unit_c<192, att::MaskNone>(QC + h * CQK, (long)b * SEQ + qb * 256, QCW, KC + h * CQK, QCW, VC + h * 128, VCW, (long)b * SEQ, (long)b * SEQ, (long)b * SEQ + SEQ - 1, SEQ / 64,
                                                   MIX + MIX_C + h * 128, DM, 0.07216878364870322f * 1.4426950408889634f, -1e5f, 0.f, mk, (char*)lds, ldsl);
            }
            if (PH(17) && (rep == NREP(4) - 1 || (REPS & 2))) for (int u = bid; u < BATCH * AH * 32; u += G) {
                const int x = u & 7, qb = (u >> 3) & 31, bh = (u >> 8) * 8 + x, b = bh / AH, hq = bh % AH, gk = hq / 3;
                const float scale = 0.08838834764831845f, slope = exp2f(-8.f * (float)(hq + 1) / 12.f), sink = args.in[4][l * AH + hq];
                att::MaskA mk; { const int qpos = qb * 256 + (tid >> 6) * 32 + (lane & 31); mk.qoff = qb * 256 - 128 - qpos; mk.lo = -qpos > -128 ? -qpos : -128; mk.hi_ = SEQ - 1 - qpos < 128 ? SEQ - 1 - qpos : 128; } mk.sl = slope / scale;
                att::attn_unit_dma<128, att::MaskA>(PROJ + OFF_AQ + hq * 128, (long)b * SEQ + qb * 256, D_INP, PROJ + OFF_AK + gk * 128, D_INP, PROJ + OFF_AV + gk * 128, D_INP,
                                                (long)b * SEQ + qb * 256 - 128, (long)b * SEQ, (long)b * SEQ + SEQ - 1, 8,
                                                MIX + MIX_A + hq * 128, DM, scale * 1.4426950408889634f, sink / scale, 1.f, mk, (char*)lds, ldsl);
            }
            if (PH(18) && (rep == NREP(4) - 1 || (REPS & 4))) for (int u = bid; u < BATCH * BH * 32; u += G) {
                const int x = u & 7, qb = (u >> 3) & 31, bh = (u >> 8) * 8 + x, b = bh / BH, h = bh % BH;
                const float scale = 0.08838834764831845f;
                float* tab = (float*)(lds + 124928);
                if (tid < 15 * 31) tab[tid] = args.in[5][((size_t)l * BH + h) * 465 + tid] * (1.f / scale);
                const int r0 = qb * 4; int kr0 = r0 - 4; kr0 = kr0 < 0 ? 0 : (kr0 > 117 ? 117 : kr0);
                const int tq = qb * 256 + (tid >> 6) * 32 + (lane & 31);
                att::MaskB mk; mk.qr = tq >> 6; mk.qc = tq & 63; mk.kr0 = kr0; { int rs = mk.qr - 4; mk.rs = rs < 0 ? 0 : (rs > 120 ? 120 : rs); int cs = mk.qc - 8; mk.cs = cs < 0 ? 0 : (cs > 48 ? 48 : cs); } mk.tab = tab;
                att::attn_unit_dma<128, att::MaskB>(PROJ + OFF_BQ + h * 128, (long)b * SEQ + qb * 256, D_INP, PROJ + OFF_BK + h * 128, D_INP, PROJ + OFF_BV + h * 128, D_INP,
                                                (long)b * SEQ + kr0 * 64, (long)b * SEQ, (long)b * SEQ + SEQ - 1, 11,
                                                MIX + MIX_B + h * 128, DM, scale * 1.4426950408889634f, -1e5f, 0.f, mk, (char*)lds, ldsl);
            }
            }
            if (BOTH(pb + 2)) GRID_BAR();
        }
        if (PH(5) && IN(pb + 3)) { REPLOOP(5) {
            pg8::Gemm g{MIX, (const bf16_t*)(wl + WO_OUT), MTOK, DM, DM, DM, DM, (DM) / 256, 0u}; pg8::StaticOrder S; S.init(MTOK, DM, G, bid);
            pg8::EpiRes E{XB, (NREP(5) == 2 && rep == 0) ? (bf16_t*)(ws + 168 * MiB) : XB, SSQ};
            pg8::gemm_phase<pg8::EpiRes, pg8::StaticOrder, true, true>(ldsl, g, S, E);
            }
            if (BOTH(pb + 3)) GRID_BAR();
        }
        if (PH(7) && IN(pb + 4)) { REPLOOP(7) {
            const int half = G / 2;
            if (bid < half) { pg8::Gemm g{XB, (const bf16_t*)(wl + WO_XQ), MTOK, XD, DM, DM, DM, (XD) / 256, 0u}; pg8::StaticOrder S; S.init(MTOK, XD, half, bid);
                LAS float* tab = (LAS float*)(ldsl + RSTD_OFF); const int trow0 = (bid & 7) * 2048; build_rstd_table(S, SSQ, trow0, tab);
                pg8::EpiStoreScaled E{XQ, XD, tab, trow0};
                pg8::gemm_phase<pg8::EpiStoreScaled, pg8::StaticOrder, true, true>(ldsl, g, S, E); }
            else { pg8::Gemm g{MEMN, (const bf16_t*)(wl + WO_XKV), MEMROWS, 2 * XD, DM, DM, DM, (2 * XD) / 256, 0u}; pg8::StaticOrder S; S.init(MEMROWS, 2 * XD, G - half, bid - half);
                pg8::EpiStore E{MEMKV, 2 * XD};
                pg8::gemm_phase<pg8::EpiStore, pg8::StaticOrder, true, true>(ldsl, g, S, E); }
            }
            if (BOTH(pb + 4)) GRID_BAR();
        }
        if (PH(8) && IN(pb + 5)) { REPLOOP(8) {
            for (int u = bid; u < BATCH * 4 * 32; u += G) {
                const int x = u & 7, qb = (u >> 3) & 31, b = x >> 2, h = x & 3;
                att::MaskNone mk;
                att::attn_unit_dma<128, att::MaskNone>(XQ + h * 128, (long)b * SEQ + qb * 256, XD, MEMKV + h * 128, 2 * XD, MEMKV + XD + h * 128, 2 * XD, (long)b * NMEM, (long)b * NMEM, (long)b * NMEM + NMEM - 1, NMEM / 64,
                                                   XO + h * 128, XD, 0.08838834764831845f * 1.4426950408889634f, -1e5f, 0.f, mk, (char*)lds, ldsl);
            }
            }
            if (BOTH(pb + 5)) GRID_BAR();
        }
        if (PH(9) && IN(pb + 6)) { REPLOOP(9) {
            pg8::Gemm g{XO, (const bf16_t*)(wl + WO_XO), MTOK, DM, XD, XD, XD, (DM) / 256, 0u}; pg8::StaticOrder S; S.init(MTOK, DM, G, bid);
            pg8::EpiRes E{XB, (NREP(9) == 2 && rep == 0) ? (bf16_t*)(ws + 168 * MiB) : XB, SSQ};
            pg8::gemm_phase<pg8::EpiRes, pg8::StaticOrder, true, true>(ldsl, g, S, E);
            }
            if (BOTH(pb + 6)) GRID_BAR();
        }
        if (PH(11) && IN(pb + 7)) { REPLOOP(11) {
            pg8::Gemm g{XB, (const bf16_t*)(wl + WO_GU), MTOK, GUW, DM, DM, DM, (GUW) / 256, 0u}; pg8::StaticOrder S; S.init(MTOK, GUW, G, bid);
            LAS float* tab = (LAS float*)(ldsl + RSTD_OFF); const int trow0 = (bid & 7) * 2048; build_rstd_table(S, SSQ, trow0, tab);
            pg8::EpiSwiglu E{ACT, DFF, tab, trow0};
            pg8::gemm_phase<pg8::EpiSwiglu, pg8::StaticOrder, true, true>(ldsl, g, S, E);
            }
            if (BOTH(pb + 7)) GRID_BAR();
        }
        if (PH(12) && IN(pb + 8)) { REPLOOP(12) {
            pg8::Gemm g{ACT, (const bf16_t*)(wl + WO_DOWN), MTOK, DM, DFF, DFF, DFF, (DM) / 256, 0u}; pg8::StaticOrder S; S.init(MTOK, DM, G, bid, WGM_G7);
            pg8::EpiRes E{XB, (NREP(12) == 2 && rep == 0) ? (bf16_t*)(ws + 512 * MiB) : XB, SSQ};
            pg8::gemm_phase<pg8::EpiRes, pg8::StaticOrder, true, true>(ldsl, g, S, E);
            }
            if (BOTH(pb + 8)) GRID_BAR();
        }
    }
    if (PH(14) && IN(19)) { PH_TID();
        for (int m = gw; m < MTOK; m += NGW) rms_row_4096_bf(XB + (size_t)m * DM, args.in[21], args.out + (size_t)m * DM, lane);
    }
    if (NPASS > 1 && pass + 1 < NPASS) GRID_BAR();
    }
#undef IN
#undef BOTH
#undef GRID_BAR
}

#if DBG
constexpr int DBG_NS = 128;
struct DbgBuf { unsigned fail[64]; float snap[64][DBG_NS]; float tol[64][DBG_NS]; };
__device__ __forceinline__ unsigned dhash(unsigned x) { x ^= x >> 16; x *= 0x7feb352dU; x ^= x >> 15; x *= 0x846ca68bU; x ^= x >> 16; return x; }
__device__ __forceinline__ float rbf(float f) { unsigned u = __float_as_uint(f); u += 0x7fffu + ((u >> 16) & 1u); return __uint_as_float(u & 0xffff0000u); }
__device__ __forceinline__ float wave_max(float v) { for (int o = 1; o < 64; o <<= 1) v = fmaxf(v, __shfl_xor(v, o)); return v; }
__device__ void wdot(const bf16_t* a, const float* W, const float* gain, int N, int n, int K, int lane, float& dot, float& sabs) {
    float d = 0.f, sa = 0.f; for (int k = lane; k < K; k += 64) { const float x = bf2f(a[k]) * rbf(W[(size_t)k * N + n] * (gain ? gain[k] : 1.f)); d += x; sa += fabsf(x); } dot = wave_sum(d); sabs = wave_sum(sa); }
__device__ float row_rstd_f32(const float* x, int n, int lane) { float ss = 0.f; for (int k = lane; k < n; k += 64) ss += x[k] * x[k]; return rsqrtf(wave_sum(ss) / n + NORM_EPS); }
__device__ float row_rstd_bf(const bf16_t* x, int n, int lane) { float ss = 0.f; for (int k = lane; k < n; k += 64) ss += bf2f(x[k]) * bf2f(x[k]); return rsqrtf(wave_sum(ss) / n + NORM_EPS); }
__device__ void dsincos(float ang, float& c, float& s) { double x = (double)ang; const double tp = 6.283185307179586476925; x -= tp * __builtin_rint(x / tp);
    double sn = 0.0, cs = 0.0, term = 1.0; for (int k = 0; k < 30; ++k) { if (k & 1) { sn += ((k >> 1) & 1) ? -term : term; } else { cs += ((k >> 1) & 1) ? -term : term; } term *= x / (double)(k + 1); } c = (float)cs; s = (float)sn; }
__device__ void dchk(DbgBuf* D, int cid, float got, float exp, float tol, int lane) { if (lane == 0 && !(fabsf(got - exp) <= tol)) D->fail[cid] = 1u; }

__global__ void __launch_bounds__(64) dbg_check(Args a, int l, int kind, int cid, int pre) {
    const int lane = threadIdx.x, s = blockIdx.x; unsigned char* ws = a.ws; DbgBuf* D = (DbgBuf*)(ws + WS_DBG);
    const unsigned h1 = dhash(cid * 1000003u + s * 7919u + 12345u), h2 = dhash(h1 + 0x9e3779b9u), h3 = dhash(h2 + 0x85ebca6bu);
    bf16_t* MEMN = (bf16_t*)(ws + WS_MEMN); bf16_t* MEMKV = (bf16_t*)(ws + WS_MEMKV); bf16_t* XQ = (bf16_t*)(ws + WS_XQ); bf16_t* XO = (bf16_t*)(ws + WS_XO);
    bf16_t* XB = (bf16_t*)(ws + WS_H); bf16_t* PROJ = (bf16_t*)(ws + WS_PROJ);
    bf16_t* QC = (bf16_t*)(ws + WS_QC); bf16_t* KC = (bf16_t*)(ws + WS_KC); bf16_t* VC = (bf16_t*)(ws + WS_VC); bf16_t* MIX = (bf16_t*)(ws + WS_MIX); bf16_t* ACT = (bf16_t*)(ws + WS_ACT);
    float* SSQ = (float*)(ws + WS_SSQ); float* SSQ2 = (float*)(ws + WS_SSQ2);
    const int m = h1 % MTOK;
    if (kind == 41) {
        const int c = h2 % DM;
        if (s < 64) { const float e = a.in[0][(size_t)m * DM + c]; dchk(D, cid, bf2f(XB[(size_t)m * DM + c]), e, 0.005f * fabsf(e) + 1e-6f, lane); }
        else if (s < 96) { float ss = 0.f; for (int k = lane; k < DM; k += 64) { const float v = a.in[0][(size_t)m * DM + k]; ss += v * v; } ss = wave_sum(ss); const float g = wave_sum(SSQ[(size_t)m * 64 + lane]); dchk(D, cid, g, ss, 1e-4f * ss, lane); }
        else { const int r = h1 % MEMROWS; const float e = a.in[1][(size_t)r * DM + c] * row_rstd_f32(a.in[1] + (size_t)r * DM, DM, lane); dchk(D, cid, bf2f(MEMN[(size_t)r * DM + c]), e, 0.01f * fabsf(e) + 1e-3f, lane); }
    } else if (kind == 40) {
        const int c = h2 % DM;
        if (pre) return; const float exp = bf2f(XB[(size_t)m * DM + c]) * row_rstd_bf(XB + (size_t)m * DM, DM, lane) * a.in[21][c];
        dchk(D, cid, a.out[(size_t)m * DM + c], exp, 1e-4f * fabsf(exp) + 1e-5f, lane);
    } else if (kind == 2) {
        const float rstd = row_rstd_bf(XB + (size_t)m * DM, DM, lane); const float* W = a.in[3] + (size_t)l * DM * D_IN; const float* g = a.in[2] + (size_t)l * DM; const bf16_t* ar = XB + (size_t)m * DM;
        const int sub = s & 7;
        if (false) {}
        else if (sub == 5) { float ss = 0.f; for (int k = lane; k < QRANK; k += 64) { const float v = bf2f(PROJ[(size_t)m * D_INP + OFF_CQ + k]); ss += v * v; } ss = wave_sum(ss); const float gs = wave_sum(lane < 16 ? SSQ2[(size_t)m * 24 + lane] : 0.f); dchk(D, cid, gs, ss, 0.01f * ss, lane); }
        else if (sub == 1) { float ss = 0.f; for (int k = lane; k < KVRANK; k += 64) { const float v = bf2f(PROJ[(size_t)m * D_INP + OFF_CKV + k]); ss += v * v; } ss = wave_sum(ss); const float gs = wave_sum(lane < 8 ? SSQ2[(size_t)m * 24 + 16 + lane] : 0.f); dchk(D, cid, gs, ss, 0.01f * ss, lane); }
        else { const int n = h2 % OFF_CKR; float d, sa; wdot(ar, W, g, D_IN, n, DM, lane, d, sa); d *= rstd; dchk(D, cid, bf2f(PROJ[(size_t)m * D_INP + n]), d, 0.02f * fabsf(d) + 2e-4f * sa * rstd, lane); }
    } else if (kind == 4) {
        const int hh = h2 % CH; const float* W = a.in[7] + (size_t)l * QRANK * QCW; const float* g = a.in[6] + (size_t)l * QRANK; const bf16_t* ar = PROJ + (size_t)m * D_INP + OFF_CQ; const float rstd = row_rstd_bf(ar, QRANK, lane);
        if (s & 1) { const int d0 = h3 % 128; float d, sa; wdot(ar, W, g, QCW, hh * CQK + d0, QRANK, lane, d, sa); d *= rstd * QSC_C; dchk(D, cid, bf2f(QC[(size_t)m * QCW + hh * CQK + d0]), d, 0.02f * fabsf(d) + 2e-4f * sa * rstd * QSC_C, lane); }
        else { const int i = h3 % 32; float x1, s1, x2, s2; wdot(ar, W, g, QCW, hh * CQK + 128 + i, QRANK, lane, x1, s1); wdot(ar, W, g, QCW, hh * CQK + 128 + i + 32, QRANK, lane, x2, s2); x1 *= rstd * QSC_C; x2 *= rstd * QSC_C;
            float c, sn; dsincos((float)(m % SEQ) * a.inv[i], c, sn); const float e1 = x1 * c - x2 * sn, e2 = x1 * sn + x2 * c; const bf16_t* q = QC + (size_t)m * QCW + hh * CQK + 128 + 2 * i;
            const float tol = 2e-4f * (s1 + s2) * rstd * QSC_C; dchk(D, cid, bf2f(q[0]), e1, 0.02f * fabsf(e1) + tol, lane); dchk(D, cid, bf2f(q[1]), e2, 0.02f * fabsf(e2) + tol, lane); }
    } else if (kind == 5 && (s & 3) == 2) {
        const float rstd = row_rstd_bf(XB + (size_t)m * DM, DM, lane); const float* W = a.in[3] + (size_t)l * DM * D_IN; const float* g = a.in[2] + (size_t)l * DM; const bf16_t* ar = XB + (size_t)m * DM;
        const int i = h2 % 32, hh = h3 % CH; float x1, s1, x2, s2; wdot(ar, W, g, D_IN, OFF_CKR + i, DM, lane, x1, s1); wdot(ar, W, g, D_IN, OFF_CKR + i + 32, DM, lane, x2, s2); x1 *= rstd; x2 *= rstd;
        float c, sn; dsincos((float)(m % SEQ) * a.inv[i], c, sn); const float e1 = x1 * c - x2 * sn, e2 = x1 * sn + x2 * c; const bf16_t* kc = KC + (size_t)m * QCW + hh * CQK + 128 + 2 * i; const float tol = 2e-4f * (s1 + s2) * rstd;
        dchk(D, cid, bf2f(kc[0]), e1, 0.02f * fabsf(e1) + tol, lane); dchk(D, cid, bf2f(kc[1]), e2, 0.02f * fabsf(e2) + tol, lane);
    } else if (kind == 5) {
        const int hh = h2 % CH, part = s & 1, d0 = h3 % 128; const bf16_t* ar = PROJ + (size_t)m * D_INP + OFF_CKV; const float rstd = row_rstd_bf(ar, KVRANK, lane); float d, sa;
        wdot(ar, a.in[9] + (size_t)l * KVRANK * KVW, a.in[8] + (size_t)l * KVRANK, KVW, hh * 256 + part * 128 + d0, KVRANK, lane, d, sa); d *= rstd;
        const float got = part ? bf2f(VC[(size_t)m * VCW + hh * 128 + d0]) : bf2f(KC[(size_t)m * QCW + hh * CQK + d0]); dchk(D, cid, got, d, 0.02f * fabsf(d) + 2e-4f * sa * rstd, lane);
    } else if (kind == 6 || kind == 7 || kind == 8 || kind == 12) {
        const int b = m / SEQ, pos = m % SEQ, d0 = h3 % 128; int nk, hh; float scale; const bf16_t *qp, *kp0, *vp0; int ldk, ldv, dqk; float got; float sinkv = 0.f; bool has_sink = false;
        int rs = 0, cs = 0, qr = pos >> 6, qc = pos & 63; float slope = 0.f; const float* rpb = nullptr;
        if (kind == 6) { hh = h2 % CH; nk = SEQ; scale = 0.6931471805599453f;     dqk = 192; qp = QC + (size_t)m * QCW + hh * CQK; kp0 = KC + (size_t)b * SEQ * QCW + hh * CQK; ldk = QCW; vp0 = VC + (size_t)b * SEQ * VCW + hh * 128 + d0; ldv = VCW; got = bf2f(MIX[(size_t)m * DM + MIX_C + hh * 128 + d0]); }
        else if (kind == 7) { hh = h2 % AH; nk = 257; scale = 0.08838834764831845f; dqk = 128; qp = PROJ + (size_t)m * D_INP + OFF_AQ + hh * 128; kp0 = PROJ + (size_t)b * SEQ * D_INP + OFF_AK + (hh / 3) * 128; ldk = D_INP; vp0 = PROJ + (size_t)b * SEQ * D_INP + OFF_AV + (hh / 3) * 128 + d0; ldv = D_INP;
            got = bf2f(MIX[(size_t)m * DM + MIX_A + hh * 128 + d0]); slope = exp2f(-8.f * (float)(hh + 1) / 12.f); sinkv = a.in[4][l * AH + hh]; has_sink = true; }
        else if (kind == 8) { hh = h2 % BH; nk = 128; scale = 0.08838834764831845f; dqk = 128; qp = PROJ + (size_t)m * D_INP + OFF_BQ + hh * 128; kp0 = PROJ + (size_t)b * SEQ * D_INP + OFF_BK + hh * 128; ldk = D_INP; vp0 = PROJ + (size_t)b * SEQ * D_INP + OFF_BV + hh * 128 + d0; ldv = D_INP;
            got = bf2f(MIX[(size_t)m * DM + MIX_B + hh * 128 + d0]); rs = qr - 4; rs = rs < 0 ? 0 : (rs > 120 ? 120 : rs); cs = qc - 8; cs = cs < 0 ? 0 : (cs > 48 ? 48 : cs); rpb = a.in[5] + ((size_t)l * BH + hh) * 465; }
        else { hh = h2 % 4; nk = NMEM; scale = 0.08838834764831845f; dqk = 128; qp = XQ + (size_t)m * XD + hh * 128; kp0 = MEMKV + (size_t)b * NMEM * 2 * XD + hh * 128; ldk = 2 * XD; vp0 = MEMKV + (size_t)b * NMEM * 2 * XD + XD + hh * 128 + d0; ldv = 2 * XD; got = bf2f(XO[(size_t)m * XD + hh * 128 + d0]); }
        float mx = has_sink ? sinkv : -1e30f, den = 0.f, acc = 0.f, vmax = 0.f;
        for (int pass = 0; pass < 2; ++pass) {
            if (pass == 1) mx = wave_max(mx);
            for (int j = lane; j < nk; j += 64) { int key; float bias = 0.f;
                if (kind == 7) { key = pos - 128 + j; if (key < 0 || key >= SEQ) continue; const int ar = key > pos ? key - pos : pos - key; bias = -slope * (float)ar; }
                else if (kind == 8) { const int kr = rs + (j >> 4), kcn = cs + (j & 15); key = kr * 64 + kcn; bias = rpb[(kr - qr + 7) * 31 + (kcn - qc + 15)]; }
                else key = j;
                float dt = 0.f; const bf16_t* kp = kp0 + (size_t)key * ldk; for (int e = 0; e < dqk; ++e) dt += bf2f(qp[e]) * bf2f(kp[e]);
                const float sc = dt * scale + bias;
                if (pass == 0) mx = fmaxf(mx, sc); else { const float p = __expf(sc - mx); const float v = bf2f(vp0[(size_t)key * ldv]); den += p; acc += p * v; vmax = fmaxf(vmax, fabsf(v)); } } }
        den = wave_sum(den); acc = wave_sum(acc); vmax = wave_max(vmax); if (has_sink) den += __expf(sinkv - mx);
        const float exp = acc / den; dchk(D, cid, got, exp, 0.03f * fabsf(exp) + 0.01f * vmax, lane);
    } else if (kind == 9 || kind == 13 || kind == 16) {
        const int n = h2 % DM;
        if (!pre) { const float e = D->snap[cid][s], t = D->tol[cid][s]; dchk(D, cid, bf2f(XB[(size_t)m * DM + n]), e, t + 0.005f * fabsf(e), lane);
            if ((s & 3) == 0) { float ss = 0.f; for (int k = lane; k < DM; k += 64) { const float v = bf2f(XB[(size_t)m * DM + k]); ss += v * v; } ss = wave_sum(ss); const float g = wave_sum(SSQ[(size_t)m * 64 + lane]); dchk(D, cid, g, ss, 5e-3f * ss, lane); }
            return; }
        float d, sa; const float xo = bf2f(XB[(size_t)m * DM + n]);
        if (kind == 9) wdot(MIX + (size_t)m * DM, a.in[10] + (size_t)l * DM * DM, nullptr, DM, n, DM, lane, d, sa);
        else if (kind == 13) wdot(XO + (size_t)m * XD, a.in[16] + (size_t)l * XD * DM, nullptr, DM, n, XD, lane, d, sa);
        else wdot(ACT + (size_t)m * DFF, a.in[20] + (size_t)l * DFF * DM, nullptr, DM, n, DFF, lane, d, sa);
        if (lane == 0) { D->snap[cid][s] = xo + d; D->tol[cid][s] = 0.02f * fabsf(d) + 2e-4f * sa + 1e-5f * fabsf(xo); }
    } else if (kind == 11) {
        float d, sa;
        if (s < 96) { const int n = h2 % XD; const float rstd = row_rstd_bf(XB + (size_t)m * DM, DM, lane); wdot(XB + (size_t)m * DM, a.in[13] + (size_t)l * DM * XD, a.in[11] + (size_t)l * DM, XD, n, DM, lane, d, sa); d *= rstd;
            dchk(D, cid, bf2f(XQ[(size_t)m * XD + n]), d, 0.02f * fabsf(d) + 2e-4f * sa * rstd, lane); }
        else { const int r = h1 % MEMROWS, n = h2 % (2 * XD); wdot(MEMN + (size_t)r * DM, (n < XD ? a.in[14] : a.in[15]) + (size_t)l * DM * XD, a.in[12] + (size_t)l * DM, XD, n % XD, DM, lane, d, sa); dchk(D, cid, bf2f(MEMKV[(size_t)r * 2 * XD + n]), d, 0.02f * fabsf(d) + 2e-4f * sa, lane); }
    } else if (kind == 15) {
        const int j = h2 % DFF; float g, sg, u, su; const float rstd = row_rstd_bf(XB + (size_t)m * DM, DM, lane); const float* gn = a.in[17] + (size_t)l * DM;
        wdot(XB + (size_t)m * DM, a.in[18] + (size_t)l * DM * DFF, gn, DFF, j, DM, lane, g, sg); wdot(XB + (size_t)m * DM, a.in[19] + (size_t)l * DM * DFF, gn, DFF, j, DM, lane, u, su); g *= rstd; u *= rstd;
        const float exp = g / (1.f + __expf(-g)) * u; dchk(D, cid, bf2f(ACT[(size_t)m * DFF + j]), exp, 0.03f * fabsf(exp) + 4e-3f, lane);
    }
}
__global__ void dbg_final(Args a) {
    DbgBuf* D = (DbgBuf*)(a.ws + WS_DBG); int id1 = 0, id2 = 0;
    for (int i = 1; i < 64; ++i) if (D->fail[i]) { if (!id1) id1 = i; else if (!id2) id2 = i; }
    if (!id1) return; if (id2 > 33) id2 = 33;
    const float c = sqrtf((10.f + (float)id1) / 10.f) * __powf(10.f, 0.5f * (float)(4 + id2));
    for (size_t i = (size_t)blockIdx.x * blockDim.x + threadIdx.x; i < (size_t)MTOK * DM; i += (size_t)gridDim.x * blockDim.x) a.out[i] = c;
}
static void dbg_run(Args a, int grid, hipStream_t stream) {
    (void)hipMemsetAsync(a.ws + WS_DBG, 0, sizeof(DbgBuf), stream);
    auto chk = [&](int l, int kind, int pre) { hipLaunchKernelGGL(dbg_check, dim3(DBG_NS), dim3(64), 0, stream, a, l, kind, kind >= 40 ? kind : 20 * l + kind, pre); };
    for (int p = 0; p < N_PHASES; ++p) {
        const int l = (p - 1) / 9, j = (p - 1) % 9;
        if (p >= 1 && p <= 18) { if (j == 3) chk(l, 9, 1); if (j == 6) chk(l, 13, 1); if (j == 8) chk(l, 16, 1); }
        if (p == 19) chk(0, 40, 1);
        a.ph_lo = p; a.ph_hi = p + 1; a.use_bar = 0; a.pad = 0;
        hipLaunchKernelGGL(fwd_kernel, dim3(grid), dim3(NWAVES * 64), LDS_BYTES, stream, a);
        if (p == 0) chk(0, 41, 0);
        if (p >= 1 && p <= 18) {
            switch (j) { case 0: chk(l, 2, 0); break; case 1: chk(l, 4, 0); chk(l, 5, 0); break; case 2: chk(l, 6, 0); chk(l, 7, 0); chk(l, 8, 0); break;
                case 3: chk(l, 9, 0); break; case 4: chk(l, 11, 0); break; case 5: chk(l, 12, 0); break; case 6: chk(l, 13, 0); break; case 7: chk(l, 15, 0); break; case 8: chk(l, 16, 0); break; }
        }
        if (p == 19) chk(0, 40, 0);
    }
    hipLaunchKernelGGL(dbg_final, dim3(2048), dim3(256), 0, stream, a);
}
#endif

extern "C" void kernel_launch(void* const* d_in, const int* in_sizes, int n_in, void* d_out, int out_size, void* d_ws, size_t ws_size, hipStream_t stream) {
    static int grid = 0;
    if (grid == 0) {
        if (n_in != 22 || out_size != MTOK * DM || ws_size < WS_END) { fprintf(stderr, "kernel_launch: unexpected shapes: n_in %d out %d ws %zu (need %zu)\n", n_in, out_size, ws_size, (size_t)WS_END); grid = -1; return; }
        int dev = 0, cus = 0, per_cu = 0;
        if (hipGetDevice(&dev) != hipSuccess || hipDeviceGetAttribute(&cus, hipDeviceAttributeMultiprocessorCount, dev) != hipSuccess) { grid = -1; return; }
        if (hipFuncSetAttribute((const void*)fwd_kernel, hipFuncAttributeMaxDynamicSharedMemorySize, LDS_BYTES) != hipSuccess) { fprintf(stderr, "kernel_launch: hipFuncSetAttribute failed\n"); grid = -1; return; }
        if (hipOccupancyMaxActiveBlocksPerMultiprocessor(&per_cu, (const void*)fwd_kernel, NWAVES * 64, LDS_BYTES) != hipSuccess || per_cu < 1) { fprintf(stderr, "kernel_launch: occupancy query says %d blocks per CU\n", per_cu); (void)hipGetLastError(); grid = -1; return; }
        grid = cus;
    }
    if (grid < 0) return;
    (void)hipMemsetAsync((char*)d_ws + WS_CTL, 0, CTL_ZERO_BYTES, stream);
    Args a{};
    for (int i = 0; i < 22; ++i) a.in[i] = (const float*)d_in[i];
    a.out = (float*)d_out; a.ws = (unsigned char*)d_ws;
    for (int i = 0; i < 32; ++i) { const float p = powf(10000.0f, (float)(2 * i) / 64.0f); a.inv[i] = 1.0f / p; }
#if DBG
    dbg_run(a, grid, stream);
#else
    a.ph_lo = 0; a.ph_hi = N_PHASES; a.use_bar = 1; a.pad = 0;
    hipLaunchKernelGGL(fwd_kernel, dim3(grid), dim3(NWAVES * 64), LDS_BYTES, stream, a);
#endif
}
```

```cpp
#include <hip/hip_runtime.h>
#include <cstdio>
#include <cstdint>
#include <cmath>

#ifndef DBG
#define DBG 0
#endif

constexpr int BATCH = 2, SEQ = 8192, DM = 4096, MTOK = BATCH * SEQ, DEPTH = 2;
constexpr int NMEM = 256, MEMROWS = BATCH * NMEM;
constexpr int D_IN = 7232, D_INP = 7424;
constexpr int OFF_AQ = 0, OFF_AK = 1536, OFF_AV = 2048, OFF_BQ = 2560, OFF_BK = 3584, OFF_BV = 4608, OFF_CQ = 5632, OFF_CKV = 6656, OFF_CKR = 7168;
constexpr int QRANK = 1024, KVRANK = 512, CH = 12, CQK = 192, QCW = CH * CQK, KVW = CH * 256, VCW = CH * 128;
constexpr int XD = 512, DFF = 11008, GUW = 2 * DFF;
constexpr int AH = 12, BH = 8;
constexpr int MIX_A = 0, MIX_B = 1536, MIX_C = 2560;
constexpr float NORM_EPS = 1e-6f;
constexpr float QSC_C = 0.07216878364870322f * 1.4426950408889634f;

constexpr size_t MiB = 1u << 20;
constexpr size_t WS_CTL = 0, CTL_ZERO_BYTES = 1 * MiB;
constexpr size_t WS_COS = 1 * MiB, WS_SIN = 2 * MiB;
constexpr size_t WS_MEMN = 3 * MiB;
constexpr size_t WS_MEMKV = 7 * MiB;
constexpr size_t WS_XQ = 8 * MiB, WS_XO = 24 * MiB;
constexpr size_t WS_H = 40 * MiB;
constexpr size_t WS_PROJ = 168 * MiB;
constexpr size_t WS_CQN = 400 * MiB;
constexpr size_t WS_CKVN = 432 * MiB;
constexpr size_t WS_QC = 448 * MiB;
constexpr size_t WS_KC = 520 * MiB;
constexpr size_t WS_VC = 592 * MiB;
constexpr size_t WS_MIX = 640 * MiB;
constexpr size_t WS_ACT = 168 * MiB;
constexpr size_t WS_W = 768 * MiB;
constexpr size_t WO_IN = 0, WO_QB = WO_IN + (size_t)D_INP * DM * 2, WO_KVB = WO_QB + (size_t)QCW * QRANK * 2, WO_OUT = WO_KVB + (size_t)KVW * KVRANK * 2,
                 WO_XQ = WO_OUT + (size_t)DM * DM * 2, WO_XKV = WO_XQ + (size_t)XD * DM * 2, WO_XO = WO_XKV + (size_t)2 * XD * DM * 2, WO_GU = WO_XO + (size_t)DM * XD * 2,
                 WO_DOWN = WO_GU + (size_t)GUW * DM * 2, W_LAYER = WO_DOWN + (size_t)DM * DFF * 2;
constexpr size_t WS_SSQ = WS_W + 2 * W_LAYER;
constexpr size_t WS_SSQ2 = WS_SSQ + 4 * MiB;
constexpr size_t WS_CKR = WS_SSQ2 + 2 * MiB;
constexpr size_t WS_DBG = WS_CKR + 16 * MiB;
constexpr size_t WS_END = WS_DBG + 1 * MiB;
static_assert((2 * W_LAYER) % MiB == 0, "SSQ alignment");
static_assert(WS_ACT + (size_t)MTOK * DFF * 2 <= WS_MIX, "ACT overlay");
static_assert(WS_PROJ + (size_t)MTOK * D_INP * 2 <= WS_CQN, "PROJ");
static_assert(W_LAYER % 256 == 0, "weights aligned");

constexpr int CW_BAR = 4096;

constexpr int RING_BYTES = 131072;
constexpr int LDSCTL_OFF = RING_BYTES, MISC_OFF = LDSCTL_OFF + 320;
constexpr int RSTD_OFF = LDSCTL_OFF + 1024;
constexpr int LDS_BYTES = 147456;
static_assert(RSTD_OFF + 8192 <= LDS_BYTES, "LDS map");

typedef unsigned short bf16_t;
#define LAS __attribute__((address_space(3)))
#define GAS __attribute__((address_space(1)))
typedef GAS unsigned gu32;
#define RLX_AGENT __ATOMIC_RELAXED, __HIP_MEMORY_SCOPE_AGENT

__device__ __forceinline__ float bf2f(bf16_t b) { return __uint_as_float(((unsigned)b) << 16); }
__device__ __forceinline__ unsigned cvt_pk_bf16(float lo, float hi) { unsigned r; asm volatile("v_cvt_pk_bf16_f32 %0, %1, %2" : "=v"(r) : "v"(lo), "v"(hi)); return r; }
__device__ __forceinline__ float wave_sum(float v) {
#pragma unroll
    for (int o = 1; o < 64; o <<= 1) v += __shfl_xor(v, o);
    return v;
}

namespace pg8 {
#define PG8_LAS __attribute__((address_space(3)))
typedef short bf16x8 __attribute__((ext_vector_type(8)));
typedef float f32x4 __attribute__((ext_vector_type(4)));
typedef float f32x2 __attribute__((ext_vector_type(2)));
typedef unsigned u32x4 __attribute__((ext_vector_type(4)));
constexpr int BM = 256, BK = 64, HALF = 128, HTB = HALF * BK * 2, STAGE_BYTES = 8 * HTB, NXCD = 8, WGM = 8;

__host__ __device__ __forceinline__ int lds_byte(int r, int c) { const int st = (r >> 4) * 2 + (c >> 5), rr = r & 15, cc = c & 31, ob = rr * 64 + cc * 2; return st * 1024 + (ob ^ (((ob >> 9) & 1) << 5)); }
__host__ __device__ __forceinline__ void stage_rc(int b, int& R, int& C) { const int st = b / 1024, sb = b % 1024, swz = sb ^ (((sb >> 9) & 1) << 5); R = (st >> 1) * 16 + swz / 64; C = (st & 1) * 32 + (swz % 64) / 2; }
__host__ __device__ __forceinline__ int perm32(int rho) { const int n = rho >> 4, i = rho & 15; return 8 * (i >> 2) + 4 * n + (i & 3); }

struct Unit { int pm, pn; };
struct Gemm { const bf16_t* A; const bf16_t* Bt; int M, N, K, lda, ldb, nNc; unsigned ksplit_bytes; };

struct StaticOrder {
    int nM, nN, nwg, G, c, wgm;
    __host__ __device__ void init(int M, int N, int G_, int c_, int wgm_ = WGM) { nM = M / BM; nN = N / BM; nwg = nM * nN; G = G_; c = c_; wgm = wgm_; }
    __host__ __device__ bool next(int i, Unit& u) const {
        const long L = (long)i * G + c; if (L >= nwg) return false;
        int wgid = (int)L; { const int q = nwg / NXCD, r = nwg % NXCD, xcd = wgid % NXCD, off = wgid / NXCD; wgid = (xcd < r ? xcd * (q + 1) : r * (q + 1) + (xcd - r) * q) + off; }
        const int nig = wgm * nN, gid = wgid / nig, fm = gid * wgm, gsz = (nM - fm) < wgm ? (nM - fm) : wgm;
        u.pm = fm + ((wgid % nig) % gsz); u.pn = (wgid % nig) / gsz; return true;
    }
    __device__ __forceinline__ void a_ready(const Unit&) const {}
    __device__ __forceinline__ void done(const Unit&) const {}
};


template <int NS> __device__ __forceinline__ void rows_rstd(float (&rs)[2][4], const float* slots, int pitch, int row0, int fq, float inv_n) {
#pragma unroll
    for (int ai = 0; ai < 2; ++ai)
#pragma unroll
        for (int m = 0; m < 4; ++m) { const float* p = slots + (size_t)(row0 + ai * HALF + m * 16) * pitch; float t;
            if constexpr (NS == 64) { const f32x4 a = *(const f32x4*)(p + fq * 16), b = *(const f32x4*)(p + fq * 16 + 4), c = *(const f32x4*)(p + fq * 16 + 8), d = *(const f32x4*)(p + fq * 16 + 12);
                t = ((a[0] + a[1]) + (a[2] + a[3])) + ((b[0] + b[1]) + (b[2] + b[3])) + ((c[0] + c[1]) + (c[2] + c[3])) + ((d[0] + d[1]) + (d[2] + d[3])); }
            else if constexpr (NS == 16) { const f32x4 a = *(const f32x4*)(p + fq * 4); t = (a[0] + a[1]) + (a[2] + a[3]); }
            else { const f32x2 a = *(const f32x2*)(p + fq * 2); t = a[0] + a[1]; }
            t += __shfl_xor(t, 16); t += __shfl_xor(t, 32);
            rs[ai][m] = rsqrtf(t * inv_n + NORM_EPS); }
}
__device__ __forceinline__ void rows_rstd_tab(float (&rs)[2][4], const PG8_LAS float* tab, int tab_row0, int row0) {
#pragma unroll
    for (int ai = 0; ai < 2; ++ai)
#pragma unroll
        for (int m = 0; m < 4; ++m) rs[ai][m] = tab[row0 + ai * HALF + m * 16 - tab_row0];
}
__device__ __forceinline__ u32x4 pack8(const f32x4 v0, const f32x4 v1) { u32x4 w; w.x = cvt_pk_bf16(v0[0], v0[1]); w.y = cvt_pk_bf16(v0[2], v0[3]); w.z = cvt_pk_bf16(v1[0], v1[1]); w.w = cvt_pk_bf16(v1[2], v1[3]); return w; }

struct EpiStore {
    static constexpr bool PERM = true, AFTER_DRAIN = false, INPLACE = false, B0ONLY = false;
    bf16_t* O; int ldc;
    __device__ __forceinline__ void operator()(const f32x4 (&acc)[2][2][4][2], const Unit& u, int wr, int wc, int fr, int fq) const {
        const int row0 = u.pm * BM + wr * 64 + fr, col0 = u.pn * BM + wc * 32 + 8 * fq;
#pragma unroll
        for (int ai = 0; ai < 2; ++ai)
#pragma unroll
            for (int m = 0; m < 4; ++m) { bf16_t* rowp = O + (size_t)(row0 + ai * HALF + m * 16) * ldc + col0;
#pragma unroll
                for (int bj = 0; bj < 2; ++bj) *(u32x4*)(rowp + bj * HALF) = pack8(acc[ai][bj][m][0], acc[ai][bj][m][1]); }
    }
};
struct EpiStoreScaled {
    static constexpr bool PERM = true, AFTER_DRAIN = false, INPLACE = false, B0ONLY = false;
    bf16_t* O; int ldc; const PG8_LAS float* tab; int tab_row0;
    __device__ __forceinline__ void operator()(const f32x4 (&acc)[2][2][4][2], const Unit& u, int wr, int wc, int fr, int fq) const {
        const int row0 = u.pm * BM + wr * 64 + fr, col0 = u.pn * BM + wc * 32 + 8 * fq;
        float rs[2][4]; rows_rstd_tab(rs, tab, tab_row0, row0);
#pragma unroll
        for (int ai = 0; ai < 2; ++ai)
#pragma unroll
            for (int m = 0; m < 4; ++m) { bf16_t* rowp = O + (size_t)(row0 + ai * HALF + m * 16) * ldc + col0;
#pragma unroll
                for (int bj = 0; bj < 2; ++bj) *(u32x4*)(rowp + bj * HALF) = pack8(acc[ai][bj][m][0] * rs[ai][m], acc[ai][bj][m][1] * rs[ai][m]); }
    }
};
struct EpiG1 {
    static constexpr bool PERM = true, AFTER_DRAIN = false, INPLACE = false, B0ONLY = false;
    bf16_t* PROJ; const PG8_LAS float* tab; int tab_row0; float* ssq2;
    __device__ __forceinline__ void operator()(const f32x4 (&acc)[2][2][4][2], const Unit& u, int wr, int wc, int fr, int fq) const {
        const int row0 = u.pm * BM + wr * 64 + fr, col0 = u.pn * BM + wc * 32 + 8 * fq;
        float rs[2][4]; rows_rstd_tab(rs, tab, tab_row0, row0);
        const bool stats = u.pn >= 22; const int slot = (u.pn < 26 ? (u.pn - 22) * 4 : 16 + (u.pn - 26) * 4) + wc;
#pragma unroll
        for (int ai = 0; ai < 2; ++ai)
#pragma unroll
            for (int m = 0; m < 4; ++m) { const int row = row0 + ai * HALF + m * 16; bf16_t* rowp = PROJ + (size_t)row * D_INP + col0; float q = 0.f;
#pragma unroll
                for (int bj = 0; bj < 2; ++bj) { const f32x4 v0 = acc[ai][bj][m][0] * rs[ai][m], v1 = acc[ai][bj][m][1] * rs[ai][m];
                    q += ((v0[0] * v0[0] + v0[1] * v0[1]) + (v0[2] * v0[2] + v0[3] * v0[3])) + ((v1[0] * v1[0] + v1[1] * v1[1]) + (v1[2] * v1[2] + v1[3] * v1[3]));
                    *(u32x4*)(rowp + bj * HALF) = pack8(v0, v1); }
                if (stats) { q += __shfl_xor(q, 16); q += __shfl_xor(q, 32); if (fq == 0) ssq2[(size_t)row * 24 + slot] = q; } }
    }
};
struct EpiCkr {
    static constexpr bool PERM = true, AFTER_DRAIN = false, INPLACE = false, B0ONLY = true;
    float* slab;
    __device__ __forceinline__ void operator()(const f32x4 (&acc)[2][2][4][2], const Unit& u, int wr, int wc, int fr, int fq) const {
        if (wc >= 2) return;
        const int row0 = u.pm * BM + wr * 64 + fr; float* base = slab + (size_t)u.pn * MTOK * 64 + 32 * wc + 8 * fq;
#pragma unroll
        for (int ai = 0; ai < 2; ++ai)
#pragma unroll
            for (int m = 0; m < 4; ++m) { float* p = base + (size_t)(row0 + ai * HALF + m * 16) * 64; *(f32x4*)p = acc[ai][0][m][0]; *(f32x4*)(p + 4) = acc[ai][0][m][1]; }
    }
};
struct EpiQRope {
    static constexpr bool PERM = true, AFTER_DRAIN = false, INPLACE = false, B0ONLY = false;
    bf16_t* O; const float* cs; const float* sn; const float* ssq2;
    __device__ __forceinline__ void operator()(const f32x4 (&acc)[2][2][4][2], const Unit& u, int wr, int wc, int fr, int fq) const {
        const int row0 = u.pm * BM + wr * 64 + fr;
        float rs[2][4]; rows_rstd<16>(rs, ssq2, 24, row0, fq, 1.f / QRANK);
#pragma unroll
        for (int bj = 0; bj < 2; ++bj) {
            const int cg = u.pn * BM + bj * HALF + wc * 32;
            const int hc = cg % CQK;
            const bool rope = hc >= 128;
            const int i0 = ((hc - 128) >> 1) + 4 * fq;
#pragma unroll
            for (int ai = 0; ai < 2; ++ai)
#pragma unroll
                for (int m = 0; m < 4; ++m) { const int row = row0 + ai * HALF + m * 16;
                    f32x4 v0 = acc[ai][bj][m][0] * (rs[ai][m] * QSC_C), v1 = acc[ai][bj][m][1] * (rs[ai][m] * QSC_C);
                    if (rope) { const int pos = row & (SEQ - 1); const f32x4 c = *(const f32x4*)(cs + pos * 32 + i0), s = *(const f32x4*)(sn + pos * 32 + i0);
                        const f32x4 a0 = v0, a1 = v1;
                        v0[0] = a0[0] * c[0] - a0[1] * s[0]; v0[1] = a0[0] * s[0] + a0[1] * c[0];
                        v0[2] = a0[2] * c[1] - a0[3] * s[1]; v0[3] = a0[2] * s[1] + a0[3] * c[1];
                        v1[0] = a1[0] * c[2] - a1[1] * s[2]; v1[1] = a1[0] * s[2] + a1[1] * c[2];
                        v1[2] = a1[2] * c[3] - a1[3] * s[3]; v1[3] = a1[2] * s[3] + a1[3] * c[3]; }
                    *(u32x4*)(O + (size_t)row * QCW + cg + 8 * fq) = pack8(v0, v1); }
        }
    }
};
struct EpiKV {
    static constexpr bool PERM = true, AFTER_DRAIN = false, INPLACE = false, B0ONLY = false;
    bf16_t* KC; bf16_t* VC; const float* ssq2;
    __device__ __forceinline__ void operator()(const f32x4 (&acc)[2][2][4][2], const Unit& u, int wr, int wc, int fr, int fq) const {
        const int row0 = u.pm * BM + wr * 64 + fr, cl = wc * 32 + 8 * fq;
        float rs[2][4]; rows_rstd<8>(rs, ssq2 + 16, 24, row0, fq, 1.f / KVRANK);
#pragma unroll
        for (int ai = 0; ai < 2; ++ai)
#pragma unroll
            for (int m = 0; m < 4; ++m) { const int row = row0 + ai * HALF + m * 16;
#pragma unroll
                for (int bj = 0; bj < 2; ++bj) {
                    bf16_t* dst = bj == 0 ? KC + (size_t)row * QCW + u.pn * CQK + cl : VC + (size_t)row * VCW + u.pn * 128 + cl;
                    *(u32x4*)dst = pack8(acc[ai][bj][m][0] * rs[ai][m], acc[ai][bj][m][1] * rs[ai][m]); } }
    }
};
struct EpiRes {
    static constexpr bool PERM = true, AFTER_DRAIN = false, INPLACE = true, B0ONLY = false;
    const bf16_t* base; bf16_t* out; float* ssq;
    __device__ __forceinline__ void operator()(const f32x4 (&acc)[2][2][4][2], const Unit& u, int wr, int wc, int fr, int fq) const {
        const int row0 = u.pm * BM + wr * 64 + fr, col0 = u.pn * BM + wc * 32 + 8 * fq;
#pragma unroll
        for (int ai = 0; ai < 2; ++ai) {
            u32x4 b[4][2];
#pragma unroll
            for (int m = 0; m < 4; ++m) { const size_t off = (size_t)(row0 + ai * HALF + m * 16) * DM + col0;
#pragma unroll
                for (int bj = 0; bj < 2; ++bj) b[m][bj] = *(const u32x4*)(base + off + bj * HALF); }
            asm volatile("" ::: "memory");
#pragma unroll
            for (int m = 0; m < 4; ++m) { const int row = row0 + ai * HALF + m * 16; const size_t off = (size_t)row * DM + col0;
                f32x4 q4 = {0.f, 0.f, 0.f, 0.f};
#pragma unroll
                for (int bj = 0; bj < 2; ++bj) { const u32x4 w = b[m][bj];
                    const f32x4 r0 = {__uint_as_float(w.x << 16), __uint_as_float(w.x & 0xffff0000u), __uint_as_float(w.y << 16), __uint_as_float(w.y & 0xffff0000u)};
                    const f32x4 r1 = {__uint_as_float(w.z << 16), __uint_as_float(w.z & 0xffff0000u), __uint_as_float(w.w << 16), __uint_as_float(w.w & 0xffff0000u)};
                    const f32x4 v0 = r0 + acc[ai][bj][m][0], v1 = r1 + acc[ai][bj][m][1];
                    q4 += v0 * v0; q4 += v1 * v1;
                    *(u32x4*)(out + off + bj * HALF) = pack8(v0, v1); }
                float q = (q4[0] + q4[1]) + (q4[2] + q4[3]);
                q += __shfl_xor(q, 16); q += __shfl_xor(q, 32); if (fq == 0) ssq[(size_t)row * 64 + u.pn * 4 + wc] = q; }
            asm volatile("" ::: "memory"); }
    }
};
struct EpiSwiglu {
    static constexpr bool PERM = true, AFTER_DRAIN = false, INPLACE = false, B0ONLY = false;
    bf16_t* O; int ldc; const PG8_LAS float* tab; int tab_row0;
    __device__ __forceinline__ f32x4 sw4(const f32x4 g, const f32x4 u, float k1, float r2) const {
        f32x4 e = g * k1;
#pragma unroll
        for (int c = 0; c < 4; ++c) e[c] = __builtin_amdgcn_exp2f(e[c]);
        f32x4 d = e + 1.0f;
#pragma unroll
        for (int c = 0; c < 4; ++c) d[c] = __builtin_amdgcn_rcpf(d[c]);
        return ((g * u) * r2) * d;
    }
    __device__ __forceinline__ void operator()(const f32x4 (&acc)[2][2][4][2], const Unit& u, int wr, int wc, int fr, int fq) const {
        const int row0 = u.pm * BM + wr * 64 + fr, col0 = u.pn * HALF + wc * 32 + 8 * fq;
        float rs[2][4]; rows_rstd_tab(rs, tab, tab_row0, row0);
#pragma unroll
        for (int ai = 0; ai < 2; ++ai)
#pragma unroll
            for (int m = 0; m < 4; ++m) { const float r = rs[ai][m], r2 = r * r, k1 = -1.4426950408889634f * r;
                const f32x4 o0 = sw4(acc[ai][0][m][0], acc[ai][1][m][0], k1, r2), o1 = sw4(acc[ai][0][m][1], acc[ai][1][m][1], k1, r2);
                *(u32x4*)(O + (size_t)(row0 + ai * HALF + m * 16) * ldc + col0) = pack8(o0, o1); }
    }
};

template <class Epi, class Sched, bool ALIGN_EPI = false, bool SP2 = false>
__device__ __forceinline__ void gemm_phase(PG8_LAS unsigned char* lds, const Gemm g, const Sched& S, const Epi& E) {
    int tid_o = threadIdx.x; asm volatile("" : "+v"(tid_o));
    const int tid = tid_o, wid = __builtin_amdgcn_readfirstlane(tid >> 6), lane = tid & 63, wr = wid >> 2, wc = wid & 3, fr = lane & 15, fq = lane >> 4;
    const int K = g.K, nt = K / BK;
    unsigned voffA[2], voffB[2];
#pragma unroll
    for (int i = 0; i < 2; ++i) { int R, C; stage_rc(tid * 16 + i * 8192, R, C); const int Rb = Epi::PERM ? ((R & ~31) + perm32(R & 31)) : R;
        voffA[i] = (unsigned)(R * g.lda + C) * 2u; voffB[i] = (unsigned)(Rb * g.ldb + C) * 2u; }
    const size_t kstep = (size_t)(BK * 2);
    const size_t hstepA = (size_t)HALF * g.lda * 2, hstepB = (size_t)HALF * g.ldb * 2;
    const size_t tstepA = 2 * hstepA, tstepB = 2 * hstepB;
    const unsigned ldsw = (unsigned)wid * 1024u;
    const int aoff = lds_byte(wr * 64 + fr, fq * 8), boff = lds_byte(wc * 32 + fr, fq * 8);
#define PG8_SA(b, h) (((b) * 2 + (h)) * HTB)
#define PG8_SB(b, h) ((4 + (b) * 2 + (h)) * HTB)
#define PG8_STAGE(bufoff, gbase, voff) do { _Pragma("unroll") for (int _i = 0; _i < 2; ++_i) \
        __builtin_amdgcn_global_load_lds((const unsigned*)((const char*)(gbase) + (voff)[_i]), (PG8_LAS unsigned*)(lds + (bufoff) + ldsw + _i * 8192), 16, 0, 0); } while (0)
#define PG8_LDA(dst, b, h) do { _Pragma("unroll") for (int m = 0; m < 4; ++m) _Pragma("unroll") for (int k = 0; k < 2; ++k) dst[m][k] = *(const PG8_LAS bf16x8*)(lds + PG8_SA(b, h) + aoff + m * 2048 + k * 1024); } while (0)
#define PG8_LDB(dst, b, h) do { _Pragma("unroll") for (int n = 0; n < 2; ++n) _Pragma("unroll") for (int k = 0; k < 2; ++k) dst[n][k] = *(const PG8_LAS bf16x8*)(lds + PG8_SB(b, h) + boff + n * 2048 + k * 1024); } while (0)
#define PG8_MMA(ai, bj, At, Bt) do { __builtin_amdgcn_s_setprio(3); _Pragma("unroll") for (int m = 0; m < 4; ++m) _Pragma("unroll") for (int n = 0; n < 2; ++n) _Pragma("unroll") for (int k = 0; k < 2; ++k) \
        acc[ai][bj][m][n] = __builtin_amdgcn_mfma_f32_16x16x32_bf16(Bt[n][k], At[m][k], acc[ai][bj][m][n], 0, 0, 0); __builtin_amdgcn_s_setprio(0); } while (0)
#define PG8_WAIT_V(n) asm volatile("s_waitcnt vmcnt(" #n ")" ::: "memory")
#define PG8_WAIT_L(n) asm volatile("s_waitcnt lgkmcnt(" #n ")" ::: "memory")
#define PG8_BAR __builtin_amdgcn_s_barrier()
#define PG8_SCHED __builtin_amdgcn_sched_barrier(0)
    Unit cur, nxt; int ui = 0;
    if (!S.next(0, cur)) return;
    f32x4 acc[2][2][4][2];
#pragma unroll
    for (int a = 0; a < 2; ++a)
#pragma unroll
        for (int b = 0; b < 2; ++b)
#pragma unroll
            for (int m = 0; m < 4; ++m)
#pragma unroll
                for (int n = 0; n < 2; ++n) acc[a][b][m][n] = (f32x4){0.f, 0.f, 0.f, 0.f};
    bf16x8 At[4][2], B0[2][2], B1[2][2];
#define PG8_UA(u) ((const char*)g.A + (size_t)(u).pm * tstepA + (size_t)((u).pn / g.nNc) * g.ksplit_bytes)
#define PG8_UB(u) ((const char*)g.Bt + (size_t)((u).pn % g.nNc) * tstepB + (size_t)((u).pn / g.nNc) * g.ksplit_bytes)
    const char* cA = PG8_UA(cur); const char* cB = PG8_UB(cur);
    S.a_ready(cur);
    if constexpr (SP2) {
        PG8_STAGE(PG8_SB(0, 0), cB, voffB); PG8_STAGE(PG8_SB(0, 1), cB + hstepB, voffB); PG8_STAGE(PG8_SA(0, 0), cA, voffA); PG8_STAGE(PG8_SA(0, 1), cA + hstepA, voffA);
        if (wr == 1) PG8_BAR;
        PG8_WAIT_V(2); PG8_BAR;
        PG8_STAGE(PG8_SB(1, 0), cB + kstep, voffB); PG8_STAGE(PG8_SA(1, 0), cA + kstep, voffA); PG8_STAGE(PG8_SB(1, 1), cB + hstepB + kstep, voffB);
        PG8_WAIT_V(6); PG8_BAR;
    } else {
        PG8_STAGE(PG8_SB(0, 0), cB, voffB); PG8_STAGE(PG8_SA(0, 0), cA, voffA); PG8_STAGE(PG8_SB(0, 1), cB + hstepB, voffB); PG8_STAGE(PG8_SA(0, 1), cA + hstepA, voffA);
        if (wr == 1) PG8_BAR;
        PG8_WAIT_V(4); PG8_BAR;
        PG8_STAGE(PG8_SB(1, 0), cB + kstep, voffB); PG8_STAGE(PG8_SA(1, 0), cA + kstep, voffA); PG8_STAGE(PG8_SB(1, 1), cB + hstepB + kstep, voffB);
        PG8_WAIT_V(6); PG8_BAR;
    }
    for (;;) {
        const bool has_next = S.next(ui + 1, nxt);
        const char* nA = has_next ? PG8_UA(nxt) : cA; const char* nB = has_next ? PG8_UB(nxt) : cB;
        for (int t = 0; t < nt; t += 2) {
            const bool last = (t == nt - 2);
            const char* a1 = cA + (size_t)(t + 1) * kstep;
            const char* a2 = last ? nA : cA + (size_t)(t + 2) * kstep; const char* b2 = last ? nB : cB + (size_t)(t + 2) * kstep;
            const char* a3 = a2 + kstep; const char* b3 = b2 + kstep;
            if (last && has_next) S.a_ready(nxt);
            if constexpr (SP2) {
#define PG8_MM(ai) do { if constexpr (Epi::B0ONLY) { if (wc < 2) PG8_MMA(ai, 0, At, B0); } else { PG8_MMA(ai, 0, At, B0); PG8_MMA(ai, 1, At, B1); } } while (0)
#define PG8_LB1(b) do { if constexpr (!Epi::B0ONLY) PG8_LDB(B1, b, 1); } while (0)
            PG8_LDB(B0, 0, 0); PG8_LB1(0); PG8_SCHED; PG8_LDA(At, 0, 0); PG8_STAGE(PG8_SA(1, 1), a1 + hstepA, voffA);
            PG8_WAIT_V(8); PG8_WAIT_L(0); PG8_BAR; PG8_MM(0); PG8_BAR; PG8_SCHED;
            PG8_LDA(At, 0, 1); PG8_STAGE(PG8_SB(0, 0), b2, voffB); PG8_STAGE(PG8_SB(0, 1), b2 + hstepB, voffB); PG8_STAGE(PG8_SA(0, 0), a2, voffA);
            PG8_WAIT_V(8); PG8_WAIT_L(0); PG8_BAR; PG8_MM(1); PG8_BAR; PG8_SCHED;
            PG8_LDB(B0, 1, 0); PG8_LB1(1); PG8_SCHED; PG8_LDA(At, 1, 0); PG8_STAGE(PG8_SA(0, 1), a2 + hstepA, voffA);
            PG8_WAIT_V(8); PG8_WAIT_L(0); PG8_BAR; PG8_MM(0); PG8_BAR; PG8_SCHED;
            PG8_LDA(At, 1, 1); PG8_STAGE(PG8_SB(1, 0), b3, voffB); PG8_STAGE(PG8_SB(1, 1), b3 + hstepB, voffB); PG8_STAGE(PG8_SA(1, 0), a3, voffA);
            PG8_WAIT_V(8); PG8_WAIT_L(0); PG8_BAR; PG8_MM(1); PG8_BAR; PG8_SCHED;
#undef PG8_MM
#undef PG8_LB1
            } else {
            PG8_LDB(B0, 0, 0); PG8_SCHED; PG8_LDA(At, 0, 0); PG8_STAGE(PG8_SA(1, 1), a1 + hstepA, voffA);
            PG8_WAIT_L(8); PG8_BAR; PG8_WAIT_L(0); PG8_MMA(0, 0, At, B0); PG8_BAR; PG8_SCHED;
            PG8_LDB(B1, 0, 1); PG8_STAGE(PG8_SB(0, 0), b2, voffB);
            PG8_BAR; PG8_WAIT_L(0); PG8_MMA(0, 1, At, B1); PG8_BAR;
            PG8_LDA(At, 0, 1); PG8_STAGE(PG8_SA(0, 0), a2, voffA);
            PG8_BAR; PG8_WAIT_L(0); PG8_MMA(1, 0, At, B0); PG8_BAR; PG8_SCHED;
            PG8_STAGE(PG8_SB(0, 1), b2 + hstepB, voffB);
            PG8_WAIT_V(6); PG8_BAR; PG8_MMA(1, 1, At, B1); PG8_BAR;
            PG8_LDB(B0, 1, 0); PG8_SCHED; PG8_LDA(At, 1, 0); PG8_STAGE(PG8_SA(0, 1), a2 + hstepA, voffA);
            PG8_WAIT_L(8); PG8_BAR; PG8_WAIT_L(0); PG8_MMA(0, 0, At, B0); PG8_BAR; PG8_SCHED;
            PG8_LDB(B1, 1, 1); PG8_STAGE(PG8_SB(1, 0), b3, voffB);
            PG8_BAR; PG8_WAIT_L(0); PG8_MMA(0, 1, At, B1); PG8_BAR;
            PG8_LDA(At, 1, 1); PG8_STAGE(PG8_SA(1, 0), a3, voffA);
            PG8_BAR; PG8_WAIT_L(0); PG8_MMA(1, 0, At, B0); PG8_BAR; PG8_SCHED;
            PG8_STAGE(PG8_SB(1, 1), b3 + hstepB, voffB);
            PG8_WAIT_V(6); PG8_BAR; PG8_MMA(1, 1, At, B1); PG8_BAR;
            }
        }
        if constexpr (ALIGN_EPI) { if (wr == 0) PG8_BAR; }
#ifndef EPIX
#define EPIX 0
#endif
        if constexpr (!Epi::AFTER_DRAIN) { E(acc, cur, wr, wc, fr, fq); if constexpr (EPIX && !Epi::INPLACE) { asm volatile("" ::: "memory"); E(acc, cur, wr, wc, fr, fq); } S.done(cur); }
        if (!has_next) break;
#pragma unroll
        for (int a = 0; a < 2; ++a)
#pragma unroll
            for (int b = 0; b < 2; ++b)
#pragma unroll
                for (int m = 0; m < 4; ++m)
#pragma unroll
                    for (int n = 0; n < 2; ++n) acc[a][b][m][n] = (f32x4){0.f, 0.f, 0.f, 0.f};
        cur = nxt; cA = nA; cB = nB; ++ui;
        if constexpr (ALIGN_EPI) { if (wr == 1) PG8_BAR; }
    }
    PG8_WAIT_V(0);
    if constexpr (!ALIGN_EPI) { if (wr == 0) PG8_BAR; }
    PG8_BAR;
#undef PG8_UA
#undef PG8_UB
#undef PG8_SA
#undef PG8_SB
#undef PG8_STAGE
#undef PG8_LDA
#undef PG8_LDB
#undef PG8_MMA
#undef PG8_WAIT_V
#undef PG8_WAIT_L
#undef PG8_BAR
#undef PG8_SCHED
}
}

namespace att {
using bf16x8 = __attribute__((ext_vector_type(8))) short;
using s16x4 = __attribute__((ext_vector_type(4))) short;
using f32x16 = __attribute__((ext_vector_type(16))) float;
using u32x4 = __attribute__((ext_vector_type(4))) unsigned;
constexpr int NW = 8, QBLK = 32, KVBLK = 64;
constexpr float THR = 8.f;
constexpr int L_V = 0, SHM_V = 16384, L_K = 32768, SHM_KMAX = 24576, L_WS = 81920, L_TAB = 83968, L_QS = 86016, L_END = L_QS + 8 * 4096;
static_assert(L_END <= 131072, "attention LDS fits the ring region");
constexpr int OST_PITCH = 272, OST_WAVE = 32 * OST_PITCH;
static_assert(NW * OST_WAVE <= L_WS, "O staging fits under the scratch");
#define SBAR() __builtin_amdgcn_sched_barrier(0)
__device__ __forceinline__ int crow(int r, int hi) { return (r & 3) + 8 * (r >> 2) + 4 * hi; }
__device__ __forceinline__ unsigned cvtpk(float lo, float hi) { unsigned r; asm volatile("v_cvt_pk_bf16_f32 %0, %1, %2" : "=v"(r) : "v"(lo), "v"(hi)); return r; }

__device__ __forceinline__ void partialSM(f32x16& p0, f32x16& p1, float& m_reg, float& mn, float& alpha, const float C, const float thr_raw) {
  float pmax = p0[0];
#pragma unroll
  for (int r = 1; r < 16; ++r) pmax = fmaxf(pmax, p0[r]);
#pragma unroll
  for (int r = 0; r < 16; ++r) pmax = fmaxf(pmax, p1[r]);
  { auto rr = __builtin_amdgcn_permlane32_swap(__float_as_uint(pmax), __float_as_uint(pmax), false, false);
    pmax = fmaxf(__uint_as_float(rr[0]), __uint_as_float(rr[1])); }
  if (__builtin_expect(__all(pmax - m_reg <= thr_raw), 1)) { mn = m_reg; alpha = 1.f; }
  else { mn = fmaxf(m_reg, pmax); alpha = __builtin_amdgcn_exp2f((m_reg - mn) * C); m_reg = mn; }
  const float mnC = -mn * C;
#pragma unroll
  for (int r = 0; r < 16; ++r) p0[r] = fmaf(p0[r], C, mnC);
#pragma unroll
  for (int r = 0; r < 16; ++r) p1[r] = fmaf(p1[r], C, mnC);
#pragma unroll
  for (int r = 0; r < 16; ++r) p0[r] = __builtin_amdgcn_exp2f(p0[r]);
}
__device__ __forceinline__ void finishSM(f32x16& p0, f32x16& p1, float alpha, float& l_reg, bf16x8& pa0, bf16x8& pa1, bf16x8& pa2, bf16x8& pa3) {
#pragma unroll
  for (int r = 0; r < 16; ++r) p1[r] = __builtin_amdgcn_exp2f(p1[r]);
  float ps = 0;
#pragma unroll
  for (int r = 0; r < 16; ++r) ps += p0[r];
#pragma unroll
  for (int r = 0; r < 16; ++r) ps += p1[r];
  { auto rr = __builtin_amdgcn_permlane32_swap(__float_as_uint(ps), __float_as_uint(ps), false, false);
    ps = __uint_as_float(rr[0]) + __uint_as_float(rr[1]); }
  l_reg = l_reg * alpha + ps;
#define PK4(P, BASE, OUT) do { unsigned a0 = cvtpk(P[BASE + 0], P[BASE + 1]), a1 = cvtpk(P[BASE + 2], P[BASE + 3]);   \
    unsigned b0 = cvtpk(P[BASE + 4], P[BASE + 5]), b1 = cvtpk(P[BASE + 6], P[BASE + 7]);                              \
    auto r0 = __builtin_amdgcn_permlane32_swap(a0, b0, false, false); auto r1 = __builtin_amdgcn_permlane32_swap(a1, b1, false, false); \
    u32x4 w = {r0[0], r1[0], r0[1], r1[1]}; OUT = *reinterpret_cast<bf16x8*>(&w); } while (0)
  PK4(p0, 0, pa0); PK4(p0, 8, pa1); PK4(p1, 0, pa2); PK4(p1, 8, pa3);
#undef PK4
}
template <int DQK, int NQR> __device__ __forceinline__ void qkt(f32x16& p0, f32x16& p1, const char* Ks, const int (&kb)[4], const bf16x8* qr, const char* qs, int r32, int hi) {
  p0 = f32x16{}; p1 = f32x16{};
  constexpr int ROWB = DQK * 2;
#pragma unroll
  for (int d0 = 0; d0 < DQK / 16; ++d0) {
    bf16x8 b0 = *reinterpret_cast<const bf16x8*>(Ks + kb[d0 & 3] + (d0 >> 2) * 128);
    bf16x8 b1 = *reinterpret_cast<const bf16x8*>(Ks + kb[d0 & 3] + (d0 >> 2) * 128 + 32 * ROWB);
    bf16x8 qf; if (d0 < NQR) qf = qr[d0]; else qf = *reinterpret_cast<const bf16x8*>(qs + ((d0 - NQR) * 2 + hi) * 512 + r32 * 16);
    p0 = __builtin_amdgcn_mfma_f32_32x32x16_bf16(b0, qf, p0, 0, 0, 0);
    p1 = __builtin_amdgcn_mfma_f32_32x32x16_bf16(b1, qf, p1, 0, 0, 0); }
}
template <int DQK, int NQR> __device__ __forceinline__ void qkt_acc(f32x16& p0, f32x16& p1, const char* Ks, const int (&kb)[4], const bf16x8* qr, int r32, int hi) {
  constexpr int ROWB = DQK * 2; (void)r32; (void)hi;
#pragma unroll
  for (int d0 = 0; d0 < DQK / 16; ++d0) {
    bf16x8 b0 = *reinterpret_cast<const bf16x8*>(Ks + kb[d0 & 3] + (d0 >> 2) * 128);
    bf16x8 b1 = *reinterpret_cast<const bf16x8*>(Ks + kb[d0 & 3] + (d0 >> 2) * 128 + 32 * ROWB);
    p0 = __builtin_amdgcn_mfma_f32_32x32x16_bf16(b0, qr[d0], p0, 0, 0, 0);
    p1 = __builtin_amdgcn_mfma_f32_32x32x16_bf16(b1, qr[d0], p1, 0, 0, 0); }
}
__device__ __forceinline__ int v_st(int k, int c) { const int kk = (k & ~0xC) | ((k & 4) << 1) | ((k & 8) >> 1); return ((kk >> 3) * 4 + (c >> 5)) * 512 + ((kk & 7) * 32 + (c & 31)) * 2; }
__device__ __forceinline__ int v_rd_base(int lane) { return ((lane & 3) << 3) | (((lane >> 2) & 3) << 6) | (((lane >> 4) & 1) << 5) | (((lane >> 5) & 1) << 8); }
constexpr int v_rd_off(int d0, int ks, int half) { return d0 * 512 + ks * 4096 + half * 2048; }
template <int OFF> __device__ __forceinline__ s16x4 tr_read(int vb) {
  s16x4 r; asm volatile("ds_read_b64_tr_b16 %0, %1 offset:%2" : "=&v"(r) : "v"(vb), "i"(OFF) : "memory"); return r;
}
typedef short v4i16_t __attribute__((ext_vector_type(4)));
__device__ __forceinline__ s16x4 vtr(LAS const unsigned char* p) { return __builtin_bit_cast(s16x4, __builtin_amdgcn_ds_read_tr16_b64_v4i16((LAS v4i16_t*)p)); }
__device__ __forceinline__ void pv_d0v(f32x16* o, LAS const unsigned char* vp, bf16x8 pa0, bf16x8 pa1, bf16x8 pa2, bf16x8 pa3) {
#define PKV(L, H) (bf16x8){L[0], L[1], L[2], L[3], H[0], H[1], H[2], H[3]}
#pragma unroll
  for (int d0 = 0; d0 < 4; ++d0) {
    const s16x4 l0 = vtr(vp + v_rd_off(d0, 0, 0)), h0 = vtr(vp + v_rd_off(d0, 0, 1)), l1 = vtr(vp + v_rd_off(d0, 1, 0)), h1 = vtr(vp + v_rd_off(d0, 1, 1));
    const s16x4 l2 = vtr(vp + v_rd_off(d0, 2, 0)), h2 = vtr(vp + v_rd_off(d0, 2, 1)), l3 = vtr(vp + v_rd_off(d0, 3, 0)), h3 = vtr(vp + v_rd_off(d0, 3, 1));
    o[d0] = __builtin_amdgcn_mfma_f32_32x32x16_bf16(pa0, PKV(l0, h0), o[d0], 0, 0, 0);
    o[d0] = __builtin_amdgcn_mfma_f32_32x32x16_bf16(pa1, PKV(l1, h1), o[d0], 0, 0, 0);
    o[d0] = __builtin_amdgcn_mfma_f32_32x32x16_bf16(pa2, PKV(l2, h2), o[d0], 0, 0, 0);
    o[d0] = __builtin_amdgcn_mfma_f32_32x32x16_bf16(pa3, PKV(l3, h3), o[d0], 0, 0, 0); }
#undef PKV
}
template <int D0> __device__ __forceinline__ void pv_one(f32x16& od, int vb, bf16x8 pa0, bf16x8 pa1, bf16x8 pa2, bf16x8 pa3) {
  const s16x4 l0 = tr_read<v_rd_off(D0, 0, 0)>(vb), h0 = tr_read<v_rd_off(D0, 0, 1)>(vb), l1 = tr_read<v_rd_off(D0, 1, 0)>(vb), h1 = tr_read<v_rd_off(D0, 1, 1)>(vb);
  const s16x4 l2 = tr_read<v_rd_off(D0, 2, 0)>(vb), h2 = tr_read<v_rd_off(D0, 2, 1)>(vb), l3 = tr_read<v_rd_off(D0, 3, 0)>(vb), h3 = tr_read<v_rd_off(D0, 3, 1)>(vb);
  asm volatile("s_waitcnt lgkmcnt(0)" ::: "memory"); SBAR();
#define PK(L, H) (bf16x8){L[0], L[1], L[2], L[3], H[0], H[1], H[2], H[3]}
  od = __builtin_amdgcn_mfma_f32_32x32x16_bf16(pa0, PK(l0, h0), od, 0, 0, 0);
  od = __builtin_amdgcn_mfma_f32_32x32x16_bf16(pa1, PK(l1, h1), od, 0, 0, 0);
  od = __builtin_amdgcn_mfma_f32_32x32x16_bf16(pa2, PK(l2, h2), od, 0, 0, 0);
  od = __builtin_amdgcn_mfma_f32_32x32x16_bf16(pa3, PK(l3, h3), od, 0, 0, 0);
#undef PK
}
__device__ __forceinline__ void pv_d0(f32x16* o, int vb, bf16x8 pa0, bf16x8 pa1, bf16x8 pa2, bf16x8 pa3) {
  pv_one<0>(o[0], vb, pa0, pa1, pa2, pa3); pv_one<1>(o[1], vb, pa0, pa1, pa2, pa3); pv_one<2>(o[2], vb, pa0, pa1, pa2, pa3); pv_one<3>(o[3], vb, pa0, pa1, pa2, pa3);
}

struct MaskNone { __device__ __forceinline__ void apply(f32x16&, f32x16&, int, int) const {} __device__ __forceinline__ bool active(int, int) const { return true; } };
struct MaskA {
  int qoff, lo, hi_; float sl;
  __device__ __forceinline__ bool active(int t, int w) const { return 64 * t + 63 >= 32 * w && 64 * t <= 32 * w + 287; }
  __device__ __forceinline__ void apply(f32x16& p0, f32x16& p1, int kt, int hi) const {
    int base = qoff + 64 * kt + 4 * hi; asm volatile("" : "+v"(base));
    const float bf = (float)base, bm = bf - 0.5f * (float)(lo + hi_), hw = 0.5f * (float)(hi_ - lo);
#pragma unroll
    for (int r = 0; r < 16; ++r) { const float c0 = (float)((r & 3) + 8 * (r >> 2)), c1 = c0 + 32.f;
      const float v0 = __builtin_fmaf(-sl, __builtin_fabsf(bf + c0), p0[r]), v1 = __builtin_fmaf(-sl, __builtin_fabsf(bf + c1), p1[r]);
      p0[r] = __builtin_fabsf(bm + c0) <= hw ? v0 : -1e30f; p1[r] = __builtin_fabsf(bm + c1) <= hw ? v1 : -1e30f; }
  }
};
struct MaskB {
  int qr, qc, kr0, rs, cs; const float* tab;
  __device__ __forceinline__ bool active(int t, int) const { const int kr = kr0 + t; return __builtin_amdgcn_readfirstlane((int)(kr >= rs && kr <= rs + 7)) != 0; }
  __device__ __forceinline__ void apply(f32x16& p0, f32x16& p1, int kt, int hi) const {
    const int dr = kr0 + kt - qr + 7;
    int dbase = 4 * hi - qc + 15; asm volatile("" : "+v"(dbase));
    int cb = 4 * hi - cs; asm volatile("" : "+v"(cb));
    const float* tp = tab + dr * 31 + dbase;
    float t0[16], t1[16];
#pragma unroll
    for (int r = 0; r < 16; ++r) { const int c = (r & 3) + 8 * (r >> 2); t0[r] = tp[c]; t1[r] = tp[c + 32]; }
#pragma unroll
    for (int r = 0; r < 16; ++r) asm volatile("" : "+v"(t0[r]), "+v"(t1[r]));
#pragma unroll
    for (int r = 0; r < 16; ++r) { const int c = (r & 3) + 8 * (r >> 2);
      p0[r] = (unsigned)(cb + c) < 16u ? p0[r] + t0[r] : -1e30f; p1[r] = (unsigned)(cb + c + 32) < 16u ? p1[r] + t1[r] : -1e30f; }
  }
};

template <int DQK, class MK>
__device__ __forceinline__ void attn_unit(const bf16_t* __restrict__ Q, long q_row0, int ldq, const bf16_t* __restrict__ K, int ldk, const bf16_t* __restrict__ V, int ldv,
                                          long k_row0, long kmin, long kmax, int NT, bf16_t* __restrict__ O, int ldo, const float Cs, const float m0, const float l0, const MK& mk, char* lds) {
  int tid_o = threadIdx.x; asm volatile("" : "+v"(tid_o));
  const int tid = tid_o, wid = tid >> 6, lane = tid & 63, r32 = lane & 31, hi = lane >> 5;
  constexpr int ROWB = DQK * 2, SHM_K = 64 * ROWB, KN = DQK / 64, CPR = DQK / 8;
  char* V_lds = lds + L_V; char* K_lds = lds + L_K;
  float* ws = (float*)(lds + L_WS) + wid * 64; float* li_l = ws; float* al_l = ws + 32;
  const float thr_raw = THR / (Cs * 0.6931471805599453f);
  constexpr int NQR = DQK / 16;
  float m_reg = m0, l_reg = l0; f32x16 o[4] = {}; bf16x8 qr[NQR];
  char* qs = lds + L_QS + wid * 4096;
  const bf16_t* Qw = Q + (q_row0 + wid * QBLK + r32) * ldq + hi * 8;
#pragma unroll
  for (int d0 = 0; d0 < NQR; ++d0) qr[d0] = *reinterpret_cast<const bf16x8*>(Qw + d0 * 16);
  if constexpr (NQR < DQK / 16) {
#pragma unroll
    for (int d0 = NQR; d0 < DQK / 16; ++d0) *reinterpret_cast<bf16x8*>(qs + ((d0 - NQR) * 2 + hi) * 512 + r32 * 16) = *reinterpret_cast<const bf16x8*>(Qw + d0 * 16);
  }
  const int sr = tid >> 4, sc = (tid & 15) * 8, vst0 = v_st(sr, sc), vst1 = v_st(32 + sr, sc);
  const int voff0 = sr * ldv + sc, voff1 = (32 + sr) * ldv + sc;
  int koff[KN], kst[KN];
#pragma unroll
  for (int i = 0; i < KN; ++i) { const int id = tid + 512 * i, kr = id / CPR, kc = (id % CPR) * 8; koff[i] = kr * ldk + kc; kst[i] = kr * ROWB + ((kc * 2) ^ ((kr & 7) << 4)); }
  const int vb0 = (int)(uintptr_t)V_lds + v_rd_base(lane);
  int kb[4];
#pragma unroll
  for (int e = 0; e < 4; ++e) { kb[e] = r32 * ROWB + ((e * 32 + hi * 16) ^ ((r32 & 7) << 4)); asm volatile("" : "+v"(kb[e])); }
  bf16x8 vs0, vs1, ks[KN];
#define SLOAD(t) do { long _r0 = k_row0 + (long)(t) * KVBLK; _r0 = _r0 < kmin ? kmin : (_r0 > kmax - 63 ? kmax - 63 : _r0); \
    const bf16_t* _Vt = V + _r0 * ldv; const bf16_t* _Kt = K + _r0 * ldk; \
    vs0 = *reinterpret_cast<const bf16x8*>(_Vt + voff0); vs1 = *reinterpret_cast<const bf16x8*>(_Vt + voff1); \
    _Pragma("unroll") for (int _k = 0; _k < KN; ++_k) ks[_k] = *reinterpret_cast<const bf16x8*>(_Kt + koff[_k]); } while (0)
#define SWRITE(b) do { *(bf16x8*)(V_lds + (b) * SHM_V + vst0) = vs0; *(bf16x8*)(V_lds + (b) * SHM_V + vst1) = vs1; \
    _Pragma("unroll") for (int _k = 0; _k < KN; ++_k) *(bf16x8*)(K_lds + (b) * SHM_K + kst[_k]) = ks[_k]; } while (0)
  SLOAD(0); SWRITE(0); __syncthreads();
  for (int t = 0; t < NT; ++t) {
    const int cb = t & 1;
    if (t + 1 < NT) SLOAD(t + 1);
    if (mk.active(t, __builtin_amdgcn_readfirstlane(wid))) {
    f32x16 p0, p1;
    qkt<DQK, NQR>(p0, p1, K_lds + cb * SHM_K, kb, qr, qs, r32, hi);
    mk.apply(p0, p1, t, hi);
    float pmax = p0[0];
#pragma unroll
    for (int r = 1; r < 16; ++r) pmax = fmaxf(pmax, p0[r]);
#pragma unroll
    for (int r = 0; r < 16; ++r) pmax = fmaxf(pmax, p1[r]);
    { auto rr = __builtin_amdgcn_permlane32_swap(__float_as_uint(pmax), __float_as_uint(pmax), false, false);
      pmax = fmaxf(__uint_as_float(rr[0]), __uint_as_float(rr[1])); }
    if (!__all(pmax - m_reg <= thr_raw)) {
      const float mn = fmaxf(m_reg, pmax); const float alpha = __builtin_amdgcn_exp2f((m_reg - mn) * Cs); m_reg = mn; l_reg *= alpha;
      if (hi == 0) al_l[r32] = alpha; asm volatile("s_waitcnt lgkmcnt(0)" ::: "memory");
#pragma unroll
      for (int d = 0; d < 4; ++d)
#pragma unroll
        for (int r = 0; r < 16; ++r) o[d][r] *= al_l[crow(r, hi)];
    }
    const float mnC = -m_reg * Cs;
#pragma unroll
    for (int r = 0; r < 16; ++r) { p0[r] = __builtin_amdgcn_exp2f(fmaf(p0[r], Cs, mnC)); p1[r] = __builtin_amdgcn_exp2f(fmaf(p1[r], Cs, mnC)); }
    float ps = 0;
#pragma unroll
    for (int r = 0; r < 16; ++r) ps += p0[r] + p1[r];
    { auto rr = __builtin_amdgcn_permlane32_swap(__float_as_uint(ps), __float_as_uint(ps), false, false);
      ps = __uint_as_float(rr[0]) + __uint_as_float(rr[1]); }
    l_reg += ps;
    bf16x8 pa0, pa1, pa2, pa3;
#define PK4(P, BASE, OUT) do { unsigned a0 = cvtpk(P[BASE + 0], P[BASE + 1]), a1 = cvtpk(P[BASE + 2], P[BASE + 3]);   \
    unsigned b0 = cvtpk(P[BASE + 4], P[BASE + 5]), b1 = cvtpk(P[BASE + 6], P[BASE + 7]);                              \
    auto r0 = __builtin_amdgcn_permlane32_swap(a0, b0, false, false); auto r1 = __builtin_amdgcn_permlane32_swap(a1, b1, false, false); \
    u32x4 w = {r0[0], r1[0], r0[1], r1[1]}; OUT = *reinterpret_cast<bf16x8*>(&w); } while (0)
    PK4(p0, 0, pa0); PK4(p0, 8, pa1); PK4(p1, 0, pa2); PK4(p1, 8, pa3);
#undef PK4
    pv_d0(o, vb0 + cb * SHM_V, pa0, pa1, pa2, pa3);
    }
    if (t + 1 < NT) SWRITE(cb ^ 1);
    __syncthreads();
  }
  if (hi == 0) li_l[r32] = l_reg; asm volatile("s_waitcnt lgkmcnt(0)" ::: "memory");
  float rli[16];
#pragma unroll
  for (int r = 0; r < 16; ++r) rli[r] = __builtin_amdgcn_rcpf(li_l[crow(r, hi)]);
  char* ost = lds + wid * OST_WAVE;
  const bool odd = lane & 1;
#pragma unroll
  for (int d0 = 0; d0 < 4; ++d0)
#pragma unroll
    for (int r = 0; r < 16; r += 2) {
      const float a = o[d0][r] * rli[r], b = o[d0][r + 1] * rli[r + 1];
      const float snd = odd ? a : b; const float rcv = __builtin_bit_cast(float, __builtin_amdgcn_mov_dpp(__builtin_bit_cast(int, snd), 0xB1, 0xF, 0xF, true));
      const float wlo = odd ? rcv : a, whi = odd ? b : rcv;
      const unsigned w = cvtpk(wlo, whi);
      const int row = crow(r, hi) + (odd ? 1 : 0), col = d0 * 32 + (r32 & ~1);
      *(unsigned*)(ost + row * OST_PITCH + col * 2) = w; }
  asm volatile("s_waitcnt lgkmcnt(0)" ::: "memory");
  bf16_t* Ow = O + (q_row0 + wid * QBLK) * ldo;
#pragma unroll
  for (int it = 0; it < 8; ++it) { const int id = it * 64 + lane, row = id >> 4, c16 = id & 15;
    const u32x4 v = *(const u32x4*)(ost + row * OST_PITCH + c16 * 16);
    *(u32x4*)(Ow + (long)row * ldo + c16 * 8) = v; }
  __syncthreads();
#undef SLOAD
#undef SWRITE
}

__device__ __forceinline__ void glds16_asm(const void* gsrc, unsigned lds_dst) { unsigned keep;
  asm volatile("s_mov_b32 %0, m0\n\ts_mov_b32 m0, %2\n\ts_nop 0\n\tglobal_load_lds_dwordx4 %1, off\n\ts_mov_b32 m0, %0" : "=&s"(keep) : "v"(gsrc), "s"(lds_dst) : "memory"); }
template <int DQK, class MK>
__device__ __forceinline__ void attn_unit_dma(const bf16_t* __restrict__ Q, long q_row0, int ldq, const bf16_t* __restrict__ K, int ldk, const bf16_t* __restrict__ V, int ldv,
                                              long k_row0, long kmin, long kmax, int NT, bf16_t* __restrict__ O, int ldo, const float Cs, const float m0, const float l0, const MK& mk, char* lds, LAS unsigned char* ldsl) {
  int tid_o = threadIdx.x; asm volatile("" : "+v"(tid_o));
  const int tid = tid_o, wid = tid >> 6, lane = tid & 63, r32 = lane & 31, hi = lane >> 5;
  const int widu = __builtin_amdgcn_readfirstlane(wid);
  constexpr int ROWB = DQK * 2, SHM_K = 64 * ROWB, KN = SHM_K / 8192, CPR = DQK / 8;
  constexpr int D_V = 0, D_K = 3 * SHM_V, D_WS = 122880;
  static_assert(D_K + 3 * SHM_K <= D_WS, "rings fit");
  char* V_lds = lds + D_V; char* K_lds = lds + D_K; const unsigned lds0 = (unsigned)(uintptr_t)ldsl;
  float* ws = (float*)(lds + D_WS) + wid * 64; float* li_l = ws; float* al_l = ws + 32;
  const float thr_raw = THR / (Cs * 0.6931471805599453f);
  constexpr int NQR = DQK / 16;
  float m_reg = m0, l_reg = l0; f32x16 o[4] = {}; bf16x8 qr[NQR];
  int ksrc[KN], vsrc[2];
#pragma unroll
  for (int i = 0; i < KN; ++i) { const int c = (wid * KN + i) * 64 + lane, row = c / CPR, ccd = c % CPR, cc = (ccd & ~7) | ((ccd & 7) ^ (row & 7)); ksrc[i] = row * ldk + cc * 8; }
#pragma unroll
  for (int i = 0; i < 2; ++i) { const int ci = (wid * 2 + i) * 64 + lane, sub = ci >> 5, within = ci & 31, kk = (sub >> 2) * 8 + (within >> 2), k = (kk & ~0xC) | ((kk & 4) << 1) | ((kk & 8) >> 1), c = (sub & 3) * 32 + (within & 3) * 8;
    vsrc[i] = k * ldv + c; }
#define DMA(t, b) do { long _r0 = k_row0 + (long)(t) * KVBLK; _r0 = _r0 < kmin ? kmin : (_r0 > kmax - 63 ? kmax - 63 : _r0); \
    const bf16_t* _Vt = V + _r0 * ldv; const bf16_t* _Kt = K + _r0 * ldk; \
    _Pragma("unroll") for (int _k = 0; _k < KN; ++_k) glds16_asm(_Kt + ksrc[_k], (unsigned)__builtin_amdgcn_readfirstlane((int)(lds0 + D_K + (b) * SHM_K + (widu * KN + _k) * 1024))); \
    _Pragma("unroll") for (int _k = 0; _k < 2; ++_k) glds16_asm(_Vt + vsrc[_k], (unsigned)__builtin_amdgcn_readfirstlane((int)(lds0 + D_V + (b) * SHM_V + (widu * 2 + _k) * 1024))); } while (0)
  DMA(0, 0); DMA(1, 1);
  const bf16_t* Qw = Q + (q_row0 + wid * QBLK + r32) * ldq + hi * 8;
#pragma unroll
  for (int d0 = 0; d0 < NQR; ++d0) qr[d0] = *reinterpret_cast<const bf16x8*>(Qw + d0 * 16);
  LAS const unsigned char* vpl = ldsl + D_V + v_rd_base(lane);
  int kb[4];
#pragma unroll
  for (int e = 0; e < 4; ++e) { kb[e] = r32 * ROWB + ((e * 32 + hi * 16) ^ ((r32 & 7) << 4)); asm volatile("" : "+v"(kb[e])); }
#pragma unroll
  for (int d0 = 0; d0 < NQR; ++d0) asm volatile("" : "+v"(qr[d0]));
  asm volatile("s_waitcnt vmcnt(0) lgkmcnt(0)" ::: "memory"); __builtin_amdgcn_s_barrier(); asm volatile("" ::: "memory");
  if (widu >= 4) __builtin_amdgcn_s_setprio(1);
  int cb = 0;
  for (int t = 0; t < NT; ++t) {
    const bool more = t + 2 < NT; int nb = cb + 2; nb = nb >= 3 ? nb - 3 : nb;
    if (more) DMA(t + 2, nb);
    if (mk.active(t, widu)) {
    f32x16 p0, p1;
    qkt<DQK, NQR>(p0, p1, K_lds + cb * SHM_K, kb, qr, nullptr, r32, hi);
    mk.apply(p0, p1, t, hi);
    float pmax = p0[0];
#pragma unroll
    for (int r = 1; r < 16; ++r) pmax = fmaxf(pmax, p0[r]);
#pragma unroll
    for (int r = 0; r < 16; ++r) pmax = fmaxf(pmax, p1[r]);
    { auto rr = __builtin_amdgcn_permlane32_swap(__float_as_uint(pmax), __float_as_uint(pmax), false, false);
      pmax = fmaxf(__uint_as_float(rr[0]), __uint_as_float(rr[1])); }
    if (!__all(pmax - m_reg <= thr_raw)) {
      const float mn = fmaxf(m_reg, pmax); const float alpha = __builtin_amdgcn_exp2f((m_reg - mn) * Cs); m_reg = mn; l_reg *= alpha;
      if (hi == 0) al_l[r32] = alpha; asm volatile("s_waitcnt lgkmcnt(0)" ::: "memory");
#pragma unroll
      for (int d = 0; d < 4; ++d)
#pragma unroll
        for (int r = 0; r < 16; ++r) o[d][r] *= al_l[crow(r, hi)];
    }
    const float mnC = -m_reg * Cs;
#pragma unroll
    for (int r = 0; r < 16; ++r) { p0[r] = __builtin_amdgcn_exp2f(fmaf(p0[r], Cs, mnC)); p1[r] = __builtin_amdgcn_exp2f(fmaf(p1[r], Cs, mnC)); }
    float ps = 0;
#pragma unroll
    for (int r = 0; r < 16; ++r) ps += p0[r] + p1[r];
    { auto rr = __builtin_amdgcn_permlane32_swap(__float_as_uint(ps), __float_as_uint(ps), false, false);
      ps = __uint_as_float(rr[0]) + __uint_as_float(rr[1]); }
    l_reg += ps;
    bf16x8 pa0, pa1, pa2, pa3;
#define PK4(P, BASE, OUT) do { unsigned a0 = cvtpk(P[BASE + 0], P[BASE + 1]), a1 = cvtpk(P[BASE + 2], P[BASE + 3]);   \
    unsigned b0 = cvtpk(P[BASE + 4], P[BASE + 5]), b1 = cvtpk(P[BASE + 6], P[BASE + 7]);                              \
    auto r0 = __builtin_amdgcn_permlane32_swap(a0, b0, false, false); auto r1 = __builtin_amdgcn_permlane32_swap(a1, b1, false, false); \
    u32x4 w = {r0[0], r1[0], r0[1], r1[1]}; OUT = *reinterpret_cast<bf16x8*>(&w); } while (0)
    PK4(p0, 0, pa0); PK4(p0, 8, pa1); PK4(p1, 0, pa2); PK4(p1, 8, pa3);
#undef PK4
    pv_d0v(o, vpl + cb * SHM_V, pa0, pa1, pa2, pa3);
    }
    if (more) { if constexpr (KN == 3) asm volatile("s_waitcnt vmcnt(5)" ::: "memory"); else asm volatile("s_waitcnt vmcnt(4)" ::: "memory"); }
    else asm volatile("s_waitcnt vmcnt(0)" ::: "memory");
    asm volatile("s_waitcnt lgkmcnt(0)" ::: "memory"); __builtin_amdgcn_s_barrier(); asm volatile("" ::: "memory");
    cb = cb == 2 ? 0 : cb + 1;
  }
  __builtin_amdgcn_s_setprio(0);
  if (hi == 0) li_l[r32] = l_reg; asm volatile("s_waitcnt lgkmcnt(0)" ::: "memory");
  float rli[16];
#pragma unroll
  for (int r = 0; r < 16; ++r) rli[r] = __builtin_amdgcn_rcpf(li_l[crow(r, hi)]);
  char* ost = lds + wid * OST_WAVE;
  const bool odd = lane & 1;
#pragma unroll
  for (int d0 = 0; d0 < 4; ++d0)
#pragma unroll
    for (int r = 0; r < 16; r += 2) {
      const float a = o[d0][r] * rli[r], b = o[d0][r + 1] * rli[r + 1];
      const float snd = odd ? a : b; const float rcv = __builtin_bit_cast(float, __builtin_amdgcn_mov_dpp(__builtin_bit_cast(int, snd), 0xB1, 0xF, 0xF, true));
      const float wlo = odd ? rcv : a, whi = odd ? b : rcv;
      const unsigned w = cvtpk(wlo, whi);
      const int row = crow(r, hi) + (odd ? 1 : 0), col = d0 * 32 + (r32 & ~1);
      *(unsigned*)(ost + row * OST_PITCH + col * 2) = w; }
  asm volatile("s_waitcnt lgkmcnt(0)" ::: "memory");
  bf16_t* Ow = O + (q_row0 + wid * QBLK) * ldo;
#pragma unroll
  for (int it = 0; it < 8; ++it) { const int id = it * 64 + lane, row = id >> 4, c16 = id & 15;
    const u32x4 v = *(const u32x4*)(ost + row * OST_PITCH + c16 * 16);
    *(u32x4*)(Ow + (long)row * ldo + c16 * 8) = v; }
  asm volatile("s_waitcnt lgkmcnt(0)" ::: "memory"); __builtin_amdgcn_s_barrier(); asm volatile("" ::: "memory");
#undef DMA
}

typedef __bf16 bf16x2_t __attribute__((ext_vector_type(2)));
typedef float f32x2_t __attribute__((ext_vector_type(2)));
__device__ __forceinline__ unsigned cvtpk_v(float lo, float hi) { f32x2_t v = {lo, hi}; bf16x2_t b = __builtin_convertvector(v, bf16x2_t); return __builtin_bit_cast(unsigned, b); }
#define PINV(x) asm volatile("" : "+v"(x))
#define MX3(a, b, c) __builtin_fmaxf(__builtin_fmaxf((a), (b)), (c))
template <int DQK, class MK>
__device__ __forceinline__ void attn_unit_c(const bf16_t* __restrict__ Q, long q_row0, int ldq, const bf16_t* __restrict__ K, int ldk, const bf16_t* __restrict__ V, int ldv,
                                              long k_row0, long kmin, long kmax, int NT, bf16_t* __restrict__ O, int ldo, const float Cs, const float m0, const float l0, const MK& mk, char* lds, LAS unsigned char* ldsl) {
  int tid_o = threadIdx.x; asm volatile("" : "+v"(tid_o));
  const int tid = tid_o, wid = tid >> 6, lane = tid & 63, r32 = lane & 31, hi = lane >> 5;
  const int widu = __builtin_amdgcn_readfirstlane(wid);
  constexpr int ROWB = DQK * 2, SHM_K = 64 * ROWB, KN = SHM_K / 8192, CPR = DQK / 8;
  constexpr int D_V = 0, D_K = 3 * SHM_V, D_WS = 122880;
  static_assert(D_K + 3 * SHM_K <= D_WS, "rings fit"); static_assert(DQK == 192, "the gap schedule below is written for 12 Q fragments");
  char* K_lds = lds + D_K; const unsigned lds0 = (unsigned)(uintptr_t)ldsl;
  float* ws = (float*)(lds + D_WS) + wid * 64; float* li_l = ws; float* al_l = ws + 32;
  constexpr int NQR = DQK / 16;
  (void)m0; (void)l0; (void)Cs; (void)mk; float m_reg = 0.f, l_reg = 0.f; f32x16 o[4] = {}; f32x16 negm = {}; bf16x8 qr[NQR];
  const float thr2 = THR * 1.4426950408889634f;
  int ksrc[KN], vsrc[2];
#pragma unroll
  for (int i = 0; i < KN; ++i) { const int c = (wid * KN + i) * 64 + lane, row = c / CPR, ccd = c % CPR, cc = (ccd & ~7) | ((ccd & 7) ^ (row & 7)); ksrc[i] = row * ldk + cc * 8; }
#pragma unroll
  for (int i = 0; i < 2; ++i) { const int ci = (wid * 2 + i) * 64 + lane, sub = ci >> 5, within = ci & 31, kk = (sub >> 2) * 8 + (within >> 2), k = (kk & ~0xC) | ((kk & 4) << 1) | ((kk & 8) >> 1), c = (sub & 3) * 32 + (within & 3) * 8;
    vsrc[i] = k * ldv + c; }
#define DMA(t, b) do { long _r0 = k_row0 + (long)(t) * KVBLK; _r0 = _r0 < kmin ? kmin : (_r0 > kmax - 63 ? kmax - 63 : _r0); \
    const bf16_t* _Vt = V + _r0 * ldv; const bf16_t* _Kt = K + _r0 * ldk; \
    _Pragma("unroll") for (int _k = 0; _k < KN; ++_k) glds16_asm(_Kt + ksrc[_k], (unsigned)__builtin_amdgcn_readfirstlane((int)(lds0 + D_K + (b) * SHM_K + (widu * KN + _k) * 1024))); \
    _Pragma("unroll") for (int _k = 0; _k < 2; ++_k) glds16_asm(_Vt + vsrc[_k], (unsigned)__builtin_amdgcn_readfirstlane((int)(lds0 + D_V + (b) * SHM_V + (widu * 2 + _k) * 1024))); } while (0)
  DMA(0, 0); DMA(1, 1);
  const bf16_t* Qw = Q + (q_row0 + wid * QBLK + r32) * ldq + hi * 8;
#pragma unroll
  for (int d0 = 0; d0 < NQR; ++d0) qr[d0] = *reinterpret_cast<const bf16x8*>(Qw + d0 * 16);
  LAS const unsigned char* vp0 = ldsl + D_V + v_rd_base(lane);
  int kb[4];
#pragma unroll
  for (int e = 0; e < 4; ++e) { kb[e] = r32 * ROWB + ((e * 32 + hi * 16) ^ ((r32 & 7) << 4)); asm volatile("" : "+v"(kb[e])); }
#pragma unroll
  for (int d0 = 0; d0 < NQR; ++d0) asm volatile("" : "+v"(qr[d0]));
  asm volatile("s_waitcnt vmcnt(0) lgkmcnt(0)" ::: "memory"); __builtin_amdgcn_s_barrier(); asm volatile("" ::: "memory");
#define MF(a, b, c) __builtin_amdgcn_mfma_f32_32x32x16_bf16(a, b, c, 0, 0, 0)
#define KFR(i) (*reinterpret_cast<const bf16x8*>(Kc + kb[((i) % 12) & 3] + (((i) % 12) >> 2) * 128 + ((i) >= 12 ? 32 * ROWB : 0)))
#define KFRN(i) (*reinterpret_cast<const bf16x8*>(Kn + kb[(i) & 3]))
#define GQ(i, CH, CIN, FILL) do { if ((i) + 3 < 24) kf[((i) + 3) & 3] = KFR((i) + 3); CH = MF(kf[(i) & 3], qr[(i) % 12], CIN); FILL; SBAR(); } while (0)
#define VFR(s) (bf16x8){vl[s][0], vl[s][1], vl[s][2], vl[s][3], vh[s][0], vh[s][1], vh[s][2], vh[s][3]}
#define VRD(j) do { vl[(j) % 3] = vtr(vpc + v_rd_off((j) & 3, (j) >> 2, 0)); vh[(j) % 3] = vtr(vpc + v_rd_off((j) & 3, (j) >> 2, 1)); } while (0)
#define GP(j, PA, FILL) do { if ((j) + 2 < 16) VRD((j) + 2); o[(j) & 3] = MF(PA, VFR((j) % 3), o[(j) & 3]); FILL; SBAR(); } while (0)
#define EX2(x) __builtin_amdgcn_exp2f(x)
#define PREP(P, B, W) do { P[B] = EX2(P[B]); P[(B) + 1] = EX2(P[(B) + 1]); rs += P[B]; rs += P[(B) + 1]; W = cvtpk_v(P[B], P[(B) + 1]); PINV(rs); PINV(W); } while (0)
#define PKSW(OUT) do { auto r0_ = __builtin_amdgcn_permlane32_swap(wa0, wb0, false, false); auto r1_ = __builtin_amdgcn_permlane32_swap(wa1, wb1, false, false); \
    u32x4 w_ = {r0_[0], r1_[0], r0_[1], r1_[1]}; OUT = *reinterpret_cast<bf16x8*>(&w_); PINV(OUT); } while (0)
  if (widu >= 4) __builtin_amdgcn_s_setprio(1);
  int cb = 0;
  bf16x8 kf[4];
  { const char* Kc = K_lds; kf[0] = KFR(0); kf[1] = KFR(1); kf[2] = KFR(2); }
  for (int t = 0; t < NT; ++t) {
    const bool more = t + 2 < NT; int nb = cb + 2; nb = nb >= 3 ? nb - 3 : nb; int n1 = cb + 1; n1 = n1 >= 3 ? n1 - 3 : n1;
    if (more) DMA(t + 2, nb);
    const char* Kc = K_lds + cb * SHM_K; const char* Kn = K_lds + n1 * SHM_K; LAS const unsigned char* vpc = vp0 + cb * SHM_V;
    f32x16 p0, p1; s16x4 vl[3], vh[3]; float mx;
    SBAR();
    GQ(0, p0, negm, ); GQ(1, p0, p0, ); GQ(2, p0, p0, ); GQ(3, p0, p0, ); GQ(4, p0, p0, ); GQ(5, p0, p0, );
    GQ(6, p0, p0, ); GQ(7, p0, p0, ); GQ(8, p0, p0, ); GQ(9, p0, p0, ); GQ(10, p0, p0, ); GQ(11, p0, p0, );
    GQ(12, p1, negm, );
    GQ(13, p1, p1, mx = MX3(p0[0], p0[1], p0[2]); PINV(mx));
    GQ(14, p1, p1, mx = MX3(mx, p0[3], p0[4]); PINV(mx));   GQ(15, p1, p1, mx = MX3(mx, p0[5], p0[6]); PINV(mx));
    GQ(16, p1, p1, mx = MX3(mx, p0[7], p0[8]); PINV(mx));   GQ(17, p1, p1, mx = MX3(mx, p0[9], p0[10]); PINV(mx));
    GQ(18, p1, p1, mx = MX3(mx, p0[11], p0[12]); PINV(mx)); GQ(19, p1, p1, mx = MX3(mx, p0[13], p0[14]); PINV(mx));
    GQ(20, p1, p1, mx = __builtin_fmaxf(mx, p0[15]); PINV(mx));
    GQ(21, p1, p1, ); GQ(22, p1, p1, );
    GQ(23, p1, p1, VRD(0); VRD(1));
    float pmax = MX3(mx, p1[0], p1[1]);
#pragma unroll
    for (int r = 2; r < 16; r += 2) pmax = MX3(pmax, p1[r], p1[r + 1]);
    { auto rr = __builtin_amdgcn_permlane32_swap(__float_as_uint(pmax), __float_as_uint(pmax), false, false);
      pmax = fmaxf(__uint_as_float(rr[0]), __uint_as_float(rr[1])); }
    const bool first = (t == 0);
    if (first || !__all(pmax <= thr2)) {
      const float d = first ? pmax : fmaxf(pmax, 0.f); const float alpha = first ? 1.f : __builtin_amdgcn_exp2f(-d); m_reg += d; l_reg *= alpha;
      if (hi == 0) al_l[r32] = alpha; asm volatile("s_waitcnt lgkmcnt(0)" ::: "memory");
#pragma unroll
      for (int r = 0; r < 16; ++r) { const float a = al_l[crow(r, hi)]; o[0][r] *= a; o[1][r] *= a; o[2][r] *= a; o[3][r] *= a; p0[r] -= d; p1[r] -= d; }
#pragma unroll
      for (int r = 0; r < 16; ++r) negm[r] = -m_reg;
    }
    SBAR();
    float rs = 0.f; unsigned wa0, wa1, wb0, wb1; bf16x8 pa0, pa1, pa2, pa3;
    PREP(p0, 0, wa0); PREP(p0, 2, wa1); PREP(p0, 4, wb0); PREP(p0, 6, wb1); PKSW(pa0); SBAR();
    GP(0, pa0, PREP(p0, 8, wa0));   GP(1, pa0, PREP(p0, 10, wa1)); GP(2, pa0, PREP(p0, 12, wb0));  GP(3, pa0, PREP(p0, 14, wb1); PKSW(pa1));
    GP(4, pa1, PREP(p1, 0, wa0));   GP(5, pa1, PREP(p1, 2, wa1));  GP(6, pa1, PREP(p1, 4, wb0));   GP(7, pa1, PREP(p1, 6, wb1); PKSW(pa2));
    GP(8, pa2, PREP(p1, 8, wa0));   GP(9, pa2, PREP(p1, 10, wa1)); GP(10, pa2, PREP(p1, 12, wb0)); GP(11, pa2, PREP(p1, 14, wb1); PKSW(pa3));
    GP(12, pa3, kf[0] = KFRN(0)); GP(13, pa3, kf[1] = KFRN(1)); GP(14, pa3, kf[2] = KFRN(2)); GP(15, pa3, );
    l_reg += rs;
    if (more) asm volatile("s_waitcnt vmcnt(2)" ::: "memory"); else asm volatile("s_waitcnt vmcnt(0)" ::: "memory");
    asm volatile("s_waitcnt lgkmcnt(0)" ::: "memory"); __builtin_amdgcn_s_barrier(); asm volatile("" ::: "memory");
    cb = cb == 2 ? 0 : cb + 1;
  }
  __builtin_amdgcn_s_setprio(0);
#undef MF
#undef KFR
#undef KFRN
#undef GQ
#undef VFR
#undef VRD
#undef GP
#undef EX2
#undef PREP
#undef PKSW
#undef DMA
  { auto rr = __builtin_amdgcn_permlane32_swap(__float_as_uint(l_reg), __float_as_uint(l_reg), false, false); l_reg = __uint_as_float(rr[0]) + __uint_as_float(rr[1]); }
  if (hi == 0) li_l[r32] = l_reg; asm volatile("s_waitcnt lgkmcnt(0)" ::: "memory");
  float rli[16];
#pragma unroll
  for (int r = 0; r < 16; ++r) rli[r] = __builtin_amdgcn_rcpf(li_l[crow(r, hi)]);
  char* ost = lds + wid * OST_WAVE;
  const bool odd = lane & 1;
#pragma unroll
  for (int d0 = 0; d0 < 4; ++d0)
#pragma unroll
    for (int r = 0; r < 16; r += 2) {
      const float a = o[d0][r] * rli[r], b = o[d0][r + 1] * rli[r + 1];
      const float snd = odd ? a : b; const float rcv = __builtin_bit_cast(float, __builtin_amdgcn_mov_dpp(__builtin_bit_cast(int, snd), 0xB1, 0xF, 0xF, true));
      const float wlo = odd ? rcv : a, whi = odd ? b : rcv;
      const unsigned w = cvtpk(wlo, whi);
      const int row = crow(r, hi) + (odd ? 1 : 0), col = d0 * 32 + (r32 & ~1);
      *(unsigned*)(ost + row * OST_PITCH + col * 2) = w; }
  asm volatile("s_waitcnt lgkmcnt(0)" ::: "memory");
  bf16_t* Ow = O + (q_row0 + wid * QBLK) * ldo;
#pragma unroll
  for (int it = 0; it < 8; ++it) { const int id = it * 64 + lane, row = id >> 4, c16 = id & 15;
    const u32x4 v = *(const u32x4*)(ost + row * OST_PITCH + c16 * 16);
    *(u32x4*)(Ow + (long)row * ldo + c16 * 8) = v; }
  asm volatile("s_waitcnt lgkmcnt(0)" ::: "memory"); __builtin_amdgcn_s_barrier(); asm volatile("" ::: "memory");
}
}

#define XB_TMO      128
#define XB_XCNT(j)  (256  + 64 * (j))
#define XB_XSUB(j)  (1280 + 64 * (j))
#define XB_XGEN(j)  (2304 + 64 * (j))
#define XB_TOP      3328
#define XB_TOPGEN   3392
#define XCD_BAR_WORDS 3456
#define XB_SPIN_CAP (1u << 18)

__device__ __forceinline__ unsigned xb_ld(unsigned* p)              { return __hip_atomic_load(p, __ATOMIC_RELAXED, __HIP_MEMORY_SCOPE_AGENT); }
__device__ __forceinline__ unsigned xb_add(unsigned* p, unsigned v) { return __hip_atomic_fetch_add(p, v, __ATOMIC_RELAXED, __HIP_MEMORY_SCOPE_AGENT); }
__device__ __forceinline__ unsigned xb_xcc_id() { return (unsigned)__builtin_amdgcn_s_getreg((3 << 11) | 20) & 0xFu; }
#define XB_SPIN(cond, bar) do { unsigned _sp = 0; while (cond) { __builtin_amdgcn_s_sleep(1); \
    if ((++_sp & 255u) == 0u) { if (xb_ld(&(bar)[XB_TMO])) break; if (_sp > XB_SPIN_CAP) { atomicAdd(&(bar)[XB_TMO], 1u); break; } } } } while (0)

struct XcdBarrier {
    unsigned* bar; unsigned x;
    volatile LAS unsigned* st;
};
__device__ __forceinline__ XcdBarrier xcd_barrier_post(unsigned* bar, volatile LAS unsigned* st) {
    XcdBarrier b; b.bar = bar; b.x = xb_xcc_id(); b.st = st;
    if (threadIdx.x == 0) (void)xb_add(&bar[XB_XCNT(b.x)], 1u);
    return b;
}
__device__ __forceinline__ void xcd_barrier_complete(unsigned* bar, unsigned x, unsigned& nloc, unsigned& nx) {
    const unsigned G = gridDim.x * gridDim.y * gridDim.z;
    unsigned sum, cnt, mine, sp = 0u;
    for (;;) {
        sum = 0u; cnt = 0u; mine = 0u;
#pragma unroll
        for (unsigned j = 0; j < 16; ++j) { const unsigned c = xb_ld(&bar[XB_XCNT(j)]); sum += c; cnt += (c > 0u) ? 1u : 0u; mine = (j == x) ? c : mine; }
        if (sum == G) break;
        __builtin_amdgcn_s_sleep(1);
        if ((++sp & 255u) == 0u) { if (xb_ld(&bar[XB_TMO])) break; if (sp > XB_SPIN_CAP) { atomicAdd(&bar[XB_TMO], 1u); break; } }
    }
    nloc = mine > 0u ? mine : 1u; nx = cnt > 0u ? cnt : 1u;
}
__device__ __forceinline__ void xcd_barrier(const XcdBarrier& b) {
    asm volatile("s_waitcnt vmcnt(0)" ::: "memory");
    __syncthreads();
    if (threadIdx.x == 0) {
        unsigned* bar = b.bar;
        __builtin_amdgcn_s_waitcnt(0);
        unsigned nloc = b.st[0], nx = b.st[1];
        if (nloc == 0u) { xcd_barrier_complete(bar, b.x, nloc, nx); b.st[0] = nloc; b.st[1] = nx; }
        const unsigned old = xb_add(&bar[XB_XSUB(b.x)], 1u);
        const unsigned gen = old / nloc;
        if (old + 1u == (gen + 1u) * nloc) {
            __builtin_amdgcn_fence(__ATOMIC_RELEASE, "agent");
            asm volatile("s_waitcnt vmcnt(0)" ::: "memory");
            const unsigned og = xb_add(&bar[XB_TOP], 1u);
            const unsigned tg = og / nx;
            if (og + 1u == (tg + 1u) * nx) xb_add(&bar[XB_TOPGEN], 1u);
            else XB_SPIN(xb_ld(&bar[XB_TOPGEN]) == tg, bar);
            __builtin_amdgcn_fence(__ATOMIC_ACQUIRE, "agent");
            xb_add(&bar[XB_XGEN(b.x)], 1u);
            asm volatile("s_waitcnt vmcnt(0)" ::: "memory");
        } else {
            XB_SPIN(xb_ld(&bar[XB_XGEN(b.x)]) == gen, bar);
            __builtin_amdgcn_fence(__ATOMIC_ACQUIRE, "agent");
            asm volatile("s_waitcnt vmcnt(0)" ::: "memory");
        }
    }
    __syncthreads();
}

#ifndef WGM_G7
#define WGM_G7 4
#endif
constexpr int NWAVES = 8;
constexpr int N_PHASES = 20;
struct Args { const float* in[22]; float* out; unsigned char* ws; float inv[32]; int ph_lo, ph_hi, use_bar, pad; };

typedef float f32x4 __attribute__((ext_vector_type(4)));
typedef unsigned u32x4v __attribute__((ext_vector_type(4)));
typedef unsigned u32x2v __attribute__((ext_vector_type(2)));

template <bool HASG> __device__ __forceinline__ void transpose_item(const float* W, const float* gain, int K, int Nsrc, int k0, int srccol_lane, bf16_t* WTrow0, LAS float* scr, int lane) {
    const int c = lane & 7;
    f32x4 g0 = {1.f, 1.f, 1.f, 1.f}, g1 = {1.f, 1.f, 1.f, 1.f};
    if constexpr (HASG) { g0 = *(const f32x4*)(gain + k0 + 8 * c); g1 = *(const f32x4*)(gain + k0 + 8 * c + 4); }
#pragma unroll 8
    for (int i = 0; i < 32; ++i) { const int kk = 2 * i + (lane >> 5); scr[kk * 33 + (lane & 31)] = W[(size_t)(k0 + kk) * Nsrc + srccol_lane]; }
    asm volatile("s_waitcnt lgkmcnt(0)" ::: "memory");
#pragma unroll
    for (int j = 0; j < 4; ++j) { const int n = (lane >> 3) + 8 * j; const LAS float* s = scr + (8 * c) * 33 + n;
        u32x4v o; o.x = cvt_pk_bf16(s[0 * 33] * g0[0], s[1 * 33] * g0[1]); o.y = cvt_pk_bf16(s[2 * 33] * g0[2], s[3 * 33] * g0[3]); o.z = cvt_pk_bf16(s[4 * 33] * g1[0], s[5 * 33] * g1[1]); o.w = cvt_pk_bf16(s[6 * 33] * g1[2], s[7 * 33] * g1[3]);
        *(u32x4v*)(WTrow0 + (size_t)n * K + k0 + 8 * c) = o; }
    asm volatile("s_waitcnt lgkmcnt(0)" ::: "memory");
}
template <int MAP, bool HASG> __device__ __forceinline__ bool tr_job(int& r, const float* W, const float* W2, const float* gain, int K, int Nsrc, int ndst, bf16_t* WT, LAS float* scr, int lane) {
    const int nblk = ndst / 32, items = (K / 64) * nblk;
    if (r >= items) { r -= items; return false; }
    const int kb = r / nblk, nb = r % nblk, n0 = nb * 32, nl = n0 + (lane & 31);
    int sc = nl; const float* Ws = W;
    if (MAP == 1) { const int h = nl / CQK, hc = nl % CQK; if (hc >= 128) { const int p = hc - 128, i = p >> 1; sc = h * CQK + 128 + ((p & 1) ? i + 32 : i); } }
    if (MAP == 2) { const int pn = nl >> 8, rr = nl & 255; sc = pn * 128 + (rr & 127); if (rr >= 128) Ws = W2; }
    if (MAP == 3) { if (nl >= OFF_CKR) { const int p = nl - OFF_CKR, i = p >> 1; sc = OFF_CKR + ((p & 1) ? i + 32 : i); } }
    transpose_item<HASG>(Ws, gain, K, Nsrc, kb * 64, sc, WT + (size_t)n0 * K, scr, lane);
    return true;
}

template <bool RAW> __device__ __forceinline__ void row_to_bf16(const float* xrow, bf16_t* orow, float* ssq_row, int lane) {
    const f32x4* xr = (const f32x4*)xrow + lane; f32x4 v[16]; float s = 0.f;
#pragma unroll
    for (int j = 0; j < 16; ++j) { v[j] = xr[64 * j]; s += (v[j].x * v[j].x + v[j].y * v[j].y) + (v[j].z * v[j].z + v[j].w * v[j].w); }
    float sc = 1.f;
    if (RAW) ssq_row[lane] = s; else sc = rsqrtf(wave_sum(s) * (1.f / DM) + NORM_EPS);
    u32x2v* o8 = (u32x2v*)orow + lane;
#pragma unroll
    for (int j = 0; j < 16; ++j) { u32x2v w; w.x = cvt_pk_bf16(v[j].x * sc, v[j].y * sc); w.y = cvt_pk_bf16(v[j].z * sc, v[j].w * sc); o8[64 * j] = w; }
}
__device__ __forceinline__ void rms_row_4096_bf(const bf16_t* xrow, const float* g, float* orow, int lane) {
    const u32x4v* xr = (const u32x4v*)xrow + lane; float v[8][8]; float s = 0.f;
#pragma unroll
    for (int j = 0; j < 8; ++j) { const u32x4v w = xr[64 * j];
#pragma unroll
        for (int e = 0; e < 4; ++e) { v[j][2 * e] = __uint_as_float(w[e] << 16); v[j][2 * e + 1] = __uint_as_float(w[e] & 0xffff0000u); s += v[j][2 * e] * v[j][2 * e] + v[j][2 * e + 1] * v[j][2 * e + 1]; } }
    const float rstd = rsqrtf(wave_sum(s) * (1.f / DM) + NORM_EPS);
#pragma unroll
    for (int j = 0; j < 8; ++j) { const int c0 = (64 * j + lane) * 8; const f32x4 g0 = *(const f32x4*)(g + c0), g1 = *(const f32x4*)(g + c0 + 4);
        f32x4 o0, o1;
#pragma unroll
        for (int e = 0; e < 4; ++e) { o0[e] = v[j][e] * rstd * g0[e]; o1[e] = v[j][4 + e] * rstd * g1[e]; }
        *(f32x4*)(orow + c0) = o0; *(f32x4*)(orow + c0 + 4) = o1; }
}

template <class Sched> __device__ __forceinline__ void build_rstd_table(const Sched& S, const float* ssq, int row0, LAS float* tab) {
    int tid = threadIdx.x; asm volatile("" : "+v"(tid)); const int lane = tid & 63, wave = tid >> 6, sub = lane >> 4, piece = lane & 15;
    int lo = 1 << 30, hi = -1; { pg8::Unit u; for (int i = 0; S.next(i, u); ++i) { lo = u.pm < lo ? u.pm : lo; hi = u.pm > hi ? u.pm : hi; } }
    for (int pm = lo; pm <= hi; ++pm) {
#pragma unroll
        for (int j = 0; j < 8; ++j) { const int r = pm * pg8::BM + wave * 32 + j * 4 + sub;
            const f32x4 a = *(const f32x4*)(ssq + (size_t)r * 64 + piece * 4);
            float t = (a[0] + a[1]) + (a[2] + a[3]); t += __shfl_xor(t, 1); t += __shfl_xor(t, 2); t += __shfl_xor(t, 4); t += __shfl_xor(t, 8);
            if (piece == 0) tab[r - row0] = rsqrtf(t * (1.f / DM) + NORM_EPS); } }
    __syncthreads();
}

__global__ void __launch_bounds__(NWAVES * 64, 2) fwd_kernel(Args args) {
    extern __shared__ __attribute__((aligned(16))) unsigned char lds[];
    LAS unsigned char* ldsl = (LAS unsigned char*)lds;
    volatile LAS unsigned* MISC = (volatile LAS unsigned*)(ldsl + MISC_OFF);
    const int G = gridDim.x, bid = blockIdx.x;
#define PH_TID() int tid = threadIdx.x; asm volatile("" : "+v"(tid)); const int lane = tid & 63, wave = __builtin_amdgcn_readfirstlane(tid >> 6); const int gw = bid * NWAVES + wave, NGW = G * NWAVES; (void)lane; (void)gw; (void)NGW
    unsigned char* ws = args.ws;
    gu32* ctl = (gu32*)(ws + WS_CTL);
    for (int u = threadIdx.x; u < (LDS_BYTES - LDSCTL_OFF) / 4; u += NWAVES * 64) ((LAS unsigned*)(ldsl + LDSCTL_OFF))[u] = 0u;
    __syncthreads();
    XcdBarrier bar; bar.bar = (unsigned*)ctl + CW_BAR; bar.x = 0; bar.st = nullptr;
    if (args.use_bar) bar = xcd_barrier_post((unsigned*)ctl + CW_BAR, MISC + 8);
#ifndef BARX
#define BARX 0
#endif
#define GRID_BAR() do { if (args.use_bar) { xcd_barrier(bar); if (BARX) xcd_barrier(bar); } } while (0)
    const int lo = args.ph_lo, hi = args.ph_hi;
#ifndef PHM
#define PHM 0xFFFFFFFFu
#endif
#define IN(k) (lo <= (k) && (k) < hi)
#define PH(j) ((PHM >> (j)) & 1)
#ifndef REPM
#define REPM 0u
#endif
#define NREP(j) (1 + (int)((REPM >> (j)) & 1u))
#define REPLOOP(j) _Pragma("unroll") for (int rep = 0; rep < NREP(j); ++rep)
#define BOTH(k) (IN(k) && IN((k) + 1))

    float* cosT = (float*)(ws + WS_COS); float* sinT = (float*)(ws + WS_SIN);
    bf16_t* MEMN = (bf16_t*)(ws + WS_MEMN); bf16_t* MEMKV = (bf16_t*)(ws + WS_MEMKV);
    bf16_t* XQ = (bf16_t*)(ws + WS_XQ); bf16_t* XO = (bf16_t*)(ws + WS_XO);
    bf16_t* XB = (bf16_t*)(ws + WS_H); bf16_t* PROJ = (bf16_t*)(ws + WS_PROJ);
    bf16_t* QC = (bf16_t*)(ws + WS_QC); bf16_t* KC = (bf16_t*)(ws + WS_KC); bf16_t* VC = (bf16_t*)(ws + WS_VC);
    bf16_t* MIX = (bf16_t*)(ws + WS_MIX); bf16_t* ACT = (bf16_t*)(ws + WS_ACT);
    float* SSQ = (float*)(ws + WS_SSQ); float* SSQ2 = (float*)(ws + WS_SSQ2); float* CKRS = (float*)(ws + WS_CKR);

#ifndef NPASS
#define NPASS 1
#endif
    for (int pass = 0; pass < NPASS; ++pass) {
    if (PH(13) && IN(0)) { PH_TID(); REPLOOP(13) {
        LAS float* scr = (LAS float*)(ldsl + wave * 16384);
        constexpr int I_IN = (DM / 64) * (D_IN / 32), I_QB = (QRANK / 64) * (QCW / 32), I_KVB = (KVRANK / 64) * (KVW / 32), I_OUT = (DM / 64) * (DM / 32), I_XQ = (DM / 64) * (XD / 32),
                      I_XO = (XD / 64) * (DM / 32), I_GU = (DM / 64) * (GUW / 32), I_DOWN = (DFF / 64) * (DM / 32);
        constexpr int I_LAYER = I_IN + I_QB + I_KVB + I_OUT + 3 * I_XQ + I_XO + I_GU + I_DOWN;
        for (int it = gw; it < DEPTH * I_LAYER; it += NGW) {
            const int l = it / I_LAYER; int r = it % I_LAYER;
            unsigned char* wl = ws + WS_W + (size_t)l * W_LAYER;
            if (tr_job<3, true>(r, args.in[3] + (size_t)l * DM * D_IN, nullptr, args.in[2] + (size_t)l * DM, DM, D_IN, D_IN, (bf16_t*)(wl + WO_IN), scr, lane)) continue;
            if (tr_job<1, true>(r, args.in[7] + (size_t)l * QRANK * QCW, nullptr, args.in[6] + (size_t)l * QRANK, QRANK, QCW, QCW, (bf16_t*)(wl + WO_QB), scr, lane)) continue;
            if (tr_job<0, true>(r, args.in[9] + (size_t)l * KVRANK * KVW, nullptr, args.in[8] + (size_t)l * KVRANK, KVRANK, KVW, KVW, (bf16_t*)(wl + WO_KVB), scr, lane)) continue;
            if (tr_job<0, false>(r, args.in[10] + (size_t)l * DM * DM, nullptr, nullptr, DM, DM, DM, (bf16_t*)(wl + WO_OUT), scr, lane)) continue;
            if (tr_job<0, true>(r, args.in[13] + (size_t)l * DM * XD, nullptr, args.in[11] + (size_t)l * DM, DM, XD, XD, (bf16_t*)(wl + WO_XQ), scr, lane)) continue;
            if (tr_job<0, true>(r, args.in[14] + (size_t)l * DM * XD, nullptr, args.in[12] + (size_t)l * DM, DM, XD, XD, (bf16_t*)(wl + WO_XKV), scr, lane)) continue;
            if (tr_job<0, true>(r, args.in[15] + (size_t)l * DM * XD, nullptr, args.in[12] + (size_t)l * DM, DM, XD, XD, (bf16_t*)(wl + WO_XKV) + (size_t)XD * DM, scr, lane)) continue;
            if (tr_job<0, false>(r, args.in[16] + (size_t)l * XD * DM, nullptr, nullptr, XD, DM, DM, (bf16_t*)(wl + WO_XO), scr, lane)) continue;
            if (tr_job<2, true>(r, args.in[18] + (size_t)l * DM * DFF, args.in[19] + (size_t)l * DM * DFF, args.in[17] + (size_t)l * DM, DM, DFF, GUW, (bf16_t*)(wl + WO_GU), scr, lane)) continue;
            tr_job<0, false>(r, args.in[20] + (size_t)l * DFF * DM, nullptr, nullptr, DFF, DM, DM, (bf16_t*)(wl + WO_DOWN), scr, lane);
        }
        for (int e = bid * 512 + tid; e < SEQ * 32; e += G * 512) { const int pos = e >> 5, i = e & 31; const float ang = (float)pos * args.inv[i];
            double rev = (double)ang * 0.15915494309189533577; rev -= __builtin_rint(rev); const float rf = (float)rev;
            cosT[e] = __builtin_amdgcn_cosf(rf); sinT[e] = __builtin_amdgcn_sinf(rf); }
        for (int m = gw; m < MTOK + MEMROWS; m += NGW) {
            if (m < MTOK) row_to_bf16<true>(args.in[0] + (size_t)m * DM, XB + (size_t)m * DM, SSQ + (size_t)m * 64, lane);
            else row_to_bf16<false>(args.in[1] + (size_t)(m - MTOK) * DM, MEMN + (size_t)(m - MTOK) * DM, nullptr, lane);
        }
            }
        if (BOTH(0)) GRID_BAR();
    }

    for (int l = 0; l < DEPTH; ++l) {
        const int pb = 1 + 9 * l;
        unsigned char* wl = ws + WS_W + (size_t)l * W_LAYER;

        if (PH(1) && IN(pb + 0)) { REPLOOP(1) {
            LAS float* tab = (LAS float*)(ldsl + RSTD_OFF); const int trow0 = (bid & 7) * 2048;
            { pg8::Gemm g{XB, (const bf16_t*)(wl + WO_IN), MTOK, OFF_CKR, DM, DM, DM, OFF_CKR / 256, 0u}; pg8::StaticOrder S; S.init(MTOK, OFF_CKR, G, bid); build_rstd_table(S, SSQ, trow0, tab);
              pg8::EpiG1 E{PROJ, tab, trow0, SSQ2};
              pg8::gemm_phase<pg8::EpiG1, pg8::StaticOrder, true, true>(ldsl, g, S, E); }
            { pg8::Gemm g{XB, (const bf16_t*)(wl + WO_IN) + (size_t)OFF_CKR * DM, MTOK, 4 * 256, DM / 4, DM, DM, 1, (unsigned)(DM / 4 * 2)}; pg8::StaticOrder S; S.init(MTOK, 4 * 256, G, bid);
              pg8::EpiCkr E{CKRS};
              pg8::gemm_phase<pg8::EpiCkr, pg8::StaticOrder, true, true>(ldsl, g, S, E); }
            }
            if (BOTH(pb + 0)) GRID_BAR();
        }
        if (PH(3) && IN(pb + 1)) { REPLOOP(3) {
            { PH_TID();
              for (int m = gw; m < MTOK; m += NGW) {
                  const float rstd = rsqrtf(wave_sum(SSQ[(size_t)m * 64 + lane]) * (1.f / DM) + NORM_EPS);
                  const float* p = CKRS + (size_t)m * 64 + lane; const float v = ((p[0] + p[(size_t)MTOK * 64]) + (p[(size_t)2 * MTOK * 64] + p[(size_t)3 * MTOK * 64])) * rstd;
                  const float o = __shfl_xor(v, 1); const int pos = m & (SEQ - 1), i = lane >> 1; const float c = cosT[pos * 32 + i], sn = sinT[pos * 32 + i];
                  const float r = (lane & 1) ? (o * sn + v * c) : (v * c - o * sn);
                  const unsigned short w = (unsigned short)(cvt_pk_bf16(r, r) & 0xffffu); bf16_t* dst = KC + (size_t)m * QCW + 128 + lane;
#pragma unroll
                  for (int h = 0; h < CH; ++h) dst[h * CQK] = w; } }
            { pg8::Gemm g{PROJ + OFF_CQ, (const bf16_t*)(wl + WO_QB), MTOK, QCW, QRANK, D_INP, QRANK, (QCW) / 256, 0u}; pg8::StaticOrder S; S.init(MTOK, QCW, G, bid);
              pg8::EpiQRope E{QC, cosT, sinT, SSQ2};
              pg8::gemm_phase<pg8::EpiQRope, pg8::StaticOrder, true, true>(ldsl, g, S, E); }
            { pg8::Gemm g{PROJ + OFF_CKV, (const bf16_t*)(wl + WO_KVB), MTOK, KVW, KVRANK, D_INP, KVRANK, (KVW) / 256, 0u}; pg8::StaticOrder S; S.init(MTOK, KVW, G, bid);
              pg8::EpiKV E{KC, VC, SSQ2};
              pg8::gemm_phase<pg8::EpiKV, pg8::StaticOrder, true, true>(ldsl, g, S, E); }
            }
            if (BOTH(pb + 1)) GRID_BAR();
        }
        if (PH(4) && IN(pb + 2)) { PH_TID(); REPLOOP(4) {
#ifndef REPS
#define REPS 7
#endif
            if (PH(16) && (rep == NREP(4) - 1 || (REPS & 1))) for (int u = bid; u < BATCH * CH * 32; u += G) {
                const int x = u & 7, qb = (u >> 3) & 31, bh = (u >> 8) * 8 + x, b = bh / CH, h = bh % CH;
                att::MaskNone mk;
                att::attn_unit_c<192, att::MaskNone>(QC + h * CQK, (long)b * SEQ + qb * 256, QCW, KC + h * CQK, QCW, VC + h * 128, VCW, (long)b * SEQ, (long)b * SEQ, (long)b * SEQ + SEQ - 1, SEQ / 64,
                                                   MIX + MIX_C + h * 128, DM, 0.07216878364870322f * 1.4426950408889634f, -1e5f, 0.f, mk, (char*)lds, ldsl);
            }
            if (PH(17) && (rep == NREP(4) - 1 || (REPS & 2))) for (int u = bid; u < BATCH * AH * 32; u += G) {
                const int x = u & 7, qb = (u >> 3) & 31, bh = (u >> 8) * 8 + x, b = bh / AH, hq = bh % AH, gk = hq / 3;
                const float scale = 0.08838834764831845f, slope = exp2f(-8.f * (float)(hq + 1) / 12.f), sink = args.in[4][l * AH + hq];
                att::MaskA mk; { const int qpos = qb * 256 + (tid >> 6) * 32 + (lane & 31); mk.qoff = qb * 256 - 128 - qpos; mk.lo = -qpos > -128 ? -qpos : -128; mk.hi_ = SEQ - 1 - qpos < 128 ? SEQ - 1 - qpos : 128; } mk.sl = slope / scale;
                att::attn_unit_dma<128, att::MaskA>(PROJ + OFF_AQ + hq * 128, (long)b * SEQ + qb * 256, D_INP, PROJ + OFF_AK + gk * 128, D_INP, PROJ + OFF_AV + gk * 128, D_INP,
                                                (long)b * SEQ + qb * 256 - 128, (long)b * SEQ, (long)b * SEQ + SEQ - 1, 8,
                                                MIX + MIX_A + hq * 128, DM, scale * 1.4426950408889634f, sink / scale, 1.f, mk, (char*)lds, ldsl);
            }
            if (PH(18) && (rep == NREP(4) - 1 || (REPS & 4))) for (int u = bid; u < BATCH * BH * 32; u += G) {
                const int x = u & 7, qb = (u >> 3) & 31, bh = (u >> 8) * 8 + x, b = bh / BH, h = bh % BH;
                const float scale = 0.08838834764831845f;
                float* tab = (float*)(lds + 124928);
                if (tid < 15 * 31) tab[tid] = args.in[5][((size_t)l * BH + h) * 465 + tid] * (1.f / scale);
                const int r0 = qb * 4; int kr0 = r0 - 4; kr0 = kr0 < 0 ? 0 : (kr0 > 116 ? 116 : kr0);
                const int tq = qb * 256 + (tid >> 6) * 32 + (lane & 31);
                att::MaskB mk; mk.qr = tq >> 6; mk.qc = tq & 63; mk.kr0 = kr0; { int rs = mk.qr - 4; mk.rs = rs < 0 ? 0 : (rs > 120 ? 120 : rs); int cs = mk.qc - 8; mk.cs = cs < 0 ? 0 : (cs > 48 ? 48 : cs); } mk.tab = tab;
                att::attn_unit_dma<128, att::MaskB>(PROJ + OFF_BQ + h * 128, (long)b * SEQ + qb * 256, D_INP, PROJ + OFF_BK + h * 128, D_INP, PROJ + OFF_BV + h * 128, D_INP,
                                                (long)b * SEQ + kr0 * 64, (long)b * SEQ, (long)b * SEQ + SEQ - 1, 12,
                                                MIX + MIX_B + h * 128, DM, scale * 1.4426950408889634f, -1e5f, 0.f, mk, (char*)lds, ldsl);
            }
            }
            if (BOTH(pb + 2)) GRID_BAR();
        }
        if (PH(5) && IN(pb + 3)) { REPLOOP(5) {
            pg8::Gemm g{MIX, (const bf16_t*)(wl + WO_OUT), MTOK, DM, DM, DM, DM, (DM) / 256, 0u}; pg8::StaticOrder S; S.init(MTOK, DM, G, bid);
            pg8::EpiRes E{XB, (NREP(5) == 2 && rep == 0) ? (bf16_t*)(ws + 168 * MiB) : XB, SSQ};
            pg8::gemm_phase<pg8::EpiRes, pg8::StaticOrder, true, true>(ldsl, g, S, E);
            }
            if (BOTH(pb + 3)) GRID_BAR();
        }
        if (PH(7) && IN(pb + 4)) { REPLOOP(7) {
            const int half = G / 2;
            if (bid < half) { pg8::Gemm g{XB, (const bf16_t*)(wl + WO_XQ), MTOK, XD, DM, DM, DM, (XD) / 256, 0u}; pg8::StaticOrder S; S.init(MTOK, XD, half, bid);
                LAS float* tab = (LAS float*)(ldsl + RSTD_OFF); const int trow0 = (bid & 7) * 2048; build_rstd_table(S, SSQ, trow0, tab);
                pg8::EpiStoreScaled E{XQ, XD, tab, trow0};
                pg8::gemm_phase<pg8::EpiStoreScaled, pg8::StaticOrder, true, true>(ldsl, g, S, E); }
            else { pg8::Gemm g{MEMN, (const bf16_t*)(wl + WO_XKV), MEMROWS, 2 * XD, DM, DM, DM, (2 * XD) / 256, 0u}; pg8::StaticOrder S; S.init(MEMROWS, 2 * XD, G - half, bid - half);
                pg8::EpiStore E{MEMKV, 2 * XD};
                pg8::gemm_phase<pg8::EpiStore, pg8::StaticOrder, true, true>(ldsl, g, S, E); }
            }
            if (BOTH(pb + 4)) GRID_BAR();
        }
        if (PH(8) && IN(pb + 5)) { REPLOOP(8) {
            for (int u = bid; u < BATCH * 4 * 32; u += G) {
                const int x = u & 7, qb = (u >> 3) & 31, b = x >> 2, h = x & 3;
                att::MaskNone mk;
                att::attn_unit_dma<128, att::MaskNone>(XQ + h * 128, (long)b * SEQ + qb * 256, XD, MEMKV + h * 128, 2 * XD, MEMKV + XD + h * 128, 2 * XD, (long)b * NMEM, (long)b * NMEM, (long)b * NMEM + NMEM - 1, NMEM / 64,
                                                   XO + h * 128, XD, 0.08838834764831845f * 1.4426950408889634f, -1e5f, 0.f, mk, (char*)lds, ldsl);
            }
            }
            if (BOTH(pb + 5)) GRID_BAR();
        }
        if (PH(9) && IN(pb + 6)) { REPLOOP(9) {
            pg8::Gemm g{XO, (const bf16_t*)(wl + WO_XO), MTOK, DM, XD, XD, XD, (DM) / 256, 0u}; pg8::StaticOrder S; S.init(MTOK, DM, G, bid);
            pg8::EpiRes E{XB, (NREP(9) == 2 && rep == 0) ? (bf16_t*)(ws + 168 * MiB) : XB, SSQ};
            pg8::gemm_phase<pg8::EpiRes, pg8::StaticOrder, true, true>(ldsl, g, S, E);
            }
            if (BOTH(pb + 6)) GRID_BAR();
        }
        if (PH(11) && IN(pb + 7)) { REPLOOP(11) {
            pg8::Gemm g{XB, (const bf16_t*)(wl + WO_GU), MTOK, GUW, DM, DM, DM, (GUW) / 256, 0u}; pg8::StaticOrder S; S.init(MTOK, GUW, G, bid);
            LAS float* tab = (LAS float*)(ldsl + RSTD_OFF); const int trow0 = (bid & 7) * 2048; build_rstd_table(S, SSQ, trow0, tab);
            pg8::EpiSwiglu E{ACT, DFF, tab, trow0};
            pg8::gemm_phase<pg8::EpiSwiglu, pg8::StaticOrder, true, true>(ldsl, g, S, E);
            }
            if (BOTH(pb + 7)) GRID_BAR();
        }
        if (PH(12) && IN(pb + 8)) { REPLOOP(12) {
            pg8::Gemm g{ACT, (const bf16_t*)(wl + WO_DOWN), MTOK, DM, DFF, DFF, DFF, (DM) / 256, 0u}; pg8::StaticOrder S; S.init(MTOK, DM, G, bid, WGM_G7);
            pg8::EpiRes E{XB, (NREP(12) == 2 && rep == 0) ? (bf16_t*)(ws + 512 * MiB) : XB, SSQ};
            pg8::gemm_phase<pg8::EpiRes, pg8::StaticOrder, true, true>(ldsl, g, S, E);
            }
            if (BOTH(pb + 8)) GRID_BAR();
        }
    }
    if (PH(14) && IN(19)) { PH_TID();
        for (int m = gw; m < MTOK; m += NGW) rms_row_4096_bf(XB + (size_t)m * DM, args.in[21], args.out + (size_t)m * DM, lane);
    }
    if (NPASS > 1 && pass + 1 < NPASS) GRID_BAR();
    }
#undef IN
#undef BOTH
#undef GRID_BAR
}

#if DBG
constexpr int DBG_NS = 128;
struct DbgBuf { unsigned fail[64]; float snap[64][DBG_NS]; float tol[64][DBG_NS]; };
__device__ __forceinline__ unsigned dhash(unsigned x) { x ^= x >> 16; x *= 0x7feb352dU; x ^= x >> 15; x *= 0x846ca68bU; x ^= x >> 16; return x; }
__device__ __forceinline__ float rbf(float f) { unsigned u = __float_as_uint(f); u += 0x7fffu + ((u >> 16) & 1u); return __uint_as_float(u & 0xffff0000u); }
__device__ __forceinline__ float wave_max(float v) { for (int o = 1; o < 64; o <<= 1) v = fmaxf(v, __shfl_xor(v, o)); return v; }
__device__ void wdot(const bf16_t* a, const float* W, const float* gain, int N, int n, int K, int lane, float& dot, float& sabs) {
    float d = 0.f, sa = 0.f; for (int k = lane; k < K; k += 64) { const float x = bf2f(a[k]) * rbf(W[(size_t)k * N + n] * (gain ? gain[k] : 1.f)); d += x; sa += fabsf(x); } dot = wave_sum(d); sabs = wave_sum(sa); }
__device__ float row_rstd_f32(const float* x, int n, int lane) { float ss = 0.f; for (int k = lane; k < n; k += 64) ss += x[k] * x[k]; return rsqrtf(wave_sum(ss) / n + NORM_EPS); }
__device__ float row_rstd_bf(const bf16_t* x, int n, int lane) { float ss = 0.f; for (int k = lane; k < n; k += 64) ss += bf2f(x[k]) * bf2f(x[k]); return rsqrtf(wave_sum(ss) / n + NORM_EPS); }
__device__ void dsincos(float ang, float& c, float& s) { double x = (double)ang; const double tp = 6.283185307179586476925; x -= tp * __builtin_rint(x / tp);
    double sn = 0.0, cs = 0.0, term = 1.0; for (int k = 0; k < 30; ++k) { if (k & 1) { sn += ((k >> 1) & 1) ? -term : term; } else { cs += ((k >> 1) & 1) ? -term : term; } term *= x / (double)(k + 1); } c = (float)cs; s = (float)sn; }
__device__ void dchk(DbgBuf* D, int cid, float got, float exp, float tol, int lane) { if (lane == 0 && !(fabsf(got - exp) <= tol)) D->fail[cid] = 1u; }

__global__ void __launch_bounds__(64) dbg_check(Args a, int l, int kind, int cid, int pre) {
    const int lane = threadIdx.x, s = blockIdx.x; unsigned char* ws = a.ws; DbgBuf* D = (DbgBuf*)(ws + WS_DBG);
    const unsigned h1 = dhash(cid * 1000003u + s * 7919u + 12345u), h2 = dhash(h1 + 0x9e3779b9u), h3 = dhash(h2 + 0x85ebca6bu);
    bf16_t* MEMN = (bf16_t*)(ws + WS_MEMN); bf16_t* MEMKV = (bf16_t*)(ws + WS_MEMKV); bf16_t* XQ = (bf16_t*)(ws + WS_XQ); bf16_t* XO = (bf16_t*)(ws + WS_XO);
    bf16_t* XB = (bf16_t*)(ws + WS_H); bf16_t* PROJ = (bf16_t*)(ws + WS_PROJ);
    bf16_t* QC = (bf16_t*)(ws + WS_QC); bf16_t* KC = (bf16_t*)(ws + WS_KC); bf16_t* VC = (bf16_t*)(ws + WS_VC); bf16_t* MIX = (bf16_t*)(ws + WS_MIX); bf16_t* ACT = (bf16_t*)(ws + WS_ACT);
    float* SSQ = (float*)(ws + WS_SSQ); float* SSQ2 = (float*)(ws + WS_SSQ2);
    const int m = h1 % MTOK;
    if (kind == 41) {
        const int c = h2 % DM;
        if (s < 64) { const float e = a.in[0][(size_t)m * DM + c]; dchk(D, cid, bf2f(XB[(size_t)m * DM + c]), e, 0.005f * fabsf(e) + 1e-6f, lane); }
        else if (s < 96) { float ss = 0.f; for (int k = lane; k < DM; k += 64) { const float v = a.in[0][(size_t)m * DM + k]; ss += v * v; } ss = wave_sum(ss); const float g = wave_sum(SSQ[(size_t)m * 64 + lane]); dchk(D, cid, g, ss, 1e-4f * ss, lane); }
        else { const int r = h1 % MEMROWS; const float e = a.in[1][(size_t)r * DM + c] * row_rstd_f32(a.in[1] + (size_t)r * DM, DM, lane); dchk(D, cid, bf2f(MEMN[(size_t)r * DM + c]), e, 0.01f * fabsf(e) + 1e-3f, lane); }
    } else if (kind == 40) {
        const int c = h2 % DM;
        if (pre) return; const float exp = bf2f(XB[(size_t)m * DM + c]) * row_rstd_bf(XB + (size_t)m * DM, DM, lane) * a.in[21][c];
        dchk(D, cid, a.out[(size_t)m * DM + c], exp, 1e-4f * fabsf(exp) + 1e-5f, lane);
    } else if (kind == 2) {
        const float rstd = row_rstd_bf(XB + (size_t)m * DM, DM, lane); const float* W = a.in[3] + (size_t)l * DM * D_IN; const float* g = a.in[2] + (size_t)l * DM; const bf16_t* ar = XB + (size_t)m * DM;
        const int sub = s & 7;
        if (false) {}
        else if (sub == 5) { float ss = 0.f; for (int k = lane; k < QRANK; k += 64) { const float v = bf2f(PROJ[(size_t)m * D_INP + OFF_CQ + k]); ss += v * v; } ss = wave_sum(ss); const float gs = wave_sum(lane < 16 ? SSQ2[(size_t)m * 24 + lane] : 0.f); dchk(D, cid, gs, ss, 0.01f * ss, lane); }
        else if (sub == 1) { float ss = 0.f; for (int k = lane; k < KVRANK; k += 64) { const float v = bf2f(PROJ[(size_t)m * D_INP + OFF_CKV + k]); ss += v * v; } ss = wave_sum(ss); const float gs = wave_sum(lane < 8 ? SSQ2[(size_t)m * 24 + 16 + lane] : 0.f); dchk(D, cid, gs, ss, 0.01f * ss, lane); }
        else { const int n = h2 % OFF_CKR; float d, sa; wdot(ar, W, g, D_IN, n, DM, lane, d, sa); d *= rstd; dchk(D, cid, bf2f(PROJ[(size_t)m * D_INP + n]), d, 0.02f * fabsf(d) + 2e-4f * sa * rstd, lane); }
    } else if (kind == 4) {
        const int hh = h2 % CH; const float* W = a.in[7] + (size_t)l * QRANK * QCW; const float* g = a.in[6] + (size_t)l * QRANK; const bf16_t* ar = PROJ + (size_t)m * D_INP + OFF_CQ; const float rstd = row_rstd_bf(ar, QRANK, lane);
        if (s & 1) { const int d0 = h3 % 128; float d, sa; wdot(ar, W, g, QCW, hh * CQK + d0, QRANK, lane, d, sa); d *= rstd * QSC_C; dchk(D, cid, bf2f(QC[(size_t)m * QCW + hh * CQK + d0]), d, 0.02f * fabsf(d) + 2e-4f * sa * rstd * QSC_C, lane); }
        else { const int i = h3 % 32; float x1, s1, x2, s2; wdot(ar, W, g, QCW, hh * CQK + 128 + i, QRANK, lane, x1, s1); wdot(ar, W, g, QCW, hh * CQK + 128 + i + 32, QRANK, lane, x2, s2); x1 *= rstd * QSC_C; x2 *= rstd * QSC_C;
            float c, sn; dsincos((float)(m % SEQ) * a.inv[i], c, sn); const float e1 = x1 * c - x2 * sn, e2 = x1 * sn + x2 * c; const bf16_t* q = QC + (size_t)m * QCW + hh * CQK + 128 + 2 * i;
            const float tol = 2e-4f * (s1 + s2) * rstd * QSC_C; dchk(D, cid, bf2f(q[0]), e1, 0.02f * fabsf(e1) + tol, lane); dchk(D, cid, bf2f(q[1]), e2, 0.02f * fabsf(e2) + tol, lane); }
    } else if (kind == 5 && (s & 3) == 2) {
        const float rstd = row_rstd_bf(XB + (size_t)m * DM, DM, lane); const float* W = a.in[3] + (size_t)l * DM * D_IN; const float* g = a.in[2] + (size_t)l * DM; const bf16_t* ar = XB + (size_t)m * DM;
        const int i = h2 % 32, hh = h3 % CH; float x1, s1, x2, s2; wdot(ar, W, g, D_IN, OFF_CKR + i, DM, lane, x1, s1); wdot(ar, W, g, D_IN, OFF_CKR + i + 32, DM, lane, x2, s2); x1 *= rstd; x2 *= rstd;
        float c, sn; dsincos((float)(m % SEQ) * a.inv[i], c, sn); const float e1 = x1 * c - x2 * sn, e2 = x1 * sn + x2 * c; const bf16_t* kc = KC + (size_t)m * QCW + hh * CQK + 128 + 2 * i; const float tol = 2e-4f * (s1 + s2) * rstd;
        dchk(D, cid, bf2f(kc[0]), e1, 0.02f * fabsf(e1) + tol, lane); dchk(D, cid, bf2f(kc[1]), e2, 0.02f * fabsf(e2) + tol, lane);
    } else if (kind == 5) {
        const int hh = h2 % CH, part = s & 1, d0 = h3 % 128; const bf16_t* ar = PROJ + (size_t)m * D_INP + OFF_CKV; const float rstd = row_rstd_bf(ar, KVRANK, lane); float d, sa;
        wdot(ar, a.in[9] + (size_t)l * KVRANK * KVW, a.in[8] + (size_t)l * KVRANK, KVW, hh * 256 + part * 128 + d0, KVRANK, lane, d, sa); d *= rstd;
        const float got = part ? bf2f(VC[(size_t)m * VCW + hh * 128 + d0]) : bf2f(KC[(size_t)m * QCW + hh * CQK + d0]); dchk(D, cid, got, d, 0.02f * fabsf(d) + 2e-4f * sa * rstd, lane);
    } else if (kind == 6 || kind == 7 || kind == 8 || kind == 12) {
        const int b = m / SEQ, pos = m % SEQ, d0 = h3 % 128; int nk, hh; float scale; const bf16_t *qp, *kp0, *vp0; int ldk, ldv, dqk; float got; float sinkv = 0.f; bool has_sink = false;
        int rs = 0, cs = 0, qr = pos >> 6, qc = pos & 63; float slope = 0.f; const float* rpb = nullptr;
        if (kind == 6) { hh = h2 % CH; nk = SEQ; scale = 0.6931471805599453f;     dqk = 192; qp = QC + (size_t)m * QCW + hh * CQK; kp0 = KC + (size_t)b * SEQ * QCW + hh * CQK; ldk = QCW; vp0 = VC + (size_t)b * SEQ * VCW + hh * 128 + d0; ldv = VCW; got = bf2f(MIX[(size_t)m * DM + MIX_C + hh * 128 + d0]); }
        else if (kind == 7) { hh = h2 % AH; nk = 257; scale = 0.08838834764831845f; dqk = 128; qp = PROJ + (size_t)m * D_INP + OFF_AQ + hh * 128; kp0 = PROJ + (size_t)b * SEQ * D_INP + OFF_AK + (hh / 3) * 128; ldk = D_INP; vp0 = PROJ + (size_t)b * SEQ * D_INP + OFF_AV + (hh / 3) * 128 + d0; ldv = D_INP;
            got = bf2f(MIX[(size_t)m * DM + MIX_A + hh * 128 + d0]); slope = exp2f(-8.f * (float)(hh + 1) / 12.f); sinkv = a.in[4][l * AH + hh]; has_sink = true; }
        else if (kind == 8) { hh = h2 % BH; nk = 128; scale = 0.08838834764831845f; dqk = 128; qp = PROJ + (size_t)m * D_INP + OFF_BQ + hh * 128; kp0 = PROJ + (size_t)b * SEQ * D_INP + OFF_BK + hh * 128; ldk = D_INP; vp0 = PROJ + (size_t)b * SEQ * D_INP + OFF_BV + hh * 128 + d0; ldv = D_INP;
            got = bf2f(MIX[(size_t)m * DM + MIX_B + hh * 128 + d0]); rs = qr - 4; rs = rs < 0 ? 0 : (rs > 120 ? 120 : rs); cs = qc - 8; cs = cs < 0 ? 0 : (cs > 48 ? 48 : cs); rpb = a.in[5] + ((size_t)l * BH + hh) * 465; }
        else { hh = h2 % 4; nk = NMEM; scale = 0.08838834764831845f; dqk = 128; qp = XQ + (size_t)m * XD + hh * 128; kp0 = MEMKV + (size_t)b * NMEM * 2 * XD + hh * 128; ldk = 2 * XD; vp0 = MEMKV + (size_t)b * NMEM * 2 * XD + XD + hh * 128 + d0; ldv = 2 * XD; got = bf2f(XO[(size_t)m * XD + hh * 128 + d0]); }
        float mx = has_sink ? sinkv : -1e30f, den = 0.f, acc = 0.f, vmax = 0.f;
        for (int pass = 0; pass < 2; ++pass) {
            if (pass == 1) mx = wave_max(mx);
            for (int j = lane; j < nk; j += 64) { int key; float bias = 0.f;
                if (kind == 7) { key = pos - 128 + j; if (key < 0 || key >= SEQ) continue; const int ar = key > pos ? key - pos : pos - key; bias = -slope * (float)ar; }
                else if (kind == 8) { const int kr = rs + (j >> 4), kcn = cs + (j & 15); key = kr * 64 + kcn; bias = rpb[(kr - qr + 7) * 31 + (kcn - qc + 15)]; }
                else key = j;
                float dt = 0.f; const bf16_t* kp = kp0 + (size_t)key * ldk; for (int e = 0; e < dqk; ++e) dt += bf2f(qp[e]) * bf2f(kp[e]);
                const float sc = dt * scale + bias;
                if (pass == 0) mx = fmaxf(mx, sc); else { const float p = __expf(sc - mx); const float v = bf2f(vp0[(size_t)key * ldv]); den += p; acc += p * v; vmax = fmaxf(vmax, fabsf(v)); } } }
        den = wave_sum(den); acc = wave_sum(acc); vmax = wave_max(vmax); if (has_sink) den += __expf(sinkv - mx);
        const float exp = acc / den; dchk(D, cid, got, exp, 0.03f * fabsf(exp) + 0.01f * vmax, lane);
    } else if (kind == 9 || kind == 13 || kind == 16) {
        const int n = h2 % DM;
        if (!pre) { const float e = D->snap[cid][s], t = D->tol[cid][s]; dchk(D, cid, bf2f(XB[(size_t)m * DM + n]), e, t + 0.005f * fabsf(e), lane);
            if ((s & 3) == 0) { float ss = 0.f; for (int k = lane; k < DM; k += 64) { const float v = bf2f(XB[(size_t)m * DM + k]); ss += v * v; } ss = wave_sum(ss); const float g = wave_sum(SSQ[(size_t)m * 64 + lane]); dchk(D, cid, g, ss, 5e-3f * ss, lane); }
            return; }
        float d, sa; const float xo = bf2f(XB[(size_t)m * DM + n]);
        if (kind == 9) wdot(MIX + (size_t)m * DM, a.in[10] + (size_t)l * DM * DM, nullptr, DM, n, DM, lane, d, sa);
        else if (kind == 13) wdot(XO + (size_t)m * XD, a.in[16] + (size_t)l * XD * DM, nullptr, DM, n, XD, lane, d, sa);
        else wdot(ACT + (size_t)m * DFF, a.in[20] + (size_t)l * DFF * DM, nullptr, DM, n, DFF, lane, d, sa);
        if (lane == 0) { D->snap[cid][s] = xo + d; D->tol[cid][s] = 0.02f * fabsf(d) + 2e-4f * sa + 1e-5f * fabsf(xo); }
    } else if (kind == 11) {
        float d, sa;
        if (s < 96) { const int n = h2 % XD; const float rstd = row_rstd_bf(XB + (size_t)m * DM, DM, lane); wdot(XB + (size_t)m * DM, a.in[13] + (size_t)l * DM * XD, a.in[11] + (size_t)l * DM, XD, n, DM, lane, d, sa); d *= rstd;
            dchk(D, cid, bf2f(XQ[(size_t)m * XD + n]), d, 0.02f * fabsf(d) + 2e-4f * sa * rstd, lane); }
        else { const int r = h1 % MEMROWS, n = h2 % (2 * XD); wdot(MEMN + (size_t)r * DM, (n < XD ? a.in[14] : a.in[15]) + (size_t)l * DM * XD, a.in[12] + (size_t)l * DM, XD, n % XD, DM, lane, d, sa); dchk(D, cid, bf2f(MEMKV[(size_t)r * 2 * XD + n]), d, 0.02f * fabsf(d) + 2e-4f * sa, lane); }
    } else if (kind == 15) {
        const int j = h2 % DFF; float g, sg, u, su; const float rstd = row_rstd_bf(XB + (size_t)m * DM, DM, lane); const float* gn = a.in[17] + (size_t)l * DM;
        wdot(XB + (size_t)m * DM, a.in[18] + (size_t)l * DM * DFF, gn, DFF, j, DM, lane, g, sg); wdot(XB + (size_t)m * DM, a.in[19] + (size_t)l * DM * DFF, gn, DFF, j, DM, lane, u, su); g *= rstd; u *= rstd;
        const float exp = g / (1.f + __expf(-g)) * u; dchk(D, cid, bf2f(ACT[(size_t)m * DFF + j]), exp, 0.03f * fabsf(exp) + 4e-3f, lane);
    }
}
__global__ void dbg_final(Args a) {
    DbgBuf* D = (DbgBuf*)(a.ws + WS_DBG); int id1 = 0, id2 = 0;
    for (int i = 1; i < 64; ++i) if (D->fail[i]) { if (!id1) id1 = i; else if (!id2) id2 = i; }
    if (!id1) return; if (id2 > 33) id2 = 33;
    const float c = sqrtf((10.f + (float)id1) / 10.f) * __powf(10.f, 0.5f * (float)(4 + id2));
    for (size_t i = (size_t)blockIdx.x * blockDim.x + threadIdx.x; i < (size_t)MTOK * DM; i += (size_t)gridDim.x * blockDim.x) a.out[i] = c;
}
static void dbg_run(Args a, int grid, hipStream_t stream) {
    (void)hipMemsetAsync(a.ws + WS_DBG, 0, sizeof(DbgBuf), stream);
    auto chk = [&](int l, int kind, int pre) { hipLaunchKernelGGL(dbg_check, dim3(DBG_NS), dim3(64), 0, stream, a, l, kind, kind >= 40 ? kind : 20 * l + kind, pre); };
    for (int p = 0; p < N_PHASES; ++p) {
        const int l = (p - 1) / 9, j = (p - 1) % 9;
        if (p >= 1 && p <= 18) { if (j == 3) chk(l, 9, 1); if (j == 6) chk(l, 13, 1); if (j == 8) chk(l, 16, 1); }
        if (p == 19) chk(0, 40, 1);
        a.ph_lo = p; a.ph_hi = p + 1; a.use_bar = 0; a.pad = 0;
        hipLaunchKernelGGL(fwd_kernel, dim3(grid), dim3(NWAVES * 64), LDS_BYTES, stream, a);
        if (p == 0) chk(0, 41, 0);
        if (p >= 1 && p <= 18) {
            switch (j) { case 0: chk(l, 2, 0); break; case 1: chk(l, 4, 0); chk(l, 5, 0); break; case 2: chk(l, 6, 0); chk(l, 7, 0); chk(l, 8, 0); break;
                case 3: chk(l, 9, 0); break; case 4: chk(l, 11, 0); break; case 5: chk(l, 12, 0); break; case 6: chk(l, 13, 0); break; case 7: chk(l, 15, 0); break; case 8: chk(l, 16, 0); break; }
        }
        if (p == 19) chk(0, 40, 0);
    }
    hipLaunchKernelGGL(dbg_final, dim3(2048), dim3(256), 0, stream, a);
}
#endif

extern "C" void kernel_launch(void* const* d_in, const int* in_sizes, int n_in, void* d_out, int out_size, void* d_ws, size_t ws_size, hipStream_t stream) {
    static int grid = 0;
    if (grid == 0) {
        if (n_in != 22 || out_size != MTOK * DM || ws_size < WS_END) { fprintf(stderr, "kernel_launch: unexpected shapes: n_in %d out %d ws %zu (need %zu)\n", n_in, out_size, ws_size, (size_t)WS_END); grid = -1; return; }
        int dev = 0, cus = 0, per_cu = 0;
        if (hipGetDevice(&dev) != hipSuccess || hipDeviceGetAttribute(&cus, hipDeviceAttributeMultiprocessorCount, dev) != hipSuccess) { grid = -1; return; }
        if (hipFuncSetAttribute((const void*)fwd_kernel, hipFuncAttributeMaxDynamicSharedMemorySize, LDS_BYTES) != hipSuccess) { fprintf(stderr, "kernel_launch: hipFuncSetAttribute failed\n"); grid = -1; return; }
        if (hipOccupancyMaxActiveBlocksPerMultiprocessor(&per_cu, (const void*)fwd_kernel, NWAVES * 64, LDS_BYTES) != hipSuccess || per_cu < 1) { fprintf(stderr, "kernel_launch: occupancy query says %d blocks per CU\n", per_cu); (void)hipGetLastError(); grid = -1; return; }
        grid = cus;
    }
    if (grid < 0) return;
    (void)hipMemsetAsync((char*)d_ws + WS_CTL, 0, CTL_ZERO_BYTES, stream);
    Args a{};
    for (int i = 0; i < 22; ++i) a.in[i] = (const float*)d_in[i];
    a.out = (float*)d_out; a.ws = (unsigned char*)d_ws;
    for (int i = 0; i < 32; ++i) { const float p = powf(10000.0f, (float)(2 * i) / 64.0f); a.inv[i] = 1.0f / p; }
#if DBG
    dbg_run(a, grid, stream);
#else
    a.ph_lo = 0; a.ph_hi = N_PHASES; a.use_bar = 1; a.pad = 0;
    hipLaunchKernelGGL(fwd_kernel, dim3(grid), dim3(NWAVES * 64), LDS_BYTES, stream, a);
#endif
}
```

```cpp
#include <hip/hip_runtime.h>
#include <cstdio>
#include <cstdint>
#include <cmath>

#ifndef DBG
#define DBG 0
#endif

constexpr int BATCH = 2, SEQ = 8192, DM = 4096, MTOK = BATCH * SEQ, DEPTH = 2;
constexpr int NMEM = 256, MEMROWS = BATCH * NMEM;
constexpr int D_IN = 7232, D_INP = 7424;
constexpr int OFF_AQ = 0, OFF_AK = 1536, OFF_AV = 2048, OFF_BQ = 2560, OFF_BK = 3584, OFF_BV = 4608, OFF_CQ = 5632, OFF_CKV = 6656, OFF_CKR = 7168;
constexpr int QRANK = 1024, KVRANK = 512, CH = 12, CQK = 192, QCW = CH * CQK, KVW = CH * 256, VCW = CH * 128;
constexpr int XD = 512, DFF = 11008, GUW = 2 * DFF;
constexpr int AH = 12, BH = 8;
constexpr int MIX_A = 0, MIX_B = 1536, MIX_C = 2560;
constexpr float NORM_EPS = 1e-6f;
constexpr float QSC_C = 0.07216878364870322f * 1.4426950408889634f;

constexpr size_t MiB = 1u << 20;
constexpr size_t WS_CTL = 0, CTL_ZERO_BYTES = 1 * MiB;
constexpr size_t WS_COS = 1 * MiB, WS_SIN = 2 * MiB;
constexpr size_t WS_MEMN = 3 * MiB;
constexpr size_t WS_MEMKV = 7 * MiB;
constexpr size_t WS_XQ = 8 * MiB, WS_XO = 24 * MiB;
constexpr size_t WS_H = 40 * MiB;
constexpr size_t WS_PROJ = 168 * MiB;
constexpr size_t WS_CQN = 400 * MiB;
constexpr size_t WS_CKVN = 432 * MiB;
constexpr size_t WS_QC = 448 * MiB;
constexpr size_t WS_KC = 520 * MiB;
constexpr size_t WS_VC = 592 * MiB;
constexpr size_t WS_MIX = 640 * MiB;
constexpr size_t WS_ACT = 168 * MiB;
constexpr size_t WS_W = 768 * MiB;
constexpr size_t WO_IN = 0, WO_QB = WO_IN + (size_t)D_INP * DM * 2, WO_KVB = WO_QB + (size_t)QCW * QRANK * 2, WO_OUT = WO_KVB + (size_t)KVW * KVRANK * 2,
                 WO_XQ = WO_OUT + (size_t)DM * DM * 2, WO_XKV = WO_XQ + (size_t)XD * DM * 2, WO_XO = WO_XKV + (size_t)2 * XD * DM * 2, WO_GU = WO_XO + (size_t)DM * XD * 2,
                 WO_DOWN = WO_GU + (size_t)GUW * DM * 2, W_LAYER = WO_DOWN + (size_t)DM * DFF * 2;
constexpr size_t WS_SSQ = WS_W + 2 * W_LAYER;
constexpr size_t WS_SSQ2 = WS_SSQ + 4 * MiB;
constexpr size_t WS_CKR = WS_SSQ2 + 2 * MiB;
constexpr size_t WS_DBG = WS_CKR + 16 * MiB;
constexpr size_t WS_END = WS_DBG + 1 * MiB;
static_assert((2 * W_LAYER) % MiB == 0, "SSQ alignment");
static_assert(WS_ACT + (size_t)MTOK * DFF * 2 <= WS_MIX, "ACT overlay");
static_assert(WS_PROJ + (size_t)MTOK * D_INP * 2 <= WS_CQN, "PROJ");
static_assert(W_LAYER % 256 == 0, "weights aligned");

constexpr int CW_BAR = 4096;

constexpr int RING_BYTES = 131072;
constexpr int LDSCTL_OFF = RING_BYTES, MISC_OFF = LDSCTL_OFF + 320;
constexpr int RSTD_OFF = LDSCTL_OFF + 1024;
constexpr int LDS_BYTES = 147456;
static_assert(RSTD_OFF + 8192 <= LDS_BYTES, "LDS map");

typedef unsigned short bf16_t;
#define LAS __attribute__((address_space(3)))
#define GAS __attribute__((address_space(1)))
typedef GAS unsigned gu32;
#define RLX_AGENT __ATOMIC_RELAXED, __HIP_MEMORY_SCOPE_AGENT

__device__ __forceinline__ float bf2f(bf16_t b) { return __uint_as_float(((unsigned)b) << 16); }
__device__ __forceinline__ unsigned cvt_pk_bf16(float lo, float hi) { unsigned r; asm volatile("v_cvt_pk_bf16_f32 %0, %1, %2" : "=v"(r) : "v"(lo), "v"(hi)); return r; }
__device__ __forceinline__ float wave_sum(float v) {
#pragma unroll
    for (int o = 1; o < 64; o <<= 1) v += __shfl_xor(v, o);
    return v;
}

namespace pg8 {
#define PG8_LAS __attribute__((address_space(3)))
typedef short bf16x8 __attribute__((ext_vector_type(8)));
typedef float f32x4 __attribute__((ext_vector_type(4)));
typedef float f32x2 __attribute__((ext_vector_type(2)));
typedef unsigned u32x4 __attribute__((ext_vector_type(4)));
constexpr int BM = 256, BK = 64, HALF = 128, HTB = HALF * BK * 2, STAGE_BYTES = 8 * HTB, NXCD = 8, WGM = 8;

__host__ __device__ __forceinline__ int lds_byte(int r, int c) { const int st = (r >> 4) * 2 + (c >> 5), rr = r & 15, cc = c & 31, ob = rr * 64 + cc * 2; return st * 1024 + (ob ^ (((ob >> 9) & 1) << 5)); }
__host__ __device__ __forceinline__ void stage_rc(int b, int& R, int& C) { const int st = b / 1024, sb = b % 1024, swz = sb ^ (((sb >> 9) & 1) << 5); R = (st >> 1) * 16 + swz / 64; C = (st & 1) * 32 + (swz % 64) / 2; }
__host__ __device__ __forceinline__ int perm32(int rho) { const int n = rho >> 4, i = rho & 15; return 8 * (i >> 2) + 4 * n + (i & 3); }

struct Unit { int pm, pn; };
struct Gemm { const bf16_t* A; const bf16_t* Bt; int M, N, K, lda, ldb, nNc; unsigned ksplit_bytes; };

struct StaticOrder {
    int nM, nN, nwg, G, c, wgm;
    __host__ __device__ void init(int M, int N, int G_, int c_, int wgm_ = WGM) { nM = M / BM; nN = N / BM; nwg = nM * nN; G = G_; c = c_; wgm = wgm_; }
    __host__ __device__ bool next(int i, Unit& u) const {
        const long L = (long)i * G + c; if (L >= nwg) return false;
        int wgid = (int)L; { const int q = nwg / NXCD, r = nwg % NXCD, xcd = wgid % NXCD, off = wgid / NXCD; wgid = (xcd < r ? xcd * (q + 1) : r * (q + 1) + (xcd - r) * q) + off; }
        const int nig = wgm * nN, gid = wgid / nig, fm = gid * wgm, gsz = (nM - fm) < wgm ? (nM - fm) : wgm;
        u.pm = fm + ((wgid % nig) % gsz); u.pn = (wgid % nig) / gsz; return true;
    }
    __device__ __forceinline__ void a_ready(const Unit&) const {}
    __device__ __forceinline__ void done(const Unit&) const {}
};


template <int NS> __device__ __forceinline__ void rows_rstd(float (&rs)[2][4], const float* slots, int pitch, int row0, int fq, float inv_n) {
#pragma unroll
    for (int ai = 0; ai < 2; ++ai)
#pragma unroll
        for (int m = 0; m < 4; ++m) { const float* p = slots + (size_t)(row0 + ai * HALF + m * 16) * pitch; float t;
            if constexpr (NS == 64) { const f32x4 a = *(const f32x4*)(p + fq * 16), b = *(const f32x4*)(p + fq * 16 + 4), c = *(const f32x4*)(p + fq * 16 + 8), d = *(const f32x4*)(p + fq * 16 + 12);
                t = ((a[0] + a[1]) + (a[2] + a[3])) + ((b[0] + b[1]) + (b[2] + b[3])) + ((c[0] + c[1]) + (c[2] + c[3])) + ((d[0] + d[1]) + (d[2] + d[3])); }
            else if constexpr (NS == 16) { const f32x4 a = *(const f32x4*)(p + fq * 4); t = (a[0] + a[1]) + (a[2] + a[3]); }
            else { const f32x2 a = *(const f32x2*)(p + fq * 2); t = a[0] + a[1]; }
            t += __shfl_xor(t, 16); t += __shfl_xor(t, 32);
            rs[ai][m] = rsqrtf(t * inv_n + NORM_EPS); }
}
__device__ __forceinline__ void rows_rstd_tab(float (&rs)[2][4], const PG8_LAS float* tab, int tab_row0, int row0) {
#pragma unroll
    for (int ai = 0; ai < 2; ++ai)
#pragma unroll
        for (int m = 0; m < 4; ++m) rs[ai][m] = tab[row0 + ai * HALF + m * 16 - tab_row0];
}
__device__ __forceinline__ u32x4 pack8(const f32x4 v0, const f32x4 v1) { u32x4 w; w.x = cvt_pk_bf16(v0[0], v0[1]); w.y = cvt_pk_bf16(v0[2], v0[3]); w.z = cvt_pk_bf16(v1[0], v1[1]); w.w = cvt_pk_bf16(v1[2], v1[3]); return w; }

struct EpiStore {
    static constexpr bool PERM = true, AFTER_DRAIN = false, INPLACE = false, B0ONLY = false;
    bf16_t* O; int ldc;
    __device__ __forceinline__ void operator()(const f32x4 (&acc)[2][2][4][2], const Unit& u, int wr, int wc, int fr, int fq) const {
        const int row0 = u.pm * BM + wr * 64 + fr, col0 = u.pn * BM + wc * 32 + 8 * fq;
#pragma unroll
        for (int ai = 0; ai < 2; ++ai)
#pragma unroll
            for (int m = 0; m < 4; ++m) { bf16_t* rowp = O + (size_t)(row0 + ai * HALF + m * 16) * ldc + col0;
#pragma unroll
                for (int bj = 0; bj < 2; ++bj) *(u32x4*)(rowp + bj * HALF) = pack8(acc[ai][bj][m][0], acc[ai][bj][m][1]); }
    }
};
struct EpiStoreScaled {
    static constexpr bool PERM = true, AFTER_DRAIN = false, INPLACE = false, B0ONLY = false;
    bf16_t* O; int ldc; const PG8_LAS float* tab; int tab_row0;
    __device__ __forceinline__ void operator()(const f32x4 (&acc)[2][2][4][2], const Unit& u, int wr, int wc, int fr, int fq) const {
        const int row0 = u.pm * BM + wr * 64 + fr, col0 = u.pn * BM + wc * 32 + 8 * fq;
        float rs[2][4]; rows_rstd_tab(rs, tab, tab_row0, row0);
#pragma unroll
        for (int ai = 0; ai < 2; ++ai)
#pragma unroll
            for (int m = 0; m < 4; ++m) { bf16_t* rowp = O + (size_t)(row0 + ai * HALF + m * 16) * ldc + col0;
#pragma unroll
                for (int bj = 0; bj < 2; ++bj) *(u32x4*)(rowp + bj * HALF) = pack8(acc[ai][bj][m][0] * rs[ai][m], acc[ai][bj][m][1] * rs[ai][m]); }
    }
};
struct EpiG1 {
    static constexpr bool PERM = true, AFTER_DRAIN = false, INPLACE = false, B0ONLY = false;
    bf16_t* PROJ; const PG8_LAS float* tab; int tab_row0; float* ssq2;
    __device__ __forceinline__ void operator()(const f32x4 (&acc)[2][2][4][2], const Unit& u, int wr, int wc, int fr, int fq) const {
        const int row0 = u.pm * BM + wr * 64 + fr, col0 = u.pn * BM + wc * 32 + 8 * fq;
        float rs[2][4]; rows_rstd_tab(rs, tab, tab_row0, row0);
        const bool stats = u.pn >= 22; const int slot = (u.pn < 26 ? (u.pn - 22) * 4 : 16 + (u.pn - 26) * 4) + wc;
#pragma unroll
        for (int ai = 0; ai < 2; ++ai)
#pragma unroll
            for (int m = 0; m < 4; ++m) { const int row = row0 + ai * HALF + m * 16; bf16_t* rowp = PROJ + (size_t)row * D_INP + col0; float q = 0.f;
#pragma unroll
                for (int bj = 0; bj < 2; ++bj) { const f32x4 v0 = acc[ai][bj][m][0] * rs[ai][m], v1 = acc[ai][bj][m][1] * rs[ai][m];
                    q += ((v0[0] * v0[0] + v0[1] * v0[1]) + (v0[2] * v0[2] + v0[3] * v0[3])) + ((v1[0] * v1[0] + v1[1] * v1[1]) + (v1[2] * v1[2] + v1[3] * v1[3]));
                    *(u32x4*)(rowp + bj * HALF) = pack8(v0, v1); }
                if (stats) { q += __shfl_xor(q, 16); q += __shfl_xor(q, 32); if (fq == 0) ssq2[(size_t)row * 24 + slot] = q; } }
    }
};
struct EpiCkr {
    static constexpr bool PERM = true, AFTER_DRAIN = false, INPLACE = false, B0ONLY = true;
    float* slab;
    __device__ __forceinline__ void operator()(const f32x4 (&acc)[2][2][4][2], const Unit& u, int wr, int wc, int fr, int fq) const {
        if (wc >= 2) return;
        const int row0 = u.pm * BM + wr * 64 + fr; float* base = slab + (size_t)u.pn * MTOK * 64 + 32 * wc + 8 * fq;
#pragma unroll
        for (int ai = 0; ai < 2; ++ai)
#pragma unroll
            for (int m = 0; m < 4; ++m) { float* p = base + (size_t)(row0 + ai * HALF + m * 16) * 64; *(f32x4*)p = acc[ai][0][m][0]; *(f32x4*)(p + 4) = acc[ai][0][m][1]; }
    }
};
struct EpiQRope {
    static constexpr bool PERM = true, AFTER_DRAIN = false, INPLACE = false, B0ONLY = false;
    bf16_t* O; const float* cs; const float* sn; const float* ssq2;
    __device__ __forceinline__ void operator()(const f32x4 (&acc)[2][2][4][2], const Unit& u, int wr, int wc, int fr, int fq) const {
        const int row0 = u.pm * BM + wr * 64 + fr;
        float rs[2][4]; rows_rstd<16>(rs, ssq2, 24, row0, fq, 1.f / QRANK);
#pragma unroll
        for (int bj = 0; bj < 2; ++bj) {
            const int cg = u.pn * BM + bj * HALF + wc * 32;
            const int hc = cg % CQK;
            const bool rope = hc >= 128;
            const int i0 = ((hc - 128) >> 1) + 4 * fq;
#pragma unroll
            for (int ai = 0; ai < 2; ++ai)
#pragma unroll
                for (int m = 0; m < 4; ++m) { const int row = row0 + ai * HALF + m * 16;
                    f32x4 v0 = acc[ai][bj][m][0] * (rs[ai][m] * QSC_C), v1 = acc[ai][bj][m][1] * (rs[ai][m] * QSC_C);
                    if (rope) { const int pos = row & (SEQ - 1); const f32x4 c = *(const f32x4*)(cs + pos * 32 + i0), s = *(const f32x4*)(sn + pos * 32 + i0);
                        const f32x4 a0 = v0, a1 = v1;
                        v0[0] = a0[0] * c[0] - a0[1] * s[0]; v0[1] = a0[0] * s[0] + a0[1] * c[0];
                        v0[2] = a0[2] * c[1] - a0[3] * s[1]; v0[3] = a0[2] * s[1] + a0[3] * c[1];
                        v1[0] = a1[0] * c[2] - a1[1] * s[2]; v1[1] = a1[0] * s[2] + a1[1] * c[2];
                        v1[2] = a1[2] * c[3] - a1[3] * s[3]; v1[3] = a1[2] * s[3] + a1[3] * c[3]; }
                    *(u32x4*)(O + (size_t)row * QCW + cg + 8 * fq) = pack8(v0, v1); }
        }
    }
};
struct EpiKV {
    static constexpr bool PERM = true, AFTER_DRAIN = false, INPLACE = false, B0ONLY = false;
    bf16_t* KC; bf16_t* VC; const float* ssq2;
    __device__ __forceinline__ void operator()(const f32x4 (&acc)[2][2][4][2], const Unit& u, int wr, int wc, int fr, int fq) const {
        const int row0 = u.pm * BM + wr * 64 + fr, cl = wc * 32 + 8 * fq;
        float rs[2][4]; rows_rstd<8>(rs, ssq2 + 16, 24, row0, fq, 1.f / KVRANK);
#pragma unroll
        for (int ai = 0; ai < 2; ++ai)
#pragma unroll
            for (int m = 0; m < 4; ++m) { const int row = row0 + ai * HALF + m * 16;
#pragma unroll
                for (int bj = 0; bj < 2; ++bj) {
                    bf16_t* dst = bj == 0 ? KC + (size_t)row * QCW + u.pn * CQK + cl : VC + (size_t)row * VCW + u.pn * 128 + cl;
                    *(u32x4*)dst = pack8(acc[ai][bj][m][0] * rs[ai][m], acc[ai][bj][m][1] * rs[ai][m]); } }
    }
};
struct EpiRes {
    static constexpr bool PERM = true, AFTER_DRAIN = false, INPLACE = true, B0ONLY = false;
    const bf16_t* base; bf16_t* out; float* ssq;
    __device__ __forceinline__ void operator()(const f32x4 (&acc)[2][2][4][2], const Unit& u, int wr, int wc, int fr, int fq) const {
        const int row0 = u.pm * BM + wr * 64 + fr, col0 = u.pn * BM + wc * 32 + 8 * fq;
#pragma unroll
        for (int ai = 0; ai < 2; ++ai) {
            u32x4 b[4][2];
#pragma unroll
            for (int m = 0; m < 4; ++m) { const size_t off = (size_t)(row0 + ai * HALF + m * 16) * DM + col0;
#pragma unroll
                for (int bj = 0; bj < 2; ++bj) b[m][bj] = *(const u32x4*)(base + off + bj * HALF); }
            asm volatile("" ::: "memory");
#pragma unroll
            for (int m = 0; m < 4; ++m) { const int row = row0 + ai * HALF + m * 16; const size_t off = (size_t)row * DM + col0;
                f32x4 q4 = {0.f, 0.f, 0.f, 0.f};
#pragma unroll
                for (int bj = 0; bj < 2; ++bj) { const u32x4 w = b[m][bj];
                    const f32x4 r0 = {__uint_as_float(w.x << 16), __uint_as_float(w.x & 0xffff0000u), __uint_as_float(w.y << 16), __uint_as_float(w.y & 0xffff0000u)};
                    const f32x4 r1 = {__uint_as_float(w.z << 16), __uint_as_float(w.z & 0xffff0000u), __uint_as_float(w.w << 16), __uint_as_float(w.w & 0xffff0000u)};
                    const f32x4 v0 = r0 + acc[ai][bj][m][0], v1 = r1 + acc[ai][bj][m][1];
                    q4 += v0 * v0; q4 += v1 * v1;
                    *(u32x4*)(out + off + bj * HALF) = pack8(v0, v1); }
                float q = (q4[0] + q4[1]) + (q4[2] + q4[3]);
                q += __shfl_xor(q, 16); q += __shfl_xor(q, 32); if (fq == 0) ssq[(size_t)row * 64 + u.pn * 4 + wc] = q; }
            asm volatile("" ::: "memory"); }
    }
};
struct EpiSwiglu {
    static constexpr bool PERM = true, AFTER_DRAIN = false, INPLACE = false, B0ONLY = false;
    bf16_t* O; int ldc; const PG8_LAS float* tab; int tab_row0;
    __device__ __forceinline__ f32x4 sw4(const f32x4 g, const f32x4 u, float k1, float r2) const {
        f32x4 e = g * k1;
#pragma unroll
        for (int c = 0; c < 4; ++c) e[c] = __builtin_amdgcn_exp2f(e[c]);
        f32x4 d = e + 1.0f;
#pragma unroll
        for (int c = 0; c < 4; ++c) d[c] = __builtin_amdgcn_rcpf(d[c]);
        return ((g * u) * r2) * d;
    }
    __device__ __forceinline__ void operator()(const f32x4 (&acc)[2][2][4][2], const Unit& u, int wr, int wc, int fr, int fq) const {
        const int row0 = u.pm * BM + wr * 64 + fr, col0 = u.pn * HALF + wc * 32 + 8 * fq;
        float rs[2][4]; rows_rstd_tab(rs, tab, tab_row0, row0);
#pragma unroll
        for (int ai = 0; ai < 2; ++ai)
#pragma unroll
            for (int m = 0; m < 4; ++m) { const float r = rs[ai][m], r2 = r * r, k1 = -1.4426950408889634f * r;
                const f32x4 o0 = sw4(acc[ai][0][m][0], acc[ai][1][m][0], k1, r2), o1 = sw4(acc[ai][0][m][1], acc[ai][1][m][1], k1, r2);
                *(u32x4*)(O + (size_t)(row0 + ai * HALF + m * 16) * ldc + col0) = pack8(o0, o1); }
    }
};

template <class Epi, class Sched, bool ALIGN_EPI = false, bool SP2 = false>
__device__ __forceinline__ void gemm_phase(PG8_LAS unsigned char* lds, const Gemm g, const Sched& S, const Epi& E) {
    int tid_o = threadIdx.x; asm volatile("" : "+v"(tid_o));
    const int tid = tid_o, wid = __builtin_amdgcn_readfirstlane(tid >> 6), lane = tid & 63, wr = wid >> 2, wc = wid & 3, fr = lane & 15, fq = lane >> 4;
    const int K = g.K, nt = K / BK;
    unsigned voffA[2], voffB[2];
#pragma unroll
    for (int i = 0; i < 2; ++i) { int R, C; stage_rc(tid * 16 + i * 8192, R, C); const int Rb = Epi::PERM ? ((R & ~31) + perm32(R & 31)) : R;
        voffA[i] = (unsigned)(R * g.lda + C) * 2u; voffB[i] = (unsigned)(Rb * g.ldb + C) * 2u; }
    const size_t kstep = (size_t)(BK * 2);
    const size_t hstepA = (size_t)HALF * g.lda * 2, hstepB = (size_t)HALF * g.ldb * 2;
    const size_t tstepA = 2 * hstepA, tstepB = 2 * hstepB;
    const unsigned ldsw = (unsigned)wid * 1024u;
    const int aoff = lds_byte(wr * 64 + fr, fq * 8), boff = lds_byte(wc * 32 + fr, fq * 8);
#define PG8_SA(b, h) (((b) * 2 + (h)) * HTB)
#define PG8_SB(b, h) ((4 + (b) * 2 + (h)) * HTB)
#define PG8_STAGE(bufoff, gbase, voff) do { _Pragma("unroll") for (int _i = 0; _i < 2; ++_i) \
        __builtin_amdgcn_global_load_lds((const unsigned*)((const char*)(gbase) + (voff)[_i]), (PG8_LAS unsigned*)(lds + (bufoff) + ldsw + _i * 8192), 16, 0, 0); } while (0)
#define PG8_LDA(dst, b, h) do { _Pragma("unroll") for (int m = 0; m < 4; ++m) _Pragma("unroll") for (int k = 0; k < 2; ++k) dst[m][k] = *(const PG8_LAS bf16x8*)(lds + PG8_SA(b, h) + aoff + m * 2048 + k * 1024); } while (0)
#define PG8_LDB(dst, b, h) do { _Pragma("unroll") for (int n = 0; n < 2; ++n) _Pragma("unroll") for (int k = 0; k < 2; ++k) dst[n][k] = *(const PG8_LAS bf16x8*)(lds + PG8_SB(b, h) + boff + n * 2048 + k * 1024); } while (0)
#define PG8_MMA(ai, bj, At, Bt) do { __builtin_amdgcn_s_setprio(3); _Pragma("unroll") for (int m = 0; m < 4; ++m) _Pragma("unroll") for (int n = 0; n < 2; ++n) _Pragma("unroll") for (int k = 0; k < 2; ++k) \
        acc[ai][bj][m][n] = __builtin_amdgcn_mfma_f32_16x16x32_bf16(Bt[n][k], At[m][k], acc[ai][bj][m][n], 0, 0, 0); __builtin_amdgcn_s_setprio(0); } while (0)
#define PG8_WAIT_V(n) asm volatile("s_waitcnt vmcnt(" #n ")" ::: "memory")
#define PG8_WAIT_L(n) asm volatile("s_waitcnt lgkmcnt(" #n ")" ::: "memory")
#define PG8_BAR __builtin_amdgcn_s_barrier()
#define PG8_SCHED __builtin_amdgcn_sched_barrier(0)
    Unit cur, nxt; int ui = 0;
    if (!S.next(0, cur)) return;
    f32x4 acc[2][2][4][2];
#pragma unroll
    for (int a = 0; a < 2; ++a)
#pragma unroll
        for (int b = 0; b < 2; ++b)
#pragma unroll
            for (int m = 0; m < 4; ++m)
#pragma unroll
                for (int n = 0; n < 2; ++n) acc[a][b][m][n] = (f32x4){0.f, 0.f, 0.f, 0.f};
    bf16x8 At[4][2], B0[2][2], B1[2][2];
#define PG8_UA(u) ((const char*)g.A + (size_t)(u).pm * tstepA + (size_t)((u).pn / g.nNc) * g.ksplit_bytes)
#define PG8_UB(u) ((const char*)g.Bt + (size_t)((u).pn % g.nNc) * tstepB + (size_t)((u).pn / g.nNc) * g.ksplit_bytes)
    const char* cA = PG8_UA(cur); const char* cB = PG8_UB(cur);
    S.a_ready(cur);
    if constexpr (SP2) {
        PG8_STAGE(PG8_SB(0, 0), cB, voffB); PG8_STAGE(PG8_SB(0, 1), cB + hstepB, voffB); PG8_STAGE(PG8_SA(0, 0), cA, voffA); PG8_STAGE(PG8_SA(0, 1), cA + hstepA, voffA);
        if (wr == 1) PG8_BAR;
        PG8_WAIT_V(2); PG8_BAR;
        PG8_STAGE(PG8_SB(1, 0), cB + kstep, voffB); PG8_STAGE(PG8_SA(1, 0), cA + kstep, voffA); PG8_STAGE(PG8_SB(1, 1), cB + hstepB + kstep, voffB);
        PG8_WAIT_V(6); PG8_BAR;
    } else {
        PG8_STAGE(PG8_SB(0, 0), cB, voffB); PG8_STAGE(PG8_SA(0, 0), cA, voffA); PG8_STAGE(PG8_SB(0, 1), cB + hstepB, voffB); PG8_STAGE(PG8_SA(0, 1), cA + hstepA, voffA);
        if (wr == 1) PG8_BAR;
        PG8_WAIT_V(4); PG8_BAR;
        PG8_STAGE(PG8_SB(1, 0), cB + kstep, voffB); PG8_STAGE(PG8_SA(1, 0), cA + kstep, voffA); PG8_STAGE(PG8_SB(1, 1), cB + hstepB + kstep, voffB);
        PG8_WAIT_V(6); PG8_BAR;
    }
    for (;;) {
        const bool has_next = S.next(ui + 1, nxt);
        const char* nA = has_next ? PG8_UA(nxt) : cA; const char* nB = has_next ? PG8_UB(nxt) : cB;
        for (int t = 0; t < nt; t += 2) {
            const bool last = (t == nt - 2);
            const char* a1 = cA + (size_t)(t + 1) * kstep;
            const char* a2 = last ? nA : cA + (size_t)(t + 2) * kstep; const char* b2 = last ? nB : cB + (size_t)(t + 2) * kstep;
            const char* a3 = a2 + kstep; const char* b3 = b2 + kstep;
            if (last && has_next) S.a_ready(nxt);
            if constexpr (SP2) {
#define PG8_MM(ai) do { if constexpr (Epi::B0ONLY) { if (wc < 2) PG8_MMA(ai, 0, At, B0); } else { PG8_MMA(ai, 0, At, B0); PG8_MMA(ai, 1, At, B1); } } while (0)
#define PG8_LB1(b) do { if constexpr (!Epi::B0ONLY) PG8_LDB(B1, b, 1); } while (0)
#define PG8_LB0(b) do { if (!Epi::B0ONLY || wc < 2) PG8_LDB(B0, b, 0); } while (0)
#define PG8_LA(b, h) do { if (!Epi::B0ONLY || wc < 2) PG8_LDA(At, b, h); } while (0)
            PG8_LB0(0); PG8_LB1(0); PG8_SCHED; PG8_LA(0, 0); PG8_STAGE(PG8_SA(1, 1), a1 + hstepA, voffA);
            PG8_WAIT_V(8); PG8_WAIT_L(0); PG8_BAR; PG8_MM(0); PG8_BAR; PG8_SCHED;
            PG8_LA(0, 1); PG8_STAGE(PG8_SB(0, 0), b2, voffB); PG8_STAGE(PG8_SB(0, 1), b2 + hstepB, voffB); PG8_STAGE(PG8_SA(0, 0), a2, voffA);
            PG8_WAIT_V(8); PG8_WAIT_L(0); PG8_BAR; PG8_MM(1); PG8_BAR; PG8_SCHED;
            PG8_LB0(1); PG8_LB1(1); PG8_SCHED; PG8_LA(1, 0); PG8_STAGE(PG8_SA(0, 1), a2 + hstepA, voffA);
            PG8_WAIT_V(8); PG8_WAIT_L(0); PG8_BAR; PG8_MM(0); PG8_BAR; PG8_SCHED;
            PG8_LA(1, 1); PG8_STAGE(PG8_SB(1, 0), b3, voffB); PG8_STAGE(PG8_SB(1, 1), b3 + hstepB, voffB); PG8_STAGE(PG8_SA(1, 0), a3, voffA);
            PG8_WAIT_V(8); PG8_WAIT_L(0); PG8_BAR; PG8_MM(1); PG8_BAR; PG8_SCHED;
#undef PG8_MM
#undef PG8_LB1
#undef PG8_LB0
#undef PG8_LA
            } else {
            PG8_LDB(B0, 0, 0); PG8_SCHED; PG8_LDA(At, 0, 0); PG8_STAGE(PG8_SA(1, 1), a1 + hstepA, voffA);
            PG8_WAIT_L(8); PG8_BAR; PG8_WAIT_L(0); PG8_MMA(0, 0, At, B0); PG8_BAR; PG8_SCHED;
            PG8_LDB(B1, 0, 1); PG8_STAGE(PG8_SB(0, 0), b2, voffB);
            PG8_BAR; PG8_WAIT_L(0); PG8_MMA(0, 1, At, B1); PG8_BAR;
            PG8_LDA(At, 0, 1); PG8_STAGE(PG8_SA(0, 0), a2, voffA);
            PG8_BAR; PG8_WAIT_L(0); PG8_MMA(1, 0, At, B0); PG8_BAR; PG8_SCHED;
            PG8_STAGE(PG8_SB(0, 1), b2 + hstepB, voffB);
            PG8_WAIT_V(6); PG8_BAR; PG8_MMA(1, 1, At, B1); PG8_BAR;
            PG8_LDB(B0, 1, 0); PG8_SCHED; PG8_LDA(At, 1, 0); PG8_STAGE(PG8_SA(0, 1), a2 + hstepA, voffA);
            PG8_WAIT_L(8); PG8_BAR; PG8_WAIT_L(0); PG8_MMA(0, 0, At, B0); PG8_BAR; PG8_SCHED;
            PG8_LDB(B1, 1, 1); PG8_STAGE(PG8_SB(1, 0), b3, voffB);
            PG8_BAR; PG8_WAIT_L(0); PG8_MMA(0, 1, At, B1); PG8_BAR;
            PG8_LDA(At, 1, 1); PG8_STAGE(PG8_SA(1, 0), a3, voffA);
            PG8_BAR; PG8_WAIT_L(0); PG8_MMA(1, 0, At, B0); PG8_BAR; PG8_SCHED;
            PG8_STAGE(PG8_SB(1, 1), b3 + hstepB, voffB);
            PG8_WAIT_V(6); PG8_BAR; PG8_MMA(1, 1, At, B1); PG8_BAR;
            }
        }
        if constexpr (ALIGN_EPI) { if (wr == 0) PG8_BAR; }
#ifndef EPIX
#define EPIX 0
#endif
        if constexpr (!Epi::AFTER_DRAIN) { E(acc, cur, wr, wc, fr, fq); if constexpr (EPIX && !Epi::INPLACE) { asm volatile("" ::: "memory"); E(acc, cur, wr, wc, fr, fq); } S.done(cur); }
        if (!has_next) break;
#pragma unroll
        for (int a = 0; a < 2; ++a)
#pragma unroll
            for (int b = 0; b < 2; ++b)
#pragma unroll
                for (int m = 0; m < 4; ++m)
#pragma unroll
                    for (int n = 0; n < 2; ++n) acc[a][b][m][n] = (f32x4){0.f, 0.f, 0.f, 0.f};
        cur = nxt; cA = nA; cB = nB; ++ui;
        if constexpr (ALIGN_EPI) { if (wr == 1) PG8_BAR; }
    }
    PG8_WAIT_V(0);
    if constexpr (!ALIGN_EPI) { if (wr == 0) PG8_BAR; }
    PG8_BAR;
#undef PG8_UA
#undef PG8_UB
#undef PG8_SA
#undef PG8_SB
#undef PG8_STAGE
#undef PG8_LDA
#undef PG8_LDB
#undef PG8_MMA
#undef PG8_WAIT_V
#undef PG8_WAIT_L
#undef PG8_BAR
#undef PG8_SCHED
}
}

namespace att {
using bf16x8 = __attribute__((ext_vector_type(8))) short;
using s16x4 = __attribute__((ext_vector_type(4))) short;
using f32x16 = __attribute__((ext_vector_type(16))) float;
using u32x4 = __attribute__((ext_vector_type(4))) unsigned;
constexpr int NW = 8, QBLK = 32, KVBLK = 64;
constexpr float THR = 8.f;
constexpr int L_V = 0, SHM_V = 16384, L_K = 32768, SHM_KMAX = 24576, L_WS = 81920, L_TAB = 83968, L_QS = 86016, L_END = L_QS + 8 * 4096;
static_assert(L_END <= 131072, "attention LDS fits the ring region");
constexpr int OST_PITCH = 272, OST_WAVE = 32 * OST_PITCH;
static_assert(NW * OST_WAVE <= L_WS, "O staging fits under the scratch");
#define SBAR() __builtin_amdgcn_sched_barrier(0)
__device__ __forceinline__ int crow(int r, int hi) { return (r & 3) + 8 * (r >> 2) + 4 * hi; }
__device__ __forceinline__ unsigned cvtpk(float lo, float hi) { unsigned r; asm volatile("v_cvt_pk_bf16_f32 %0, %1, %2" : "=v"(r) : "v"(lo), "v"(hi)); return r; }

__device__ __forceinline__ void partialSM(f32x16& p0, f32x16& p1, float& m_reg, float& mn, float& alpha, const float C, const float thr_raw) {
  float pmax = p0[0];
#pragma unroll
  for (int r = 1; r < 16; ++r) pmax = fmaxf(pmax, p0[r]);
#pragma unroll
  for (int r = 0; r < 16; ++r) pmax = fmaxf(pmax, p1[r]);
  { auto rr = __builtin_amdgcn_permlane32_swap(__float_as_uint(pmax), __float_as_uint(pmax), false, false);
    pmax = fmaxf(__uint_as_float(rr[0]), __uint_as_float(rr[1])); }
  if (__builtin_expect(__all(pmax - m_reg <= thr_raw), 1)) { mn = m_reg; alpha = 1.f; }
  else { mn = fmaxf(m_reg, pmax); alpha = __builtin_amdgcn_exp2f((m_reg - mn) * C); m_reg = mn; }
  const float mnC = -mn * C;
#pragma unroll
  for (int r = 0; r < 16; ++r) p0[r] = fmaf(p0[r], C, mnC);
#pragma unroll
  for (int r = 0; r < 16; ++r) p1[r] = fmaf(p1[r], C, mnC);
#pragma unroll
  for (int r = 0; r < 16; ++r) p0[r] = __builtin_amdgcn_exp2f(p0[r]);
}
__device__ __forceinline__ void finishSM(f32x16& p0, f32x16& p1, float alpha, float& l_reg, bf16x8& pa0, bf16x8& pa1, bf16x8& pa2, bf16x8& pa3) {
#pragma unroll
  for (int r = 0; r < 16; ++r) p1[r] = __builtin_amdgcn_exp2f(p1[r]);
  float ps = 0;
#pragma unroll
  for (int r = 0; r < 16; ++r) ps += p0[r];
#pragma unroll
  for (int r = 0; r < 16; ++r) ps += p1[r];
  { auto rr = __builtin_amdgcn_permlane32_swap(__float_as_uint(ps), __float_as_uint(ps), false, false);
    ps = __uint_as_float(rr[0]) + __uint_as_float(rr[1]); }
  l_reg = l_reg * alpha + ps;
#define PK4(P, BASE, OUT) do { unsigned a0 = cvtpk(P[BASE + 0], P[BASE + 1]), a1 = cvtpk(P[BASE + 2], P[BASE + 3]);   \
    unsigned b0 = cvtpk(P[BASE + 4], P[BASE + 5]), b1 = cvtpk(P[BASE + 6], P[BASE + 7]);                              \
    auto r0 = __builtin_amdgcn_permlane32_swap(a0, b0, false, false); auto r1 = __builtin_amdgcn_permlane32_swap(a1, b1, false, false); \
    u32x4 w = {r0[0], r1[0], r0[1], r1[1]}; OUT = *reinterpret_cast<bf16x8*>(&w); } while (0)
  PK4(p0, 0, pa0); PK4(p0, 8, pa1); PK4(p1, 0, pa2); PK4(p1, 8, pa3);
#undef PK4
}
template <int DQK, int NQR> __device__ __forceinline__ void qkt(f32x16& p0, f32x16& p1, const char* Ks, const int (&kb)[4], const bf16x8* qr, const char* qs, int r32, int hi) {
  p0 = f32x16{}; p1 = f32x16{};
  constexpr int ROWB = DQK * 2;
#pragma unroll
  for (int d0 = 0; d0 < DQK / 16; ++d0) {
    bf16x8 b0 = *reinterpret_cast<const bf16x8*>(Ks + kb[d0 & 3] + (d0 >> 2) * 128);
    bf16x8 b1 = *reinterpret_cast<const bf16x8*>(Ks + kb[d0 & 3] + (d0 >> 2) * 128 + 32 * ROWB);
    bf16x8 qf; if (d0 < NQR) qf = qr[d0]; else qf = *reinterpret_cast<const bf16x8*>(qs + ((d0 - NQR) * 2 + hi) * 512 + r32 * 16);
    p0 = __builtin_amdgcn_mfma_f32_32x32x16_bf16(b0, qf, p0, 0, 0, 0);
    p1 = __builtin_amdgcn_mfma_f32_32x32x16_bf16(b1, qf, p1, 0, 0, 0); }
}
template <int DQK, int NQR> __device__ __forceinline__ void qkt_acc(f32x16& p0, f32x16& p1, const char* Ks, const int (&kb)[4], const bf16x8* qr, int r32, int hi) {
  constexpr int ROWB = DQK * 2; (void)r32; (void)hi;
#pragma unroll
  for (int d0 = 0; d0 < DQK / 16; ++d0) {
    bf16x8 b0 = *reinterpret_cast<const bf16x8*>(Ks + kb[d0 & 3] + (d0 >> 2) * 128);
    bf16x8 b1 = *reinterpret_cast<const bf16x8*>(Ks + kb[d0 & 3] + (d0 >> 2) * 128 + 32 * ROWB);
    p0 = __builtin_amdgcn_mfma_f32_32x32x16_bf16(b0, qr[d0], p0, 0, 0, 0);
    p1 = __builtin_amdgcn_mfma_f32_32x32x16_bf16(b1, qr[d0], p1, 0, 0, 0); }
}
__device__ __forceinline__ int v_st(int k, int c) { const int kk = (k & ~0xC) | ((k & 4) << 1) | ((k & 8) >> 1); return ((kk >> 3) * 4 + (c >> 5)) * 512 + ((kk & 7) * 32 + (c & 31)) * 2; }
__device__ __forceinline__ int v_rd_base(int lane) { return ((lane & 3) << 3) | (((lane >> 2) & 3) << 6) | (((lane >> 4) & 1) << 5) | (((lane >> 5) & 1) << 8); }
constexpr int v_rd_off(int d0, int ks, int half) { return d0 * 512 + ks * 4096 + half * 2048; }
template <int OFF> __device__ __forceinline__ s16x4 tr_read(int vb) {
  s16x4 r; asm volatile("ds_read_b64_tr_b16 %0, %1 offset:%2" : "=&v"(r) : "v"(vb), "i"(OFF) : "memory"); return r;
}
typedef short v4i16_t __attribute__((ext_vector_type(4)));
__device__ __forceinline__ s16x4 vtr(LAS const unsigned char* p) { return __builtin_bit_cast(s16x4, __builtin_amdgcn_ds_read_tr16_b64_v4i16((LAS v4i16_t*)p)); }
__device__ __forceinline__ void pv_d0v(f32x16* o, LAS const unsigned char* vp, bf16x8 pa0, bf16x8 pa1, bf16x8 pa2, bf16x8 pa3) {
#define PKV(L, H) (bf16x8){L[0], L[1], L[2], L[3], H[0], H[1], H[2], H[3]}
#pragma unroll
  for (int d0 = 0; d0 < 4; ++d0) {
    const s16x4 l0 = vtr(vp + v_rd_off(d0, 0, 0)), h0 = vtr(vp + v_rd_off(d0, 0, 1)), l1 = vtr(vp + v_rd_off(d0, 1, 0)), h1 = vtr(vp + v_rd_off(d0, 1, 1));
    const s16x4 l2 = vtr(vp + v_rd_off(d0, 2, 0)), h2 = vtr(vp + v_rd_off(d0, 2, 1)), l3 = vtr(vp + v_rd_off(d0, 3, 0)), h3 = vtr(vp + v_rd_off(d0, 3, 1));
    o[d0] = __builtin_amdgcn_mfma_f32_32x32x16_bf16(pa0, PKV(l0, h0), o[d0], 0, 0, 0);
    o[d0] = __builtin_amdgcn_mfma_f32_32x32x16_bf16(pa1, PKV(l1, h1), o[d0], 0, 0, 0);
    o[d0] = __builtin_amdgcn_mfma_f32_32x32x16_bf16(pa2, PKV(l2, h2), o[d0], 0, 0, 0);
    o[d0] = __builtin_amdgcn_mfma_f32_32x32x16_bf16(pa3, PKV(l3, h3), o[d0], 0, 0, 0); }
#undef PKV
}
template <int D0> __device__ __forceinline__ void pv_one(f32x16& od, int vb, bf16x8 pa0, bf16x8 pa1, bf16x8 pa2, bf16x8 pa3) {
  const s16x4 l0 = tr_read<v_rd_off(D0, 0, 0)>(vb), h0 = tr_read<v_rd_off(D0, 0, 1)>(vb), l1 = tr_read<v_rd_off(D0, 1, 0)>(vb), h1 = tr_read<v_rd_off(D0, 1, 1)>(vb);
  const s16x4 l2 = tr_read<v_rd_off(D0, 2, 0)>(vb), h2 = tr_read<v_rd_off(D0, 2, 1)>(vb), l3 = tr_read<v_rd_off(D0, 3, 0)>(vb), h3 = tr_read<v_rd_off(D0, 3, 1)>(vb);
  asm volatile("s_waitcnt lgkmcnt(0)" ::: "memory"); SBAR();
#define PK(L, H) (bf16x8){L[0], L[1], L[2], L[3], H[0], H[1], H[2], H[3]}
  od = __builtin_amdgcn_mfma_f32_32x32x16_bf16(pa0, PK(l0, h0), od, 0, 0, 0);
  od = __builtin_amdgcn_mfma_f32_32x32x16_bf16(pa1, PK(l1, h1), od, 0, 0, 0);
  od = __builtin_amdgcn_mfma_f32_32x32x16_bf16(pa2, PK(l2, h2), od, 0, 0, 0);
  od = __builtin_amdgcn_mfma_f32_32x32x16_bf16(pa3, PK(l3, h3), od, 0, 0, 0);
#undef PK
}
__device__ __forceinline__ void pv_d0(f32x16* o, int vb, bf16x8 pa0, bf16x8 pa1, bf16x8 pa2, bf16x8 pa3) {
  pv_one<0>(o[0], vb, pa0, pa1, pa2, pa3); pv_one<1>(o[1], vb, pa0, pa1, pa2, pa3); pv_one<2>(o[2], vb, pa0, pa1, pa2, pa3); pv_one<3>(o[3], vb, pa0, pa1, pa2, pa3);
}

struct MaskNone { __device__ __forceinline__ void apply(f32x16&, f32x16&, int, int) const {} __device__ __forceinline__ bool active(int, int) const { return true; } };
struct MaskA {
  int qoff, lo, hi_; float sl;
  __device__ __forceinline__ bool active(int t, int w) const { return 64 * t + 63 >= 32 * w && 64 * t <= 32 * w + 287; }
  __device__ __forceinline__ void apply(f32x16& p0, f32x16& p1, int kt, int hi) const {
    int base = qoff + 64 * kt + 4 * hi; asm volatile("" : "+v"(base));
    const float bf = (float)base, bm = bf - 0.5f * (float)(lo + hi_), hw = 0.5f * (float)(hi_ - lo);
#pragma unroll
    for (int r = 0; r < 16; ++r) { const float c0 = (float)((r & 3) + 8 * (r >> 2)), c1 = c0 + 32.f;
      const float v0 = __builtin_fmaf(-sl, __builtin_fabsf(bf + c0), p0[r]), v1 = __builtin_fmaf(-sl, __builtin_fabsf(bf + c1), p1[r]);
      p0[r] = __builtin_fabsf(bm + c0) <= hw ? v0 : -1e30f; p1[r] = __builtin_fabsf(bm + c1) <= hw ? v1 : -1e30f; }
  }
};
struct MaskB {
  int qr, qc, kr0, rs, cs; const float* tab;
  __device__ __forceinline__ bool active(int t, int) const { const int kr = kr0 + t; return __builtin_amdgcn_readfirstlane((int)(kr >= rs && kr <= rs + 7)) != 0; }
  __device__ __forceinline__ void apply(f32x16& p0, f32x16& p1, int kt, int hi) const {
    const int dr = kr0 + kt - qr + 7;
    int dbase = 4 * hi - qc + 15; asm volatile("" : "+v"(dbase));
    int cb = 4 * hi - cs; asm volatile("" : "+v"(cb));
    const float* tp = tab + dr * 31 + dbase;
    float t0[16], t1[16];
#pragma unroll
    for (int r = 0; r < 16; ++r) { const int c = (r & 3) + 8 * (r >> 2); t0[r] = tp[c]; t1[r] = tp[c + 32]; }
#pragma unroll
    for (int r = 0; r < 16; ++r) asm volatile("" : "+v"(t0[r]), "+v"(t1[r]));
#pragma unroll
    for (int r = 0; r < 16; ++r) { const int c = (r & 3) + 8 * (r >> 2);
      p0[r] = (unsigned)(cb + c) < 16u ? p0[r] + t0[r] : -1e30f; p1[r] = (unsigned)(cb + c + 32) < 16u ? p1[r] + t1[r] : -1e30f; }
  }
};

template <int DQK, class MK>
__device__ __forceinline__ void attn_unit(const bf16_t* __restrict__ Q, long q_row0, int ldq, const bf16_t* __restrict__ K, int ldk, const bf16_t* __restrict__ V, int ldv,
                                          long k_row0, long kmin, long kmax, int NT, bf16_t* __restrict__ O, int ldo, const float Cs, const float m0, const float l0, const MK& mk, char* lds) {
  int tid_o = threadIdx.x; asm volatile("" : "+v"(tid_o));
  const int tid = tid_o, wid = tid >> 6, lane = tid & 63, r32 = lane & 31, hi = lane >> 5;
  constexpr int ROWB = DQK * 2, SHM_K = 64 * ROWB, KN = DQK / 64, CPR = DQK / 8;
  char* V_lds = lds + L_V; char* K_lds = lds + L_K;
  float* ws = (float*)(lds + L_WS) + wid * 64; float* li_l = ws; float* al_l = ws + 32;
  const float thr_raw = THR / (Cs * 0.6931471805599453f);
  constexpr int NQR = DQK / 16;
  float m_reg = m0, l_reg = l0; f32x16 o[4] = {}; bf16x8 qr[NQR];
  char* qs = lds + L_QS + wid * 4096;
  const bf16_t* Qw = Q + (q_row0 + wid * QBLK + r32) * ldq + hi * 8;
#pragma unroll
  for (int d0 = 0; d0 < NQR; ++d0) qr[d0] = *reinterpret_cast<const bf16x8*>(Qw + d0 * 16);
  if constexpr (NQR < DQK / 16) {
#pragma unroll
    for (int d0 = NQR; d0 < DQK / 16; ++d0) *reinterpret_cast<bf16x8*>(qs + ((d0 - NQR) * 2 + hi) * 512 + r32 * 16) = *reinterpret_cast<const bf16x8*>(Qw + d0 * 16);
  }
  const int sr = tid >> 4, sc = (tid & 15) * 8, vst0 = v_st(sr, sc), vst1 = v_st(32 + sr, sc);
  const int voff0 = sr * ldv + sc, voff1 = (32 + sr) * ldv + sc;
  int koff[KN], kst[KN];
#pragma unroll
  for (int i = 0; i < KN; ++i) { const int id = tid + 512 * i, kr = id / CPR, kc = (id % CPR) * 8; koff[i] = kr * ldk + kc; kst[i] = kr * ROWB + ((kc * 2) ^ ((kr & 7) << 4)); }
  const int vb0 = (int)(uintptr_t)V_lds + v_rd_base(lane);
  int kb[4];
#pragma unroll
  for (int e = 0; e < 4; ++e) { kb[e] = r32 * ROWB + ((e * 32 + hi * 16) ^ ((r32 & 7) << 4)); asm volatile("" : "+v"(kb[e])); }
  bf16x8 vs0, vs1, ks[KN];
#define SLOAD(t) do { long _r0 = k_row0 + (long)(t) * KVBLK; _r0 = _r0 < kmin ? kmin : (_r0 > kmax - 63 ? kmax - 63 : _r0); \
    const bf16_t* _Vt = V + _r0 * ldv; const bf16_t* _Kt = K + _r0 * ldk; \
    vs0 = *reinterpret_cast<const bf16x8*>(_Vt + voff0); vs1 = *reinterpret_cast<const bf16x8*>(_Vt + voff1); \
    _Pragma("unroll") for (int _k = 0; _k < KN; ++_k) ks[_k] = *reinterpret_cast<const bf16x8*>(_Kt + koff[_k]); } while (0)
#define SWRITE(b) do { *(bf16x8*)(V_lds + (b) * SHM_V + vst0) = vs0; *(bf16x8*)(V_lds + (b) * SHM_V + vst1) = vs1; \
    _Pragma("unroll") for (int _k = 0; _k < KN; ++_k) *(bf16x8*)(K_lds + (b) * SHM_K + kst[_k]) = ks[_k]; } while (0)
  SLOAD(0); SWRITE(0); __syncthreads();
  for (int t = 0; t < NT; ++t) {
    const int cb = t & 1;
    if (t + 1 < NT) SLOAD(t + 1);
    if (mk.active(t, __builtin_amdgcn_readfirstlane(wid))) {
    f32x16 p0, p1;
    qkt<DQK, NQR>(p0, p1, K_lds + cb * SHM_K, kb, qr, qs, r32, hi);
    mk.apply(p0, p1, t, hi);
    float pmax = p0[0];
#pragma unroll
    for (int r = 1; r < 16; ++r) pmax = fmaxf(pmax, p0[r]);
#pragma unroll
    for (int r = 0; r < 16; ++r) pmax = fmaxf(pmax, p1[r]);
    { auto rr = __builtin_amdgcn_permlane32_swap(__float_as_uint(pmax), __float_as_uint(pmax), false, false);
      pmax = fmaxf(__uint_as_float(rr[0]), __uint_as_float(rr[1])); }
    if (!__all(pmax - m_reg <= thr_raw)) {
      const float mn = fmaxf(m_reg, pmax); const float alpha = __builtin_amdgcn_exp2f((m_reg - mn) * Cs); m_reg = mn; l_reg *= alpha;
      if (hi == 0) al_l[r32] = alpha; asm volatile("s_waitcnt lgkmcnt(0)" ::: "memory");
#pragma unroll
      for (int d = 0; d < 4; ++d)
#pragma unroll
        for (int r = 0; r < 16; ++r) o[d][r] *= al_l[crow(r, hi)];
    }
    const float mnC = -m_reg * Cs;
#pragma unroll
    for (int r = 0; r < 16; ++r) { p0[r] = __builtin_amdgcn_exp2f(fmaf(p0[r], Cs, mnC)); p1[r] = __builtin_amdgcn_exp2f(fmaf(p1[r], Cs, mnC)); }
    float ps = 0;
#pragma unroll
    for (int r = 0; r < 16; ++r) ps += p0[r] + p1[r];
    { auto rr = __builtin_amdgcn_permlane32_swap(__float_as_uint(ps), __float_as_uint(ps), false, false);
      ps = __uint_as_float(rr[0]) + __uint_as_float(rr[1]); }
    l_reg += ps;
    bf16x8 pa0, pa1, pa2, pa3;
#define PK4(P, BASE, OUT) do { unsigned a0 = cvtpk(P[BASE + 0], P[BASE + 1]), a1 = cvtpk(P[BASE + 2], P[BASE + 3]);   \
    unsigned b0 = cvtpk(P[BASE + 4], P[BASE + 5]), b1 = cvtpk(P[BASE + 6], P[BASE + 7]);                              \
    auto r0 = __builtin_amdgcn_permlane32_swap(a0, b0, false, false); auto r1 = __builtin_amdgcn_permlane32_swap(a1, b1, false, false); \
    u32x4 w = {r0[0], r1[0], r0[1], r1[1]}; OUT = *reinterpret_cast<bf16x8*>(&w); } while (0)
    PK4(p0, 0, pa0); PK4(p0, 8, pa1); PK4(p1, 0, pa2); PK4(p1, 8, pa3);
#undef PK4
    pv_d0(o, vb0 + cb * SHM_V, pa0, pa1, pa2, pa3);
    }
    if (t + 1 < NT) SWRITE(cb ^ 1);
    __syncthreads();
  }
  if (hi == 0) li_l[r32] = l_reg; asm volatile("s_waitcnt lgkmcnt(0)" ::: "memory");
  float rli[16];
#pragma unroll
  for (int r = 0; r < 16; ++r) rli[r] = __builtin_amdgcn_rcpf(li_l[crow(r, hi)]);
  char* ost = lds + wid * OST_WAVE;
  const bool odd = lane & 1;
#pragma unroll
  for (int d0 = 0; d0 < 4; ++d0)
#pragma unroll
    for (int r = 0; r < 16; r += 2) {
      const float a = o[d0][r] * rli[r], b = o[d0][r + 1] * rli[r + 1];
      const float snd = odd ? a : b; const float rcv = __builtin_bit_cast(float, __builtin_amdgcn_mov_dpp(__builtin_bit_cast(int, snd), 0xB1, 0xF, 0xF, true));
      const float wlo = odd ? rcv : a, whi = odd ? b : rcv;
      const unsigned w = cvtpk(wlo, whi);
      const int row = crow(r, hi) + (odd ? 1 : 0), col = d0 * 32 + (r32 & ~1);
      *(unsigned*)(ost + row * OST_PITCH + col * 2) = w; }
  asm volatile("s_waitcnt lgkmcnt(0)" ::: "memory");
  bf16_t* Ow = O + (q_row0 + wid * QBLK) * ldo;
#pragma unroll
  for (int it = 0; it < 8; ++it) { const int id = it * 64 + lane, row = id >> 4, c16 = id & 15;
    const u32x4 v = *(const u32x4*)(ost + row * OST_PITCH + c16 * 16);
    *(u32x4*)(Ow + (long)row * ldo + c16 * 8) = v; }
  __syncthreads();
#undef SLOAD
#undef SWRITE
}

__device__ __forceinline__ void glds16_asm(const void* gsrc, unsigned lds_dst) { unsigned keep;
  asm volatile("s_mov_b32 %0, m0\n\ts_mov_b32 m0, %2\n\ts_nop 0\n\tglobal_load_lds_dwordx4 %1, off\n\ts_mov_b32 m0, %0" : "=&s"(keep) : "v"(gsrc), "s"(lds_dst) : "memory"); }
template <int DQK, class MK>
__device__ __forceinline__ void attn_unit_dma(const bf16_t* __restrict__ Q, long q_row0, int ldq, const bf16_t* __restrict__ K, int ldk, const bf16_t* __restrict__ V, int ldv,
                                              long k_row0, long kmin, long kmax, int NT, bf16_t* __restrict__ O, int ldo, const float Cs, const float m0, const float l0, const MK& mk, char* lds, LAS unsigned char* ldsl) {
  int tid_o = threadIdx.x; asm volatile("" : "+v"(tid_o));
  const int tid = tid_o, wid = tid >> 6, lane = tid & 63, r32 = lane & 31, hi = lane >> 5;
  const int widu = __builtin_amdgcn_readfirstlane(wid);
  constexpr int ROWB = DQK * 2, SHM_K = 64 * ROWB, KN = SHM_K / 8192, CPR = DQK / 8;
  constexpr int D_V = 0, D_K = 3 * SHM_V, D_WS = 122880;
  static_assert(D_K + 3 * SHM_K <= D_WS, "rings fit");
  char* V_lds = lds + D_V; char* K_lds = lds + D_K; const unsigned lds0 = (unsigned)(uintptr_t)ldsl;
  float* ws = (float*)(lds + D_WS) + wid * 64; float* li_l = ws; float* al_l = ws + 32;
  const float thr_raw = THR / (Cs * 0.6931471805599453f);
  constexpr int NQR = DQK / 16;
  float m_reg = m0, l_reg = l0; f32x16 o[4] = {}; bf16x8 qr[NQR];
  int ksrc[KN], vsrc[2];
#pragma unroll
  for (int i = 0; i < KN; ++i) { const int c = (wid * KN + i) * 64 + lane, row = c / CPR, ccd = c % CPR, cc = (ccd & ~7) | ((ccd & 7) ^ (row & 7)); ksrc[i] = row * ldk + cc * 8; }
#pragma unroll
  for (int i = 0; i < 2; ++i) { const int ci = (wid * 2 + i) * 64 + lane, sub = ci >> 5, within = ci & 31, kk = (sub >> 2) * 8 + (within >> 2), k = (kk & ~0xC) | ((kk & 4) << 1) | ((kk & 8) >> 1), c = (sub & 3) * 32 + (within & 3) * 8;
    vsrc[i] = k * ldv + c; }
#define DMA(t, b) do { long _r0 = k_row0 + (long)(t) * KVBLK; _r0 = _r0 < kmin ? kmin : (_r0 > kmax - 63 ? kmax - 63 : _r0); \
    const bf16_t* _Vt = V + _r0 * ldv; const bf16_t* _Kt = K + _r0 * ldk; \
    _Pragma("unroll") for (int _k = 0; _k < KN; ++_k) glds16_asm(_Kt + ksrc[_k], (unsigned)__builtin_amdgcn_readfirstlane((int)(lds0 + D_K + (b) * SHM_K + (widu * KN + _k) * 1024))); \
    _Pragma("unroll") for (int _k = 0; _k < 2; ++_k) glds16_asm(_Vt + vsrc[_k], (unsigned)__builtin_amdgcn_readfirstlane((int)(lds0 + D_V + (b) * SHM_V + (widu * 2 + _k) * 1024))); } while (0)
  DMA(0, 0); DMA(1, 1);
  const bf16_t* Qw = Q + (q_row0 + wid * QBLK + r32) * ldq + hi * 8;
#pragma unroll
  for (int d0 = 0; d0 < NQR; ++d0) qr[d0] = *reinterpret_cast<const bf16x8*>(Qw + d0 * 16);
  LAS const unsigned char* vpl = ldsl + D_V + v_rd_base(lane);
  int kb[4];
#pragma unroll
  for (int e = 0; e < 4; ++e) { kb[e] = r32 * ROWB + ((e * 32 + hi * 16) ^ ((r32 & 7) << 4)); asm volatile("" : "+v"(kb[e])); }
#pragma unroll
  for (int d0 = 0; d0 < NQR; ++d0) asm volatile("" : "+v"(qr[d0]));
  asm volatile("s_waitcnt vmcnt(0) lgkmcnt(0)" ::: "memory"); __builtin_amdgcn_s_barrier(); asm volatile("" ::: "memory");
  if (widu >= 4) __builtin_amdgcn_s_setprio(1);
  int cb = 0;
  for (int t = 0; t < NT; ++t) {
    const bool more = t + 2 < NT; int nb = cb + 2; nb = nb >= 3 ? nb - 3 : nb;
    if (more) DMA(t + 2, nb);
    if (mk.active(t, widu)) {
    f32x16 p0, p1;
    qkt<DQK, NQR>(p0, p1, K_lds + cb * SHM_K, kb, qr, nullptr, r32, hi);
    mk.apply(p0, p1, t, hi);
    float pmax = p0[0];
#pragma unroll
    for (int r = 1; r < 16; ++r) pmax = fmaxf(pmax, p0[r]);
#pragma unroll
    for (int r = 0; r < 16; ++r) pmax = fmaxf(pmax, p1[r]);
    { auto rr = __builtin_amdgcn_permlane32_swap(__float_as_uint(pmax), __float_as_uint(pmax), false, false);
      pmax = fmaxf(__uint_as_float(rr[0]), __uint_as_float(rr[1])); }
    if (!__all(pmax - m_reg <= thr_raw)) {
      const float mn = fmaxf(m_reg, pmax); const float alpha = __builtin_amdgcn_exp2f((m_reg - mn) * Cs); m_reg = mn; l_reg *= alpha;
      if (hi == 0) al_l[r32] = alpha; asm volatile("s_waitcnt lgkmcnt(0)" ::: "memory");
#pragma unroll
      for (int d = 0; d < 4; ++d)
#pragma unroll
        for (int r = 0; r < 16; ++r) o[d][r] *= al_l[crow(r, hi)];
    }
    const float mnC = -m_reg * Cs;
#pragma unroll
    for (int r = 0; r < 16; ++r) { p0[r] = __builtin_amdgcn_exp2f(fmaf(p0[r], Cs, mnC)); p1[r] = __builtin_amdgcn_exp2f(fmaf(p1[r], Cs, mnC)); }
    float ps = 0;
#pragma unroll
    for (int r = 0; r < 16; ++r) ps += p0[r] + p1[r];
    { auto rr = __builtin_amdgcn_permlane32_swap(__float_as_uint(ps), __float_as_uint(ps), false, false);
      ps = __uint_as_float(rr[0]) + __uint_as_float(rr[1]); }
    l_reg += ps;
    bf16x8 pa0, pa1, pa2, pa3;
#define PK4(P, BASE, OUT) do { unsigned a0 = cvtpk(P[BASE + 0], P[BASE + 1]), a1 = cvtpk(P[BASE + 2], P[BASE + 3]);   \
    unsigned b0 = cvtpk(P[BASE + 4], P[BASE + 5]), b1 = cvtpk(P[BASE + 6], P[BASE + 7]);                              \
    auto r0 = __builtin_amdgcn_permlane32_swap(a0, b0, false, false); auto r1 = __builtin_amdgcn_permlane32_swap(a1, b1, false, false); \
    u32x4 w = {r0[0], r1[0], r0[1], r1[1]}; OUT = *reinterpret_cast<bf16x8*>(&w); } while (0)
    PK4(p0, 0, pa0); PK4(p0, 8, pa1); PK4(p1, 0, pa2); PK4(p1, 8, pa3);
#undef PK4
    pv_d0v(o, vpl + cb * SHM_V, pa0, pa1, pa2, pa3);
    }
    if (more) { if constexpr (KN == 3) asm volatile("s_waitcnt vmcnt(5)" ::: "memory"); else asm volatile("s_waitcnt vmcnt(4)" ::: "memory"); }
    else asm volatile("s_waitcnt vmcnt(0)" ::: "memory");
    asm volatile("s_waitcnt lgkmcnt(0)" ::: "memory"); __builtin_amdgcn_s_barrier(); asm volatile("" ::: "memory");
    cb = cb == 2 ? 0 : cb + 1;
  }
  __builtin_amdgcn_s_setprio(0);
  if (hi == 0) li_l[r32] = l_reg; asm volatile("s_waitcnt lgkmcnt(0)" ::: "memory");
  float rli[16];
#pragma unroll
  for (int r = 0; r < 16; ++r) rli[r] = __builtin_amdgcn_rcpf(li_l[crow(r, hi)]);
  char* ost = lds + wid * OST_WAVE;
  const bool odd = lane & 1;
#pragma unroll
  for (int d0 = 0; d0 < 4; ++d0)
#pragma unroll
    for (int r = 0; r < 16; r += 2) {
      const float a = o[d0][r] * rli[r], b = o[d0][r + 1] * rli[r + 1];
      const float snd = odd ? a : b; const float rcv = __builtin_bit_cast(float, __builtin_amdgcn_mov_dpp(__builtin_bit_cast(int, snd), 0xB1, 0xF, 0xF, true));
      const float wlo = odd ? rcv : a, whi = odd ? b : rcv;
      const unsigned w = cvtpk(wlo, whi);
      const int row = crow(r, hi) + (odd ? 1 : 0), col = d0 * 32 + (r32 & ~1);
      *(unsigned*)(ost + row * OST_PITCH + col * 2) = w; }
  asm volatile("s_waitcnt lgkmcnt(0)" ::: "memory");
  bf16_t* Ow = O + (q_row0 + wid * QBLK) * ldo;
#pragma unroll
  for (int it = 0; it < 8; ++it) { const int id = it * 64 + lane, row = id >> 4, c16 = id & 15;
    const u32x4 v = *(const u32x4*)(ost + row * OST_PITCH + c16 * 16);
    *(u32x4*)(Ow + (long)row * ldo + c16 * 8) = v; }
  asm volatile("s_waitcnt lgkmcnt(0)" ::: "memory"); __builtin_amdgcn_s_barrier(); asm volatile("" ::: "memory");
#undef DMA
}

typedef __bf16 bf16x2_t __attribute__((ext_vector_type(2)));
typedef float f32x2_t __attribute__((ext_vector_type(2)));
__device__ __forceinline__ unsigned cvtpk_v(float lo, float hi) { f32x2_t v = {lo, hi}; bf16x2_t b = __builtin_convertvector(v, bf16x2_t); return __builtin_bit_cast(unsigned, b); }
#define PINV(x) asm volatile("" : "+v"(x))
#define MX3(a, b, c) __builtin_fmaxf(__builtin_fmaxf((a), (b)), (c))
template <int DQK, class MK>
__device__ __forceinline__ void attn_unit_c(const bf16_t* __restrict__ Q, long q_row0, int ldq, const bf16_t* __restrict__ K, int ldk, const bf16_t* __restrict__ V, int ldv,
                                              long k_row0, long kmin, long kmax, int NT, bf16_t* __restrict__ O, int ldo, const float Cs, const float m0, const float l0, const MK& mk, char* lds, LAS unsigned char* ldsl) {
  int tid_o = threadIdx.x; asm volatile("" : "+v"(tid_o));
  const int tid = tid_o, wid = tid >> 6, lane = tid & 63, r32 = lane & 31, hi = lane >> 5;
  const int widu = __builtin_amdgcn_readfirstlane(wid);
  constexpr int ROWB = DQK * 2, SHM_K = 64 * ROWB, KN = SHM_K / 8192, CPR = DQK / 8;
  constexpr int D_V = 0, D_K = 3 * SHM_V, D_WS = 122880;
  static_assert(D_K + 3 * SHM_K <= D_WS, "rings fit"); static_assert(DQK == 192, "the gap schedule below is written for 12 Q fragments");
  char* K_lds = lds + D_K; const unsigned lds0 = (unsigned)(uintptr_t)ldsl;
  float* ws = (float*)(lds + D_WS) + wid * 64; float* li_l = ws; float* al_l = ws + 32;
  constexpr int NQR = DQK / 16;
  (void)m0; (void)l0; (void)Cs; (void)mk; float m_reg = 0.f, l_reg = 0.f; f32x16 o[4] = {}; f32x16 negm = {}; bf16x8 qr[NQR];
  const float thr2 = THR * 1.4426950408889634f;
  int ksrc[KN], vsrc[2];
#pragma unroll
  for (int i = 0; i < KN; ++i) { const int c = (wid * KN + i) * 64 + lane, row = c / CPR, ccd = c % CPR, cc = (ccd & ~7) | ((ccd & 7) ^ (row & 7)); ksrc[i] = row * ldk + cc * 8; }
#pragma unroll
  for (int i = 0; i < 2; ++i) { const int ci = (wid * 2 + i) * 64 + lane, sub = ci >> 5, within = ci & 31, kk = (sub >> 2) * 8 + (within >> 2), k = (kk & ~0xC) | ((kk & 4) << 1) | ((kk & 8) >> 1), c = (sub & 3) * 32 + (within & 3) * 8;
    vsrc[i] = k * ldv + c; }
#define DMA(t, b) do { long _r0 = k_row0 + (long)(t) * KVBLK; _r0 = _r0 < kmin ? kmin : (_r0 > kmax - 63 ? kmax - 63 : _r0); \
    const bf16_t* _Vt = V + _r0 * ldv; const bf16_t* _Kt = K + _r0 * ldk; \
    _Pragma("unroll") for (int _k = 0; _k < KN; ++_k) glds16_asm(_Kt + ksrc[_k], (unsigned)__builtin_amdgcn_readfirstlane((int)(lds0 + D_K + (b) * SHM_K + (widu * KN + _k) * 1024))); \
    _Pragma("unroll") for (int _k = 0; _k < 2; ++_k) glds16_asm(_Vt + vsrc[_k], (unsigned)__builtin_amdgcn_readfirstlane((int)(lds0 + D_V + (b) * SHM_V + (widu * 2 + _k) * 1024))); } while (0)
  DMA(0, 0); DMA(1, 1);
  const bf16_t* Qw = Q + (q_row0 + wid * QBLK + r32) * ldq + hi * 8;
#pragma unroll
  for (int d0 = 0; d0 < NQR; ++d0) qr[d0] = *reinterpret_cast<const bf16x8*>(Qw + d0 * 16);
  LAS const unsigned char* vp0 = ldsl + D_V + v_rd_base(lane);
  int kb[4];
#pragma unroll
  for (int e = 0; e < 4; ++e) { kb[e] = r32 * ROWB + ((e * 32 + hi * 16) ^ ((r32 & 7) << 4)); asm volatile("" : "+v"(kb[e])); }
#pragma unroll
  for (int d0 = 0; d0 < NQR; ++d0) asm volatile("" : "+v"(qr[d0]));
  asm volatile("s_waitcnt vmcnt(0) lgkmcnt(0)" ::: "memory"); __builtin_amdgcn_s_barrier(); asm volatile("" ::: "memory");
#define MF(a, b, c) __builtin_amdgcn_mfma_f32_32x32x16_bf16(a, b, c, 0, 0, 0)
#define KFR(i) (*reinterpret_cast<const bf16x8*>(Kc + kb[((i) % 12) & 3] + (((i) % 12) >> 2) * 128 + ((i) >= 12 ? 32 * ROWB : 0)))
#define KFRN(i) (*reinterpret_cast<const bf16x8*>(Kn + kb[(i) & 3]))
#define GQ(i, CH, CIN, FILL) do { if ((i) + 3 < 24) kf[((i) + 3) & 3] = KFR((i) + 3); CH = MF(kf[(i) & 3], qr[(i) % 12], CIN); FILL; SBAR(); } while (0)
#define VFR(s) (bf16x8){vl[s][0], vl[s][1], vl[s][2], vl[s][3], vh[s][0], vh[s][1], vh[s][2], vh[s][3]}
#define VRD(j) do { vl[(j) % 3] = vtr(vpc + v_rd_off((j) & 3, (j) >> 2, 0)); vh[(j) % 3] = vtr(vpc + v_rd_off((j) & 3, (j) >> 2, 1)); } while (0)
#define GP(j, PA, FILL) do { if ((j) + 2 < 16) VRD((j) + 2); o[(j) & 3] = MF(PA, VFR((j) % 3), o[(j) & 3]); FILL; SBAR(); } while (0)
#define EX2(x) __builtin_amdgcn_exp2f(x)
#define PREP(P, B, W) do { P[B] = EX2(P[B]); P[(B) + 1] = EX2(P[(B) + 1]); rs += P[B]; rs += P[(B) + 1]; W = cvtpk_v(P[B], P[(B) + 1]); PINV(rs); PINV(W); } while (0)
#define PKSW(OUT) do { auto r0_ = __builtin_amdgcn_permlane32_swap(wa0, wb0, false, false); auto r1_ = __builtin_amdgcn_permlane32_swap(wa1, wb1, false, false); \
    u32x4 w_ = {r0_[0], r1_[0], r0_[1], r1_[1]}; OUT = *reinterpret_cast<bf16x8*>(&w_); PINV(OUT); } while (0)
  if (widu >= 4) __builtin_amdgcn_s_setprio(1);
  int cb = 0;
  bf16x8 kf[4];
  { const char* Kc = K_lds; kf[0] = KFR(0); kf[1] = KFR(1); kf[2] = KFR(2); }
  for (int t = 0; t < NT; ++t) {
    const bool more = t + 2 < NT; int nb = cb + 2; nb = nb >= 3 ? nb - 3 : nb; int n1 = cb + 1; n1 = n1 >= 3 ? n1 - 3 : n1;
    if (more) DMA(t + 2, nb);
    const char* Kc = K_lds + cb * SHM_K; const char* Kn = K_lds + n1 * SHM_K; LAS const unsigned char* vpc = vp0 + cb * SHM_V;
    f32x16 p0, p1; s16x4 vl[3], vh[3]; float mx;
    SBAR();
    GQ(0, p0, negm, ); GQ(1, p0, p0, ); GQ(2, p0, p0, ); GQ(3, p0, p0, ); GQ(4, p0, p0, ); GQ(5, p0, p0, );
    GQ(6, p0, p0, ); GQ(7, p0, p0, ); GQ(8, p0, p0, ); GQ(9, p0, p0, ); GQ(10, p0, p0, ); GQ(11, p0, p0, );
    GQ(12, p1, negm, );
    GQ(13, p1, p1, mx = MX3(p0[0], p0[1], p0[2]); PINV(mx));
    GQ(14, p1, p1, mx = MX3(mx, p0[3], p0[4]); PINV(mx));   GQ(15, p1, p1, mx = MX3(mx, p0[5], p0[6]); PINV(mx));
    GQ(16, p1, p1, mx = MX3(mx, p0[7], p0[8]); PINV(mx));   GQ(17, p1, p1, mx = MX3(mx, p0[9], p0[10]); PINV(mx));
    GQ(18, p1, p1, mx = MX3(mx, p0[11], p0[12]); PINV(mx)); GQ(19, p1, p1, mx = MX3(mx, p0[13], p0[14]); PINV(mx));
    GQ(20, p1, p1, mx = __builtin_fmaxf(mx, p0[15]); PINV(mx));
    GQ(21, p1, p1, ); GQ(22, p1, p1, );
    GQ(23, p1, p1, VRD(0); VRD(1));
    float pmax = MX3(mx, p1[0], p1[1]);
#pragma unroll
    for (int r = 2; r < 16; r += 2) pmax = MX3(pmax, p1[r], p1[r + 1]);
    { auto rr = __builtin_amdgcn_permlane32_swap(__float_as_uint(pmax), __float_as_uint(pmax), false, false);
      pmax = fmaxf(__uint_as_float(rr[0]), __uint_as_float(rr[1])); }
    const bool first = (t == 0);
    if (first || !__all(pmax <= thr2)) {
      const float d = first ? pmax : fmaxf(pmax, 0.f); const float alpha = first ? 1.f : __builtin_amdgcn_exp2f(-d); m_reg += d; l_reg *= alpha;
      if (hi == 0) al_l[r32] = alpha; asm volatile("s_waitcnt lgkmcnt(0)" ::: "memory");
#pragma unroll
      for (int r = 0; r < 16; ++r) { const float a = al_l[crow(r, hi)]; o[0][r] *= a; o[1][r] *= a; o[2][r] *= a; o[3][r] *= a; p0[r] -= d; p1[r] -= d; }
#pragma unroll
      for (int r = 0; r < 16; ++r) negm[r] = -m_reg;
    }
    SBAR();
    float rs = 0.f; unsigned wa0, wa1, wb0, wb1; bf16x8 pa0, pa1, pa2, pa3;
    PREP(p0, 0, wa0); PREP(p0, 2, wa1); PREP(p0, 4, wb0); PREP(p0, 6, wb1); PKSW(pa0); SBAR();
    GP(0, pa0, PREP(p0, 8, wa0));   GP(1, pa0, PREP(p0, 10, wa1)); GP(2, pa0, PREP(p0, 12, wb0));  GP(3, pa0, PREP(p0, 14, wb1); PKSW(pa1));
    GP(4, pa1, PREP(p1, 0, wa0));   GP(5, pa1, PREP(p1, 2, wa1));  GP(6, pa1, PREP(p1, 4, wb0));   GP(7, pa1, PREP(p1, 6, wb1); PKSW(pa2));
    GP(8, pa2, PREP(p1, 8, wa0));   GP(9, pa2, PREP(p1, 10, wa1)); GP(10, pa2, PREP(p1, 12, wb0)); GP(11, pa2, PREP(p1, 14, wb1); PKSW(pa3));
    GP(12, pa3, kf[0] = KFRN(0)); GP(13, pa3, kf[1] = KFRN(1)); GP(14, pa3, kf[2] = KFRN(2)); GP(15, pa3, );
    l_reg += rs;
    if (more) asm volatile("s_waitcnt vmcnt(2)" ::: "memory"); else asm volatile("s_waitcnt vmcnt(0)" ::: "memory");
    asm volatile("s_waitcnt lgkmcnt(0)" ::: "memory"); __builtin_amdgcn_s_barrier(); asm volatile("" ::: "memory");
    cb = cb == 2 ? 0 : cb + 1;
  }
  __builtin_amdgcn_s_setprio(0);
#undef MF
#undef KFR
#undef KFRN
#undef GQ
#undef VFR
#undef VRD
#undef GP
#undef EX2
#undef PREP
#undef PKSW
#undef DMA
  { auto rr = __builtin_amdgcn_permlane32_swap(__float_as_uint(l_reg), __float_as_uint(l_reg), false, false); l_reg = __uint_as_float(rr[0]) + __uint_as_float(rr[1]); }
  if (hi == 0) li_l[r32] = l_reg; asm volatile("s_waitcnt lgkmcnt(0)" ::: "memory");
  float rli[16];
#pragma unroll
  for (int r = 0; r < 16; ++r) rli[r] = __builtin_amdgcn_rcpf(li_l[crow(r, hi)]);
  char* ost = lds + wid * OST_WAVE;
  const bool odd = lane & 1;
#pragma unroll
  for (int d0 = 0; d0 < 4; ++d0)
#pragma unroll
    for (int r = 0; r < 16; r += 2) {
      const float a = o[d0][r] * rli[r], b = o[d0][r + 1] * rli[r + 1];
      const float snd = odd ? a : b; const float rcv = __builtin_bit_cast(float, __builtin_amdgcn_mov_dpp(__builtin_bit_cast(int, snd), 0xB1, 0xF, 0xF, true));
      const float wlo = odd ? rcv : a, whi = odd ? b : rcv;
      const unsigned w = cvtpk(wlo, whi);
      const int row = crow(r, hi) + (odd ? 1 : 0), col = d0 * 32 + (r32 & ~1);
      *(unsigned*)(ost + row * OST_PITCH + col * 2) = w; }
  asm volatile("s_waitcnt lgkmcnt(0)" ::: "memory");
  bf16_t* Ow = O + (q_row0 + wid * QBLK) * ldo;
#pragma unroll
  for (int it = 0; it < 8; ++it) { const int id = it * 64 + lane, row = id >> 4, c16 = id & 15;
    const u32x4 v = *(const u32x4*)(ost + row * OST_PITCH + c16 * 16);
    *(u32x4*)(Ow + (long)row * ldo + c16 * 8) = v; }
  asm volatile("s_waitcnt lgkmcnt(0)" ::: "memory"); __builtin_amdgcn_s_barrier(); asm volatile("" ::: "memory");
}
}

#define XB_TMO      128
#define XB_XCNT(j)  (256  + 64 * (j))
#define XB_XSUB(j)  (1280 + 64 * (j))
#define XB_XGEN(j)  (2304 + 64 * (j))
#define XB_TOP      3328
#define XB_TOPGEN   3392
#define XCD_BAR_WORDS 3456
#define XB_SPIN_CAP (1u << 18)

__device__ __forceinline__ unsigned xb_ld(unsigned* p)              { return __hip_atomic_load(p, __ATOMIC_RELAXED, __HIP_MEMORY_SCOPE_AGENT); }
__device__ __forceinline__ unsigned xb_add(unsigned* p, unsigned v) { return __hip_atomic_fetch_add(p, v, __ATOMIC_RELAXED, __HIP_MEMORY_SCOPE_AGENT); }
__device__ __forceinline__ unsigned xb_xcc_id() { return (unsigned)__builtin_amdgcn_s_getreg((3 << 11) | 20) & 0xFu; }
#define XB_SPIN(cond, bar) do { unsigned _sp = 0; while (cond) { __builtin_amdgcn_s_sleep(1); \
    if ((++_sp & 255u) == 0u) { if (xb_ld(&(bar)[XB_TMO])) break; if (_sp > XB_SPIN_CAP) { atomicAdd(&(bar)[XB_TMO], 1u); break; } } } } while (0)

struct XcdBarrier {
    unsigned* bar; unsigned x;
    volatile LAS unsigned* st;
};
__device__ __forceinline__ XcdBarrier xcd_barrier_post(unsigned* bar, volatile LAS unsigned* st) {
    XcdBarrier b; b.bar = bar; b.x = xb_xcc_id(); b.st = st;
    if (threadIdx.x == 0) (void)xb_add(&bar[XB_XCNT(b.x)], 1u);
    return b;
}
__device__ __forceinline__ void xcd_barrier_complete(unsigned* bar, unsigned x, unsigned& nloc, unsigned& nx) {
    const unsigned G = gridDim.x * gridDim.y * gridDim.z;
    unsigned sum, cnt, mine, sp = 0u;
    for (;;) {
        sum = 0u; cnt = 0u; mine = 0u;
#pragma unroll
        for (unsigned j = 0; j < 16; ++j) { const unsigned c = xb_ld(&bar[XB_XCNT(j)]); sum += c; cnt += (c > 0u) ? 1u : 0u; mine = (j == x) ? c : mine; }
        if (sum == G) break;
        __builtin_amdgcn_s_sleep(1);
        if ((++sp & 255u) == 0u) { if (xb_ld(&bar[XB_TMO])) break; if (sp > XB_SPIN_CAP) { atomicAdd(&bar[XB_TMO], 1u); break; } }
    }
    nloc = mine > 0u ? mine : 1u; nx = cnt > 0u ? cnt : 1u;
}
__device__ __forceinline__ void xcd_barrier(const XcdBarrier& b) {
    asm volatile("s_waitcnt vmcnt(0)" ::: "memory");
    __syncthreads();
    if (threadIdx.x == 0) {
        unsigned* bar = b.bar;
        __builtin_amdgcn_s_waitcnt(0);
        unsigned nloc = b.st[0], nx = b.st[1];
        if (nloc == 0u) { xcd_barrier_complete(bar, b.x, nloc, nx); b.st[0] = nloc; b.st[1] = nx; }
        const unsigned old = xb_add(&bar[XB_XSUB(b.x)], 1u);
        const unsigned gen = old / nloc;
        if (old + 1u == (gen + 1u) * nloc) {
            __builtin_amdgcn_fence(__ATOMIC_RELEASE, "agent");
            asm volatile("s_waitcnt vmcnt(0)" ::: "memory");
            const unsigned og = xb_add(&bar[XB_TOP], 1u);
            const unsigned tg = og / nx;
            if (og + 1u == (tg + 1u) * nx) xb_add(&bar[XB_TOPGEN], 1u);
            else XB_SPIN(xb_ld(&bar[XB_TOPGEN]) == tg, bar);
            __builtin_amdgcn_fence(__ATOMIC_ACQUIRE, "agent");
            xb_add(&bar[XB_XGEN(b.x)], 1u);
            asm volatile("s_waitcnt vmcnt(0)" ::: "memory");
        } else {
            XB_SPIN(xb_ld(&bar[XB_XGEN(b.x)]) == gen, bar);
            __builtin_amdgcn_fence(__ATOMIC_ACQUIRE, "agent");
            asm volatile("s_waitcnt vmcnt(0)" ::: "memory");
        }
    }
    __syncthreads();
}

#ifndef WGM_G7
#define WGM_G7 4
#endif
constexpr int NWAVES = 8;
constexpr int N_PHASES = 20;
struct Args { const float* in[22]; float* out; unsigned char* ws; float inv[32]; int ph_lo, ph_hi, use_bar, pad; };

typedef float f32x4 __attribute__((ext_vector_type(4)));
typedef unsigned u32x4v __attribute__((ext_vector_type(4)));
typedef unsigned u32x2v __attribute__((ext_vector_type(2)));

template <bool HASG> __device__ __forceinline__ void transpose_item(const float* W, const float* gain, int K, int Nsrc, int k0, int srccol_lane, bf16_t* WTrow0, LAS float* scr, int lane) {
    const int c = lane & 7;
    f32x4 g0 = {1.f, 1.f, 1.f, 1.f}, g1 = {1.f, 1.f, 1.f, 1.f};
    if constexpr (HASG) { g0 = *(const f32x4*)(gain + k0 + 8 * c); g1 = *(const f32x4*)(gain + k0 + 8 * c + 4); }
#pragma unroll 8
    for (int i = 0; i < 32; ++i) { const int kk = 2 * i + (lane >> 5); scr[kk * 33 + (lane & 31)] = W[(size_t)(k0 + kk) * Nsrc + srccol_lane]; }
    asm volatile("s_waitcnt lgkmcnt(0)" ::: "memory");
#pragma unroll
    for (int j = 0; j < 4; ++j) { const int n = (lane >> 3) + 8 * j; const LAS float* s = scr + (8 * c) * 33 + n;
        u32x4v o; o.x = cvt_pk_bf16(s[0 * 33] * g0[0], s[1 * 33] * g0[1]); o.y = cvt_pk_bf16(s[2 * 33] * g0[2], s[3 * 33] * g0[3]); o.z = cvt_pk_bf16(s[4 * 33] * g1[0], s[5 * 33] * g1[1]); o.w = cvt_pk_bf16(s[6 * 33] * g1[2], s[7 * 33] * g1[3]);
        *(u32x4v*)(WTrow0 + (size_t)n * K + k0 + 8 * c) = o; }
    asm volatile("s_waitcnt lgkmcnt(0)" ::: "memory");
}
template <int MAP, bool HASG> __device__ __forceinline__ bool tr_job(int& r, const float* W, const float* W2, const float* gain, int K, int Nsrc, int ndst, bf16_t* WT, LAS float* scr, int lane) {
    const int nblk = ndst / 32, items = (K / 64) * nblk;
    if (r >= items) { r -= items; return false; }
    const int kb = r / nblk, nb = r % nblk, n0 = nb * 32, nl = n0 + (lane & 31);
    int sc = nl; const float* Ws = W;
    if (MAP == 1) { const int h = nl / CQK, hc = nl % CQK; if (hc >= 128) { const int p = hc - 128, i = p >> 1; sc = h * CQK + 128 + ((p & 1) ? i + 32 : i); } }
    if (MAP == 2) { const int pn = nl >> 8, rr = nl & 255; sc = pn * 128 + (rr & 127); if (rr >= 128) Ws = W2; }
    if (MAP == 3) { if (nl >= OFF_CKR) { const int p = nl - OFF_CKR, i = p >> 1; sc = OFF_CKR + ((p & 1) ? i + 32 : i); } }
    transpose_item<HASG>(Ws, gain, K, Nsrc, kb * 64, sc, WT + (size_t)n0 * K, scr, lane);
    return true;
}

template <bool RAW> __device__ __forceinline__ void row_to_bf16(const float* xrow, bf16_t* orow, float* ssq_row, int lane) {
    const f32x4* xr = (const f32x4*)xrow + lane; f32x4 v[16]; float s = 0.f;
#pragma unroll
    for (int j = 0; j < 16; ++j) { v[j] = xr[64 * j]; s += (v[j].x * v[j].x + v[j].y * v[j].y) + (v[j].z * v[j].z + v[j].w * v[j].w); }
    float sc = 1.f;
    if (RAW) ssq_row[lane] = s; else sc = rsqrtf(wave_sum(s) * (1.f / DM) + NORM_EPS);
    u32x2v* o8 = (u32x2v*)orow + lane;
#pragma unroll
    for (int j = 0; j < 16; ++j) { u32x2v w; w.x = cvt_pk_bf16(v[j].x * sc, v[j].y * sc); w.y = cvt_pk_bf16(v[j].z * sc, v[j].w * sc); o8[64 * j] = w; }
}
__device__ __forceinline__ void rms_row_4096_bf(const bf16_t* xrow, const float* g, float* orow, int lane) {
    const u32x4v* xr = (const u32x4v*)xrow + lane; float v[8][8]; float s = 0.f;
#pragma unroll
    for (int j = 0; j < 8; ++j) { const u32x4v w = xr[64 * j];
#pragma unroll
        for (int e = 0; e < 4; ++e) { v[j][2 * e] = __uint_as_float(w[e] << 16); v[j][2 * e + 1] = __uint_as_float(w[e] & 0xffff0000u); s += v[j][2 * e] * v[j][2 * e] + v[j][2 * e + 1] * v[j][2 * e + 1]; } }
    const float rstd = rsqrtf(wave_sum(s) * (1.f / DM) + NORM_EPS);
#pragma unroll
    for (int j = 0; j < 8; ++j) { const int c0 = (64 * j + lane) * 8; const f32x4 g0 = *(const f32x4*)(g + c0), g1 = *(const f32x4*)(g + c0 + 4);
        f32x4 o0, o1;
#pragma unroll
        for (int e = 0; e < 4; ++e) { o0[e] = v[j][e] * rstd * g0[e]; o1[e] = v[j][4 + e] * rstd * g1[e]; }
        *(f32x4*)(orow + c0) = o0; *(f32x4*)(orow + c0 + 4) = o1; }
}

template <class Sched> __device__ __forceinline__ void build_rstd_table(const Sched& S, const float* ssq, int row0, LAS float* tab) {
    int tid = threadIdx.x; asm volatile("" : "+v"(tid)); const int lane = tid & 63, wave = tid >> 6, sub = lane >> 4, piece = lane & 15;
    int lo = 1 << 30, hi = -1; { pg8::Unit u; for (int i = 0; S.next(i, u); ++i) { lo = u.pm < lo ? u.pm : lo; hi = u.pm > hi ? u.pm : hi; } }
    for (int pm = lo; pm <= hi; ++pm) {
#pragma unroll
        for (int j = 0; j < 8; ++j) { const int r = pm * pg8::BM + wave * 32 + j * 4 + sub;
            const f32x4 a = *(const f32x4*)(ssq + (size_t)r * 64 + piece * 4);
            float t = (a[0] + a[1]) + (a[2] + a[3]); t += __shfl_xor(t, 1); t += __shfl_xor(t, 2); t += __shfl_xor(t, 4); t += __shfl_xor(t, 8);
            if (piece == 0) tab[r - row0] = rsqrtf(t * (1.f / DM) + NORM_EPS); } }
    __syncthreads();
}

__global__ void __launch_bounds__(NWAVES * 64, 2) fwd_kernel(Args args) {
    extern __shared__ __attribute__((aligned(16))) unsigned char lds[];
    LAS unsigned char* ldsl = (LAS unsigned char*)lds;
    volatile LAS unsigned* MISC = (volatile LAS unsigned*)(ldsl + MISC_OFF);
    const int G = gridDim.x, bid = blockIdx.x;
#define PH_TID() int tid = threadIdx.x; asm volatile("" : "+v"(tid)); const int lane = tid & 63, wave = __builtin_amdgcn_readfirstlane(tid >> 6); const int gw = bid * NWAVES + wave, NGW = G * NWAVES; (void)lane; (void)gw; (void)NGW
    unsigned char* ws = args.ws;
    gu32* ctl = (gu32*)(ws + WS_CTL);
    for (int u = threadIdx.x; u < (LDS_BYTES - LDSCTL_OFF) / 4; u += NWAVES * 64) ((LAS unsigned*)(ldsl + LDSCTL_OFF))[u] = 0u;
    __syncthreads();
    XcdBarrier bar; bar.bar = (unsigned*)ctl + CW_BAR; bar.x = 0; bar.st = nullptr;
    if (args.use_bar) bar = xcd_barrier_post((unsigned*)ctl + CW_BAR, MISC + 8);
#ifndef BARX
#define BARX 0
#endif
#define GRID_BAR() do { if (args.use_bar) { xcd_barrier(bar); if (BARX) xcd_barrier(bar); } } while (0)
    const int lo = args.ph_lo, hi = args.ph_hi;
#ifndef PHM
#define PHM 0xFFFFFFFFu
#endif
#define IN(k) (lo <= (k) && (k) < hi)
#define PH(j) ((PHM >> (j)) & 1)
#ifndef REPM
#define REPM 0u
#endif
#define NREP(j) (1 + (int)((REPM >> (j)) & 1u))
#define REPLOOP(j) _Pragma("unroll") for (int rep = 0; rep < NREP(j); ++rep)
#define BOTH(k) (IN(k) && IN((k) + 1))

    float* cosT = (float*)(ws + WS_COS); float* sinT = (float*)(ws + WS_SIN);
    bf16_t* MEMN = (bf16_t*)(ws + WS_MEMN); bf16_t* MEMKV = (bf16_t*)(ws + WS_MEMKV);
    bf16_t* XQ = (bf16_t*)(ws + WS_XQ); bf16_t* XO = (bf16_t*)(ws + WS_XO);
    bf16_t* XB = (bf16_t*)(ws + WS_H); bf16_t* PROJ = (bf16_t*)(ws + WS_PROJ);
    bf16_t* QC = (bf16_t*)(ws + WS_QC); bf16_t* KC = (bf16_t*)(ws + WS_KC); bf16_t* VC = (bf16_t*)(ws + WS_VC);
    bf16_t* MIX = (bf16_t*)(ws + WS_MIX); bf16_t* ACT = (bf16_t*)(ws + WS_ACT);
    float* SSQ = (float*)(ws + WS_SSQ); float* SSQ2 = (float*)(ws + WS_SSQ2); float* CKRS = (float*)(ws + WS_CKR);

#ifndef NPASS
#define NPASS 1
#endif
    for (int pass = 0; pass < NPASS; ++pass) {
    if (PH(13) && IN(0)) { PH_TID(); REPLOOP(13) {
        LAS float* scr = (LAS float*)(ldsl + wave * 16384);
        constexpr int I_IN = (DM / 64) * (D_IN / 32), I_QB = (QRANK / 64) * (QCW / 32), I_KVB = (KVRANK / 64) * (KVW / 32), I_OUT = (DM / 64) * (DM / 32), I_XQ = (DM / 64) * (XD / 32),
                      I_XO = (XD / 64) * (DM / 32), I_GU = (DM / 64) * (GUW / 32), I_DOWN = (DFF / 64) * (DM / 32);
        constexpr int I_LAYER = I_IN + I_QB + I_KVB + I_OUT + 3 * I_XQ + I_XO + I_GU + I_DOWN;
        for (int it = gw; it < DEPTH * I_LAYER; it += NGW) {
            const int l = it / I_LAYER; int r = it % I_LAYER;
            unsigned char* wl = ws + WS_W + (size_t)l * W_LAYER;
            if (tr_job<3, true>(r, args.in[3] + (size_t)l * DM * D_IN, nullptr, args.in[2] + (size_t)l * DM, DM, D_IN, D_IN, (bf16_t*)(wl + WO_IN), scr, lane)) continue;
            if (tr_job<1, true>(r, args.in[7] + (size_t)l * QRANK * QCW, nullptr, args.in[6] + (size_t)l * QRANK, QRANK, QCW, QCW, (bf16_t*)(wl + WO_QB), scr, lane)) continue;
            if (tr_job<0, true>(r, args.in[9] + (size_t)l * KVRANK * KVW, nullptr, args.in[8] + (size_t)l * KVRANK, KVRANK, KVW, KVW, (bf16_t*)(wl + WO_KVB), scr, lane)) continue;
            if (tr_job<0, false>(r, args.in[10] + (size_t)l * DM * DM, nullptr, nullptr, DM, DM, DM, (bf16_t*)(wl + WO_OUT), scr, lane)) continue;
            if (tr_job<0, true>(r, args.in[13] + (size_t)l * DM * XD, nullptr, args.in[11] + (size_t)l * DM, DM, XD, XD, (bf16_t*)(wl + WO_XQ), scr, lane)) continue;
            if (tr_job<0, true>(r, args.in[14] + (size_t)l * DM * XD, nullptr, args.in[12] + (size_t)l * DM, DM, XD, XD, (bf16_t*)(wl + WO_XKV), scr, lane)) continue;
            if (tr_job<0, true>(r, args.in[15] + (size_t)l * DM * XD, nullptr, args.in[12] + (size_t)l * DM, DM, XD, XD, (bf16_t*)(wl + WO_XKV) + (size_t)XD * DM, scr, lane)) continue;
            if (tr_job<0, false>(r, args.in[16] + (size_t)l * XD * DM, nullptr, nullptr, XD, DM, DM, (bf16_t*)(wl + WO_XO), scr, lane)) continue;
            if (tr_job<2, true>(r, args.in[18] + (size_t)l * DM * DFF, args.in[19] + (size_t)l * DM * DFF, args.in[17] + (size_t)l * DM, DM, DFF, GUW, (bf16_t*)(wl + WO_GU), scr, lane)) continue;
            tr_job<0, false>(r, args.in[20] + (size_t)l * DFF * DM, nullptr, nullptr, DFF, DM, DM, (bf16_t*)(wl + WO_DOWN), scr, lane);
        }
        for (int e = bid * 512 + tid; e < SEQ * 32; e += G * 512) { const int pos = e >> 5, i = e & 31; const float ang = (float)pos * args.inv[i];
            double rev = (double)ang * 0.15915494309189533577; rev -= __builtin_rint(rev); const float rf = (float)rev;
            cosT[e] = __builtin_amdgcn_cosf(rf); sinT[e] = __builtin_amdgcn_sinf(rf); }
        for (int m = gw; m < MTOK + MEMROWS; m += NGW) {
            if (m < MTOK) row_to_bf16<true>(args.in[0] + (size_t)m * DM, XB + (size_t)m * DM, SSQ + (size_t)m * 64, lane);
            else row_to_bf16<false>(args.in[1] + (size_t)(m - MTOK) * DM, MEMN + (size_t)(m - MTOK) * DM, nullptr, lane);
        }
            }
        if (BOTH(0)) GRID_BAR();
    }

    for (int l = 0; l < DEPTH; ++l) {
        const int pb = 1 + 9 * l;
        unsigned char* wl = ws + WS_W + (size_t)l * W_LAYER;

        if (PH(1) && IN(pb + 0)) { REPLOOP(1) {
            LAS float* tab = (LAS float*)(ldsl + RSTD_OFF); const int trow0 = (bid & 7) * 2048;
            { pg8::Gemm g{XB, (const bf16_t*)(wl + WO_IN), MTOK, OFF_CKR, DM, DM, DM, OFF_CKR / 256, 0u}; pg8::StaticOrder S; S.init(MTOK, OFF_CKR, G, bid); build_rstd_table(S, SSQ, trow0, tab);
              pg8::EpiG1 E{PROJ, tab, trow0, SSQ2};
              pg8::gemm_phase<pg8::EpiG1, pg8::StaticOrder, true, true>(ldsl, g, S, E); }
            { pg8::Gemm g{XB, (const bf16_t*)(wl + WO_IN) + (size_t)OFF_CKR * DM, MTOK, 4 * 256, DM / 4, DM, DM, 1, (unsigned)(DM / 4 * 2)}; pg8::StaticOrder S; S.init(MTOK, 4 * 256, G, bid);
              pg8::EpiCkr E{CKRS};
              pg8::gemm_phase<pg8::EpiCkr, pg8::StaticOrder, true, true>(ldsl, g, S, E); }
            }
            if (BOTH(pb + 0)) GRID_BAR();
        }
        if (PH(3) && IN(pb + 1)) { REPLOOP(3) {
            { PH_TID();
              for (int m = gw; m < MTOK; m += NGW) {
                  const float rstd = rsqrtf(wave_sum(SSQ[(size_t)m * 64 + lane]) * (1.f / DM) + NORM_EPS);
                  const float* p = CKRS + (size_t)m * 64 + lane; const float v = ((p[0] + p[(size_t)MTOK * 64]) + (p[(size_t)2 * MTOK * 64] + p[(size_t)3 * MTOK * 64])) * rstd;
                  const float o = __shfl_xor(v, 1); const int pos = m & (SEQ - 1), i = lane >> 1; const float c = cosT[pos * 32 + i], sn = sinT[pos * 32 + i];
                  const float r = (lane & 1) ? (o * sn + v * c) : (v * c - o * sn);
                  const unsigned short w = (unsigned short)(cvt_pk_bf16(r, r) & 0xffffu); bf16_t* dst = KC + (size_t)m * QCW + 128 + lane;
#pragma unroll
                  for (int h = 0; h < CH; ++h) dst[h * CQK] = w; } }
            { pg8::Gemm g{PROJ + OFF_CQ, (const bf16_t*)(wl + WO_QB), MTOK, QCW, QRANK, D_INP, QRANK, (QCW) / 256, 0u}; pg8::StaticOrder S; S.init(MTOK, QCW, G, bid);
              pg8::EpiQRope E{QC, cosT, sinT, SSQ2};
              pg8::gemm_phase<pg8::EpiQRope, pg8::StaticOrder, true, true>(ldsl, g, S, E); }
            { pg8::Gemm g{PROJ + OFF_CKV, (const bf16_t*)(wl + WO_KVB), MTOK, KVW, KVRANK, D_INP, KVRANK, (KVW) / 256, 0u}; pg8::StaticOrder S; S.init(MTOK, KVW, G, bid);
              pg8::EpiKV E{KC, VC, SSQ2};
              pg8::gemm_phase<pg8::EpiKV, pg8::StaticOrder, true, true>(ldsl, g, S, E); }
            }
            if (BOTH(pb + 1)) GRID_BAR();
        }
        if (PH(4) && IN(pb + 2)) { PH_TID(); REPLOOP(4) {
#ifndef REPS
#define REPS 7
#endif
            if (PH(16) && (rep == NREP(4) - 1 || (REPS & 1))) for (int u = bid; u < BATCH * CH * 32; u += G) {
                const int x = u & 7, qb = (u >> 3) & 31, bh = (u >> 8) * 8 + x, b = bh / CH, h = bh % CH;
                att::MaskNone mk;
                att::attn_unit_c<192, att::MaskNone>(QC + h * CQK, (long)b * SEQ + qb * 256, QCW, KC + h * CQK, QCW, VC + h * 128, VCW, (long)b * SEQ, (long)b * SEQ, (long)b * SEQ + SEQ - 1, SEQ / 64,
                                                   MIX + MIX_C + h * 128, DM, 0.07216878364870322f * 1.4426950408889634f, -1e5f, 0.f, mk, (char*)lds, ldsl);
            }
            if (PH(17) && (rep == NREP(4) - 1 || (REPS & 2))) for (int u = bid; u < BATCH * AH * 32; u += G) {
                const int x = u & 7, qb = (u >> 3) & 31, bh = (u >> 8) * 8 + x, b = bh / AH, hq = bh % AH, gk = hq / 3;
                const float scale = 0.08838834764831845f, slope = exp2f(-8.f * (float)(hq + 1) / 12.f), sink = args.in[4][l * AH + hq];
                att::MaskA mk; { const int qpos = qb * 256 + (tid >> 6) * 32 + (lane & 31); mk.qoff = qb * 256 - 128 - qpos; mk.lo = -qpos > -128 ? -qpos : -128; mk.hi_ = SEQ - 1 - qpos < 128 ? SEQ - 1 - qpos : 128; } mk.sl = slope / scale;
                att::attn_unit_dma<128, att::MaskA>(PROJ + OFF_AQ + hq * 128, (long)b * SEQ + qb * 256, D_INP, PROJ + OFF_AK + gk * 128, D_INP, PROJ + OFF_AV + gk * 128, D_INP,
                                                (long)b * SEQ + qb * 256 - 128, (long)b * SEQ, (long)b * SEQ + SEQ - 1, 8,
                                                MIX + MIX_A + hq * 128, DM, scale * 1.4426950408889634f, sink / scale, 1.f, mk, (char*)lds, ldsl);
            }
            if (PH(18) && (rep == NREP(4) - 1 || (REPS & 4))) for (int u = bid; u < BATCH * BH * 32; u += G) {
                const int x = u & 7, qb = (u >> 3) & 31, bh = (u >> 8) * 8 + x, b = bh / BH, h = bh % BH;
                const float scale = 0.08838834764831845f;
                float* tab = (float*)(lds + 124928);
                if (tid < 15 * 31) tab[tid] = args.in[5][((size_t)l * BH + h) * 465 + tid] * (1.f / scale);
                const int r0 = qb * 4; int kr0 = r0 - 4; kr0 = kr0 < 0 ? 0 : (kr0 > 117 ? 117 : kr0);
                const int tq = qb * 256 + (tid >> 6) * 32 + (lane & 31);
                att::MaskB mk; mk.qr = tq >> 6; mk.qc = tq & 63; mk.kr0 = kr0; { int rs = mk.qr - 4; mk.rs = rs < 0 ? 0 : (rs > 120 ? 120 : rs); int cs = mk.qc - 8; mk.cs = cs < 0 ? 0 : (cs > 48 ? 48 : cs); } mk.tab = tab;
                att::attn_unit_dma<128, att::MaskB>(PROJ + OFF_BQ + h * 128, (long)b * SEQ + qb * 256, D_INP, PROJ + OFF_BK + h * 128, D_INP, PROJ + OFF_BV + h * 128, D_INP,
                                                (long)b * SEQ + kr0 * 64, (long)b * SEQ, (long)b * SEQ + SEQ - 1, 11,
                                                MIX + MIX_B + h * 128, DM, scale * 1.4426950408889634f, -1e5f, 0.f, mk, (char*)lds, ldsl);
            }
            }
            if (BOTH(pb + 2)) GRID_BAR();
        }
        if (PH(5) && IN(pb + 3)) { REPLOOP(5) {
            pg8::Gemm g{MIX, (const bf16_t*)(wl + WO_OUT), MTOK, DM, DM, DM, DM, (DM) / 256, 0u}; pg8::StaticOrder S; S.init(MTOK, DM, G, bid);
            pg8::EpiRes E{XB, (NREP(5) == 2 && rep == 0) ? (bf16_t*)(ws + 168 * MiB) : XB, SSQ};
            pg8::gemm_phase<pg8::EpiRes, pg8::StaticOrder, true, true>(ldsl, g, S, E);
            }
            if (BOTH(pb + 3)) GRID_BAR();
        }
        if (PH(7) && IN(pb + 4)) { REPLOOP(7) {
            const int half = G / 2;
            if (bid < half) { pg8::Gemm g{XB, (const bf16_t*)(wl + WO_XQ), MTOK, XD, DM, DM, DM, (XD) / 256, 0u}; pg8::StaticOrder S; S.init(MTOK, XD, half, bid);
                LAS float* tab = (LAS float*)(ldsl + RSTD_OFF); const int trow0 = (bid & 7) * 2048; build_rstd_table(S, SSQ, trow0, tab);
                pg8::EpiStoreScaled E{XQ, XD, tab, trow0};
                pg8::gemm_phase<pg8::EpiStoreScaled, pg8::StaticOrder, true, true>(ldsl, g, S, E); }
            else { pg8::Gemm g{MEMN, (const bf16_t*)(wl + WO_XKV), MEMROWS, 2 * XD, DM, DM, DM, (2 * XD) / 256, 0u}; pg8::StaticOrder S; S.init(MEMROWS, 2 * XD, G - half, bid - half);
                pg8::EpiStore E{MEMKV, 2 * XD};
                pg8::gemm_phase<pg8::EpiStore, pg8::StaticOrder, true, true>(ldsl, g, S, E); }
            }
            if (BOTH(pb + 4)) GRID_BAR();
        }
        if (PH(8) && IN(pb + 5)) { REPLOOP(8) {
            for (int u = bid; u < BATCH * 4 * 32; u += G) {
                const int x = u & 7, qb = (u >> 3) & 31, b = x >> 2, h = x & 3;
                att::MaskNone mk;
                att::attn_unit_dma<128, att::MaskNone>(XQ + h * 128, (long)b * SEQ + qb * 256, XD, MEMKV + h * 128, 2 * XD, MEMKV + XD + h * 128, 2 * XD, (long)b * NMEM, (long)b * NMEM, (long)b * NMEM + NMEM - 1, NMEM / 64,
                                                   XO + h * 128, XD, 0.08838834764831845f * 1.4426950408889634f, -1e5f, 0.f, mk, (char*)lds, ldsl);
            }
            }
            if (BOTH(pb + 5)) GRID_BAR();
        }
        if (PH(9) && IN(pb + 6)) { REPLOOP(9) {
            pg8::Gemm g{XO, (const bf16_t*)(wl + WO_XO), MTOK, DM, XD, XD, XD, (DM) / 256, 0u}; pg8::StaticOrder S; S.init(MTOK, DM, G, bid);
            pg8::EpiRes E{XB, (NREP(9) == 2 && rep == 0) ? (bf16_t*)(ws + 168 * MiB) : XB, SSQ};
            pg8::gemm_phase<pg8::EpiRes, pg8::StaticOrder, true, true>(ldsl, g, S, E);
            }
            if (BOTH(pb + 6)) GRID_BAR();
        }
        if (PH(11) && IN(pb + 7)) { REPLOOP(11) {
            pg8::Gemm g{XB, (const bf16_t*)(wl + WO_GU), MTOK, GUW, DM, DM, DM, (GUW) / 256, 0u}; pg8::StaticOrder S; S.init(MTOK, GUW, G, bid);
            LAS float* tab = (LAS float*)(ldsl + RSTD_OFF); const int trow0 = (bid & 7) * 2048; build_rstd_table(S, SSQ, trow0, tab);
            pg8::EpiSwiglu E{ACT, DFF, tab, trow0};
            pg8::gemm_phase<pg8::EpiSwiglu, pg8::StaticOrder, true, true>(ldsl, g, S, E);
            }
            if (BOTH(pb + 7)) GRID_BAR();
        }
        if (PH(12) && IN(pb + 8)) { REPLOOP(12) {
            pg8::Gemm g{ACT, (const bf16_t*)(wl + WO_DOWN), MTOK, DM, DFF, DFF, DFF, (DM) / 256, 0u}; pg8::StaticOrder S; S.init(MTOK, DM, G, bid, WGM_G7);
            pg8::EpiRes E{XB, (NREP(12) == 2 && rep == 0) ? (bf16_t*)(ws + 512 * MiB) : XB, SSQ};
            pg8::gemm_phase<pg8::EpiRes, pg8::StaticOrder, true, true>(ldsl, g, S, E);
            }
            if (BOTH(pb + 8)) GRID_BAR();
        }
    }
    if (PH(14) && IN(19)) { PH_TID();
        for (int m = gw; m < MTOK; m += NGW) rms_row_4096_bf(XB + (size_t)m * DM, args.in[21], args.out + (size_t)m * DM, lane);
    }
    if (NPASS > 1 && pass + 1 < NPASS) GRID_BAR();
    }
#undef IN
#undef BOTH
#undef GRID_BAR
}

#if DBG
constexpr int DBG_NS = 128;
struct DbgBuf { unsigned fail[64]; float snap[64][DBG_NS]; float tol[64][DBG_NS]; };
__device__ __forceinline__ unsigned dhash(unsigned x) { x ^= x >> 16; x *= 0x7feb352dU; x ^= x >> 15; x *= 0x846ca68bU; x ^= x >> 16; return x; }
__device__ __forceinline__ float rbf(float f) { unsigned u = __float_as_uint(f); u += 0x7fffu + ((u >> 16) & 1u); return __uint_as_float(u & 0xffff0000u); }
__device__ __forceinline__ float wave_max(float v) { for (int o = 1; o < 64; o <<= 1) v = fmaxf(v, __shfl_xor(v, o)); return v; }
__device__ void wdot(const bf16_t* a, const float* W, const float* gain, int N, int n, int K, int lane, float& dot, float& sabs) {
    float d = 0.f, sa = 0.f; for (int k = lane; k < K; k += 64) { const float x = bf2f(a[k]) * rbf(W[(size_t)k * N + n] * (gain ? gain[k] : 1.f)); d += x; sa += fabsf(x); } dot = wave_sum(d); sabs = wave_sum(sa); }
__device__ float row_rstd_f32(const float* x, int n, int lane) { float ss = 0.f; for (int k = lane; k < n; k += 64) ss += x[k] * x[k]; return rsqrtf(wave_sum(ss) / n + NORM_EPS); }
__device__ float row_rstd_bf(const bf16_t* x, int n, int lane) { float ss = 0.f; for (int k = lane; k < n; k += 64) ss += bf2f(x[k]) * bf2f(x[k]); return rsqrtf(wave_sum(ss) / n + NORM_EPS); }
__device__ void dsincos(float ang, float& c, float& s) { double x = (double)ang; const double tp = 6.283185307179586476925; x -= tp * __builtin_rint(x / tp);
    double sn = 0.0, cs = 0.0, term = 1.0; for (int k = 0; k < 30; ++k) { if (k & 1) { sn += ((k >> 1) & 1) ? -term : term; } else { cs += ((k >> 1) & 1) ? -term : term; } term *= x / (double)(k + 1); } c = (float)cs; s = (float)sn; }
__device__ void dchk(DbgBuf* D, int cid, float got, float exp, float tol, int lane) { if (lane == 0 && !(fabsf(got - exp) <= tol)) D->fail[cid] = 1u; }

__global__ void __launch_bounds__(64) dbg_check(Args a, int l, int kind, int cid, int pre) {
    const int lane = threadIdx.x, s = blockIdx.x; unsigned char* ws = a.ws; DbgBuf* D = (DbgBuf*)(ws + WS_DBG);
    const unsigned h1 = dhash(cid * 1000003u + s * 7919u + 12345u), h2 = dhash(h1 + 0x9e3779b9u), h3 = dhash(h2 + 0x85ebca6bu);
    bf16_t* MEMN = (bf16_t*)(ws + WS_MEMN); bf16_t* MEMKV = (bf16_t*)(ws + WS_MEMKV); bf16_t* XQ = (bf16_t*)(ws + WS_XQ); bf16_t* XO = (bf16_t*)(ws + WS_XO);
    bf16_t* XB = (bf16_t*)(ws + WS_H); bf16_t* PROJ = (bf16_t*)(ws + WS_PROJ);
    bf16_t* QC = (bf16_t*)(ws + WS_QC); bf16_t* KC = (bf16_t*)(ws + WS_KC); bf16_t* VC = (bf16_t*)(ws + WS_VC); bf16_t* MIX = (bf16_t*)(ws + WS_MIX); bf16_t* ACT = (bf16_t*)(ws + WS_ACT);
    float* SSQ = (float*)(ws + WS_SSQ); float* SSQ2 = (float*)(ws + WS_SSQ2);
    const int m = h1 % MTOK;
    if (kind == 41) {
        const int c = h2 % DM;
        if (s < 64) { const float e = a.in[0][(size_t)m * DM + c]; dchk(D, cid, bf2f(XB[(size_t)m * DM + c]), e, 0.005f * fabsf(e) + 1e-6f, lane); }
        else if (s < 96) { float ss = 0.f; for (int k = lane; k < DM; k += 64) { const float v = a.in[0][(size_t)m * DM + k]; ss += v * v; } ss = wave_sum(ss); const float g = wave_sum(SSQ[(size_t)m * 64 + lane]); dchk(D, cid, g, ss, 1e-4f * ss, lane); }
        else { const int r = h1 % MEMROWS; const float e = a.in[1][(size_t)r * DM + c] * row_rstd_f32(a.in[1] + (size_t)r * DM, DM, lane); dchk(D, cid, bf2f(MEMN[(size_t)r * DM + c]), e, 0.01f * fabsf(e) + 1e-3f, lane); }
    } else if (kind == 40) {
        const int c = h2 % DM;
        if (pre) return; const float exp = bf2f(XB[(size_t)m * DM + c]) * row_rstd_bf(XB + (size_t)m * DM, DM, lane) * a.in[21][c];
        dchk(D, cid, a.out[(size_t)m * DM + c], exp, 1e-4f * fabsf(exp) + 1e-5f, lane);
    } else if (kind == 2) {
        const float rstd = row_rstd_bf(XB + (size_t)m * DM, DM, lane); const float* W = a.in[3] + (size_t)l * DM * D_IN; const float* g = a.in[2] + (size_t)l * DM; const bf16_t* ar = XB + (size_t)m * DM;
        const int sub = s & 7;
        if (false) {}
        else if (sub == 5) { float ss = 0.f; for (int k = lane; k < QRANK; k += 64) { const float v = bf2f(PROJ[(size_t)m * D_INP + OFF_CQ + k]); ss += v * v; } ss = wave_sum(ss); const float gs = wave_sum(lane < 16 ? SSQ2[(size_t)m * 24 + lane] : 0.f); dchk(D, cid, gs, ss, 0.01f * ss, lane); }
        else if (sub == 1) { float ss = 0.f; for (int k = lane; k < KVRANK; k += 64) { const float v = bf2f(PROJ[(size_t)m * D_INP + OFF_CKV + k]); ss += v * v; } ss = wave_sum(ss); const float gs = wave_sum(lane < 8 ? SSQ2[(size_t)m * 24 + 16 + lane] : 0.f); dchk(D, cid, gs, ss, 0.01f * ss, lane); }
        else { const int n = h2 % OFF_CKR; float d, sa; wdot(ar, W, g, D_IN, n, DM, lane, d, sa); d *= rstd; dchk(D, cid, bf2f(PROJ[(size_t)m * D_INP + n]), d, 0.02f * fabsf(d) + 2e-4f * sa * rstd, lane); }
    } else if (kind == 4) {
        const int hh = h2 % CH; const float* W = a.in[7] + (size_t)l * QRANK * QCW; const float* g = a.in[6] + (size_t)l * QRANK; const bf16_t* ar = PROJ + (size_t)m * D_INP + OFF_CQ; const float rstd = row_rstd_bf(ar, QRANK, lane);
        if (s & 1) { const int d0 = h3 % 128; float d, sa; wdot(ar, W, g, QCW, hh * CQK + d0, QRANK, lane, d, sa); d *= rstd * QSC_C; dchk(D, cid, bf2f(QC[(size_t)m * QCW + hh * CQK + d0]), d, 0.02f * fabsf(d) + 2e-4f * sa * rstd * QSC_C, lane); }
        else { const int i = h3 % 32; float x1, s1, x2, s2; wdot(ar, W, g, QCW, hh * CQK + 128 + i, QRANK, lane, x1, s1); wdot(ar, W, g, QCW, hh * CQK + 128 + i + 32, QRANK, lane, x2, s2); x1 *= rstd * QSC_C; x2 *= rstd * QSC_C;
            float c, sn; dsincos((float)(m % SEQ) * a.inv[i], c, sn); const float e1 = x1 * c - x2 * sn, e2 = x1 * sn + x2 * c; const bf16_t* q = QC + (size_t)m * QCW + hh * CQK + 128 + 2 * i;
            const float tol = 2e-4f * (s1 + s2) * rstd * QSC_C; dchk(D, cid, bf2f(q[0]), e1, 0.02f * fabsf(e1) + tol, lane); dchk(D, cid, bf2f(q[1]), e2, 0.02f * fabsf(e2) + tol, lane); }
    } else if (kind == 5 && (s & 3) == 2) {
        const float rstd = row_rstd_bf(XB + (size_t)m * DM, DM, lane); const float* W = a.in[3] + (size_t)l * DM * D_IN; const float* g = a.in[2] + (size_t)l * DM; const bf16_t* ar = XB + (size_t)m * DM;
        const int i = h2 % 32, hh = h3 % CH; float x1, s1, x2, s2; wdot(ar, W, g, D_IN, OFF_CKR + i, DM, lane, x1, s1); wdot(ar, W, g, D_IN, OFF_CKR + i + 32, DM, lane, x2, s2); x1 *= rstd; x2 *= rstd;
        float c, sn; dsincos((float)(m % SEQ) * a.inv[i], c, sn); const float e1 = x1 * c - x2 * sn, e2 = x1 * sn + x2 * c; const bf16_t* kc = KC + (size_t)m * QCW + hh * CQK + 128 + 2 * i; const float tol = 2e-4f * (s1 + s2) * rstd;
        dchk(D, cid, bf2f(kc[0]), e1, 0.02f * fabsf(e1) + tol, lane); dchk(D, cid, bf2f(kc[1]), e2, 0.02f * fabsf(e2) + tol, lane);
    } else if (kind == 5) {
        const int hh = h2 % CH, part = s & 1, d0 = h3 % 128; const bf16_t* ar = PROJ + (size_t)m * D_INP + OFF_CKV; const float rstd = row_rstd_bf(ar, KVRANK, lane); float d, sa;
        wdot(ar, a.in[9] + (size_t)l * KVRANK * KVW, a.in[8] + (size_t)l * KVRANK, KVW, hh * 256 + part * 128 + d0, KVRANK, lane, d, sa); d *= rstd;
        const float got = part ? bf2f(VC[(size_t)m * VCW + hh * 128 + d0]) : bf2f(KC[(size_t)m * QCW + hh * CQK + d0]); dchk(D, cid, got, d, 0.02f * fabsf(d) + 2e-4f * sa * rstd, lane);
    } else if (kind == 6 || kind == 7 || kind == 8 || kind == 12) {
        const int b = m / SEQ, pos = m % SEQ, d0 = h3 % 128; int nk, hh; float scale; const bf16_t *qp, *kp0, *vp0; int ldk, ldv, dqk; float got; float sinkv = 0.f; bool has_sink = false;
        int rs = 0, cs = 0, qr = pos >> 6, qc = pos & 63; float slope = 0.f; const float* rpb = nullptr;
        if (kind == 6) { hh = h2 % CH; nk = SEQ; scale = 0.6931471805599453f;     dqk = 192; qp = QC + (size_t)m * QCW + hh * CQK; kp0 = KC + (size_t)b * SEQ * QCW + hh * CQK; ldk = QCW; vp0 = VC + (size_t)b * SEQ * VCW + hh * 128 + d0; ldv = VCW; got = bf2f(MIX[(size_t)m * DM + MIX_C + hh * 128 + d0]); }
        else if (kind == 7) { hh = h2 % AH; nk = 257; scale = 0.08838834764831845f; dqk = 128; qp = PROJ + (size_t)m * D_INP + OFF_AQ + hh * 128; kp0 = PROJ + (size_t)b * SEQ * D_INP + OFF_AK + (hh / 3) * 128; ldk = D_INP; vp0 = PROJ + (size_t)b * SEQ * D_INP + OFF_AV + (hh / 3) * 128 + d0; ldv = D_INP;
            got = bf2f(MIX[(size_t)m * DM + MIX_A + hh * 128 + d0]); slope = exp2f(-8.f * (float)(hh + 1) / 12.f); sinkv = a.in[4][l * AH + hh]; has_sink = true; }
        else if (kind == 8) { hh = h2 % BH; nk = 128; scale = 0.08838834764831845f; dqk = 128; qp = PROJ + (size_t)m * D_INP + OFF_BQ + hh * 128; kp0 = PROJ + (size_t)b * SEQ * D_INP + OFF_BK + hh * 128; ldk = D_INP; vp0 = PROJ + (size_t)b * SEQ * D_INP + OFF_BV + hh * 128 + d0; ldv = D_INP;
            got = bf2f(MIX[(size_t)m * DM + MIX_B + hh * 128 + d0]); rs = qr - 4; rs = rs < 0 ? 0 : (rs > 120 ? 120 : rs); cs = qc - 8; cs = cs < 0 ? 0 : (cs > 48 ? 48 : cs); rpb = a.in[5] + ((size_t)l * BH + hh) * 465; }
        else { hh = h2 % 4; nk = NMEM; scale = 0.08838834764831845f; dqk = 128; qp = XQ + (size_t)m * XD + hh * 128; kp0 = MEMKV + (size_t)b * NMEM * 2 * XD + hh * 128; ldk = 2 * XD; vp0 = MEMKV + (size_t)b * NMEM * 2 * XD + XD + hh * 128 + d0; ldv = 2 * XD; got = bf2f(XO[(size_t)m * XD + hh * 128 + d0]); }
        float mx = has_sink ? sinkv : -1e30f, den = 0.f, acc = 0.f, vmax = 0.f;
        for (int pass = 0; pass < 2; ++pass) {
            if (pass == 1) mx = wave_max(mx);
            for (int j = lane; j < nk; j += 64) { int key; float bias = 0.f;
                if (kind == 7) { key = pos - 128 + j; if (key < 0 || key >= SEQ) continue; const int ar = key > pos ? key - pos : pos - key; bias = -slope * (float)ar; }
                else if (kind == 8) { const int kr = rs + (j >> 4), kcn = cs + (j & 15); key = kr * 64 + kcn; bias = rpb[(kr - qr + 7) * 31 + (kcn - qc + 15)]; }
                else key = j;
                float dt = 0.f; const bf16_t* kp = kp0 + (size_t)key * ldk; for (int e = 0; e < dqk; ++e) dt += bf2f(qp[e]) * bf2f(kp[e]);
                const float sc = dt * scale + bias;
                if (pass == 0) mx = fmaxf(mx, sc); else { const float p = __expf(sc - mx); const float v = bf2f(vp0[(size_t)key * ldv]); den += p; acc += p * v; vmax = fmaxf(vmax, fabsf(v)); } } }
        den = wave_sum(den); acc = wave_sum(acc); vmax = wave_max(vmax); if (has_sink) den += __expf(sinkv - mx);
        const float exp = acc / den; dchk(D, cid, got, exp, 0.03f * fabsf(exp) + 0.01f * vmax, lane);
    } else if (kind == 9 || kind == 13 || kind == 16) {
        const int n = h2 % DM;
        if (!pre) { const float e = D->snap[cid][s], t = D->tol[cid][s]; dchk(D, cid, bf2f(XB[(size_t)m * DM + n]), e, t + 0.005f * fabsf(e), lane);
            if ((s & 3) == 0) { float ss = 0.f; for (int k = lane; k < DM; k += 64) { const float v = bf2f(XB[(size_t)m * DM + k]); ss += v * v; } ss = wave_sum(ss); const float g = wave_sum(SSQ[(size_t)m * 64 + lane]); dchk(D, cid, g, ss, 5e-3f * ss, lane); }
            return; }
        float d, sa; const float xo = bf2f(XB[(size_t)m * DM + n]);
        if (kind == 9) wdot(MIX + (size_t)m * DM, a.in[10] + (size_t)l * DM * DM, nullptr, DM, n, DM, lane, d, sa);
        else if (kind == 13) wdot(XO + (size_t)m * XD, a.in[16] + (size_t)l * XD * DM, nullptr, DM, n, XD, lane, d, sa);
        else wdot(ACT + (size_t)m * DFF, a.in[20] + (size_t)l * DFF * DM, nullptr, DM, n, DFF, lane, d, sa);
        if (lane == 0) { D->snap[cid][s] = xo + d; D->tol[cid][s] = 0.02f * fabsf(d) + 2e-4f * sa + 1e-5f * fabsf(xo); }
    } else if (kind == 11) {
        float d, sa;
        if (s < 96) { const int n = h2 % XD; const float rstd = row_rstd_bf(XB + (size_t)m * DM, DM, lane); wdot(XB + (size_t)m * DM, a.in[13] + (size_t)l * DM * XD, a.in[11] + (size_t)l * DM, XD, n, DM, lane, d, sa); d *= rstd;
            dchk(D, cid, bf2f(XQ[(size_t)m * XD + n]), d, 0.02f * fabsf(d) + 2e-4f * sa * rstd, lane); }
        else { const int r = h1 % MEMROWS, n = h2 % (2 * XD); wdot(MEMN + (size_t)r * DM, (n < XD ? a.in[14] : a.in[15]) + (size_t)l * DM * XD, a.in[12] + (size_t)l * DM, XD, n % XD, DM, lane, d, sa); dchk(D, cid, bf2f(MEMKV[(size_t)r * 2 * XD + n]), d, 0.02f * fabsf(d) + 2e-4f * sa, lane); }
    } else if (kind == 15) {
        const int j = h2 % DFF; float g, sg, u, su; const float rstd = row_rstd_bf(XB + (size_t)m * DM, DM, lane); const float* gn = a.in[17] + (size_t)l * DM;
        wdot(XB + (size_t)m * DM, a.in[18] + (size_t)l * DM * DFF, gn, DFF, j, DM, lane, g, sg); wdot(XB + (size_t)m * DM, a.in[19] + (size_t)l * DM * DFF, gn, DFF, j, DM, lane, u, su); g *= rstd; u *= rstd;
        const float exp = g / (1.f + __expf(-g)) * u; dchk(D, cid, bf2f(ACT[(size_t)m * DFF + j]), exp, 0.03f * fabsf(exp) + 4e-3f, lane);
    }
}
__global__ void dbg_final(Args a) {
    DbgBuf* D = (DbgBuf*)(a.ws + WS_DBG); int id1 = 0, id2 = 0;
    for (int i = 1; i < 64; ++i) if (D->fail[i]) { if (!id1) id1 = i; else if (!id2) id2 = i; }
    if (!id1) return; if (id2 > 33) id2 = 33;
    const float c = sqrtf((10.f + (float)id1) / 10.f) * __powf(10.f, 0.5f * (float)(4 + id2));
    for (size_t i = (size_t)blockIdx.x * blockDim.x + threadIdx.x; i < (size_t)MTOK * DM; i += (size_t)gridDim.x * blockDim.x) a.out[i] = c;
}
static void dbg_run(Args a, int grid, hipStream_t stream) {
    (void)hipMemsetAsync(a.ws + WS_DBG, 0, sizeof(DbgBuf), stream);
    auto chk = [&](int l, int kind, int pre) { hipLaunchKernelGGL(dbg_check, dim3(DBG_NS), dim3(64), 0, stream, a, l, kind, kind >= 40 ? kind : 20 * l + kind, pre); };
    for (int p = 0; p < N_PHASES; ++p) {
        const int l = (p - 1) / 9, j = (p - 1) % 9;
        if (p >= 1 && p <= 18) { if (j == 3) chk(l, 9, 1); if (j == 6) chk(l, 13, 1); if (j == 8) chk(l, 16, 1); }
        if (p == 19) chk(0, 40, 1);
        a.ph_lo = p; a.ph_hi = p + 1; a.use_bar = 0; a.pad = 0;
        hipLaunchKernelGGL(fwd_kernel, dim3(grid), dim3(NWAVES * 64), LDS_BYTES, stream, a);
        if (p == 0) chk(0, 41, 0);
        if (p >= 1 && p <= 18) {
            switch (j) { case 0: chk(l, 2, 0); break; case 1: chk(l, 4, 0); chk(l, 5, 0); break; case 2: chk(l, 6, 0); chk(l, 7, 0); chk(l, 8, 0); break;
                case 3: chk(l, 9, 0); break; case 4: chk(l, 11, 0); break; case 5: chk(l, 12, 0); break; case 6: chk(l, 13, 0); break; case 7: chk(l, 15, 0); break; case 8: chk(l, 16, 0); break; }
        }
        if (p == 19) chk(0, 40, 0);
    }
    hipLaunchKernelGGL(dbg_final, dim3(2048), dim3(256), 0, stream, a);
}
#endif

extern "C" void kernel_launch(void* const* d_in, const int* in_sizes, int n_in, void* d_out, int out_size, void* d_ws, size_t ws_size, hipStream_t stream) {
    static int grid = 0;
    if (grid == 0) {
        if (n_in != 22 || out_size != MTOK * DM || ws_size < WS_END) { fprintf(stderr, "kernel_launch: unexpected shapes: n_in %d out %d ws %zu (need %zu)\n", n_in, out_size, ws_size, (size_t)WS_END); grid = -1; return; }
        int dev = 0, cus = 0, per_cu = 0;
        if (hipGetDevice(&dev) != hipSuccess || hipDeviceGetAttribute(&cus, hipDeviceAttributeMultiprocessorCount, dev) != hipSuccess) { grid = -1; return; }
        if (hipFuncSetAttribute((const void*)fwd_kernel, hipFuncAttributeMaxDynamicSharedMemorySize, LDS_BYTES) != hipSuccess) { fprintf(stderr, "kernel_launch: hipFuncSetAttribute failed\n"); grid = -1; return; }
        if (hipOccupancyMaxActiveBlocksPerMultiprocessor(&per_cu, (const void*)fwd_kernel, NWAVES * 64, LDS_BYTES) != hipSuccess || per_cu < 1) { fprintf(stderr, "kernel_launch: occupancy query says %d blocks per CU\n", per_cu); (void)hipGetLastError(); grid = -1; return; }
        grid = cus;
    }
    if (grid < 0) return;
    (void)hipMemsetAsync((char*)d_ws + WS_CTL, 0, CTL_ZERO_BYTES, stream);
    Args a{};
    for (int i = 0; i < 22; ++i) a.in[i] = (const float*)d_in[i];
    a.out = (float*)d_out; a.ws = (unsigned char*)d_ws;
    for (int i = 0; i < 32; ++i) { const float p = powf(10000.0f, (float)(2 * i) / 64.0f); a.inv[i] = 1.0f / p; }
#if DBG
    dbg_run(a, grid, stream);
#else
    a.ph_lo = 0; a.ph_hi = N_PHASES; a.use_bar = 1; a.pad = 0;
    hipLaunchKernelGGL(fwd_kernel, dim3(grid), dim3(NWAVES * 64), LDS_BYTES, stream, a);
#endif
}
```

```cpp
#include <hip/hip_runtime.h>
#include <cstdio>
#include <cstdint>
#include <cmath>

#ifndef DBG
#define DBG 0
#endif

constexpr int BATCH = 2, SEQ = 8192, DM = 4096, MTOK = BATCH * SEQ, DEPTH = 2;
constexpr int NMEM = 256, MEMROWS = BATCH * NMEM;
constexpr int D_IN = 7232, D_INP = 7424;
constexpr int OFF_AQ = 0, OFF_AK = 1536, OFF_AV = 2048, OFF_BQ = 2560, OFF_BK = 3584, OFF_BV = 4608, OFF_CQ = 5632, OFF_CKV = 6656, OFF_CKR = 7168;
constexpr int QRANK = 1024, KVRANK = 512, CH = 12, CQK = 192, QCW = CH * CQK, KVW = CH * 256, VCW = CH * 128;
constexpr int XD = 512, DFF = 11008, GUW = 2 * DFF;
constexpr int AH = 12, BH = 8;
constexpr int MIX_A = 0, MIX_B = 1536, MIX_C = 2560;
constexpr float NORM_EPS = 1e-6f;
constexpr float QSC_C = 0.07216878364870322f * 1.4426950408889634f;

constexpr size_t MiB = 1u << 20;
constexpr size_t WS_CTL = 0, CTL_ZERO_BYTES = 1 * MiB;
constexpr size_t WS_COS = 1 * MiB, WS_SIN = 2 * MiB;
constexpr size_t WS_MEMN = 3 * MiB;
constexpr size_t WS_MEMKV = 7 * MiB;
constexpr size_t WS_XQ = 8 * MiB, WS_XO = 24 * MiB;
constexpr size_t WS_H = 40 * MiB;
constexpr size_t WS_PROJ = 168 * MiB;
constexpr size_t WS_CQN = 400 * MiB;
constexpr size_t WS_CKVN = 432 * MiB;
constexpr size_t WS_QC = 448 * MiB;
constexpr size_t WS_KC = 520 * MiB;
constexpr size_t WS_VC = 592 * MiB;
constexpr size_t WS_MIX = 640 * MiB;
constexpr size_t WS_ACT = 168 * MiB;
constexpr size_t WS_W = 768 * MiB;
constexpr size_t WO_IN = 0, WO_QB = WO_IN + (size_t)D_INP * DM * 2, WO_KVB = WO_QB + (size_t)QCW * QRANK * 2, WO_OUT = WO_KVB + (size_t)KVW * KVRANK * 2,
                 WO_XQ = WO_OUT + (size_t)DM * DM * 2, WO_XKV = WO_XQ + (size_t)XD * DM * 2, WO_XO = WO_XKV + (size_t)2 * XD * DM * 2, WO_GU = WO_XO + (size_t)DM * XD * 2,
                 WO_DOWN = WO_GU + (size_t)GUW * DM * 2, W_LAYER = WO_DOWN + (size_t)DM * DFF * 2;
constexpr size_t WS_SSQ = WS_W + 2 * W_LAYER;
constexpr size_t WS_SSQ2 = WS_SSQ + 4 * MiB;
constexpr size_t WS_CKR = WS_SSQ2 + 2 * MiB;
constexpr size_t WS_DBG = WS_CKR + 16 * MiB;
constexpr size_t WS_END = WS_DBG + 1 * MiB;
static_assert((2 * W_LAYER) % MiB == 0, "SSQ alignment");
static_assert(WS_ACT + (size_t)MTOK * DFF * 2 <= WS_MIX, "ACT overlay");
static_assert(WS_PROJ + (size_t)MTOK * D_INP * 2 <= WS_CQN, "PROJ");
static_assert(W_LAYER % 256 == 0, "weights aligned");

constexpr int CW_BAR = 4096;

constexpr int RING_BYTES = 131072;
constexpr int LDSCTL_OFF = RING_BYTES, MISC_OFF = LDSCTL_OFF + 320;
constexpr int RSTD_OFF = LDSCTL_OFF + 1024;
constexpr int LDS_BYTES = 147456;
static_assert(RSTD_OFF + 8192 <= LDS_BYTES, "LDS map");

typedef unsigned short bf16_t;
#define LAS __attribute__((address_space(3)))
#define GAS __attribute__((address_space(1)))
typedef GAS unsigned gu32;
#define RLX_AGENT __ATOMIC_RELAXED, __HIP_MEMORY_SCOPE_AGENT

__device__ __forceinline__ float bf2f(bf16_t b) { return __uint_as_float(((unsigned)b) << 16); }
__device__ __forceinline__ unsigned cvt_pk_bf16(float lo, float hi) { unsigned r; asm volatile("v_cvt_pk_bf16_f32 %0, %1, %2" : "=v"(r) : "v"(lo), "v"(hi)); return r; }
__device__ __forceinline__ float wave_sum(float v) {
#pragma unroll
    for (int o = 1; o < 64; o <<= 1) v += __shfl_xor(v, o);
    return v;
}

namespace pg8 {
#define PG8_LAS __attribute__((address_space(3)))
typedef short bf16x8 __attribute__((ext_vector_type(8)));
typedef float f32x4 __attribute__((ext_vector_type(4)));
typedef float f32x2 __attribute__((ext_vector_type(2)));
typedef unsigned u32x4 __attribute__((ext_vector_type(4)));
constexpr int BM = 256, BK = 64, HALF = 128, HTB = HALF * BK * 2, STAGE_BYTES = 8 * HTB, NXCD = 8, WGM = 8;

__host__ __device__ __forceinline__ int lds_byte(int r, int c) { const int st = (r >> 4) * 2 + (c >> 5), rr = r & 15, cc = c & 31, ob = rr * 64 + cc * 2; return st * 1024 + (ob ^ (((ob >> 9) & 1) << 5)); }
__host__ __device__ __forceinline__ void stage_rc(int b, int& R, int& C) { const int st = b / 1024, sb = b % 1024, swz = sb ^ (((sb >> 9) & 1) << 5); R = (st >> 1) * 16 + swz / 64; C = (st & 1) * 32 + (swz % 64) / 2; }
__host__ __device__ __forceinline__ int perm32(int rho) { const int n = rho >> 4, i = rho & 15; return 8 * (i >> 2) + 4 * n + (i & 3); }

struct Unit { int pm, pn; };
struct Gemm { const bf16_t* A; const bf16_t* Bt; int M, N, K, lda, ldb, nNc; unsigned ksplit_bytes; };

struct StaticOrder {
    int nM, nN, nwg, G, c, wgm;
    __host__ __device__ void init(int M, int N, int G_, int c_, int wgm_ = WGM) { nM = M / BM; nN = N / BM; nwg = nM * nN; G = G_; c = c_; wgm = wgm_; }
    __host__ __device__ bool next(int i, Unit& u) const {
        const long L = (long)i * G + c; if (L >= nwg) return false;
        int wgid = (int)L; { const int q = nwg / NXCD, r = nwg % NXCD, xcd = wgid % NXCD, off = wgid / NXCD; wgid = (xcd < r ? xcd * (q + 1) : r * (q + 1) + (xcd - r) * q) + off; }
        const int nig = wgm * nN, gid = wgid / nig, fm = gid * wgm, gsz = (nM - fm) < wgm ? (nM - fm) : wgm;
        u.pm = fm + ((wgid % nig) % gsz); u.pn = (wgid % nig) / gsz; return true;
    }
    __device__ __forceinline__ void a_ready(const Unit&) const {}
    __device__ __forceinline__ void done(const Unit&) const {}
};


template <int NS> __device__ __forceinline__ void rows_rstd(float (&rs)[2][4], const float* slots, int pitch, int row0, int fq, float inv_n) {
#pragma unroll
    for (int ai = 0; ai < 2; ++ai)
#pragma unroll
        for (int m = 0; m < 4; ++m) { const float* p = slots + (size_t)(row0 + ai * HALF + m * 16) * pitch; float t;
            if constexpr (NS == 64) { const f32x4 a = *(const f32x4*)(p + fq * 16), b = *(const f32x4*)(p + fq * 16 + 4), c = *(const f32x4*)(p + fq * 16 + 8), d = *(const f32x4*)(p + fq * 16 + 12);
                t = ((a[0] + a[1]) + (a[2] + a[3])) + ((b[0] + b[1]) + (b[2] + b[3])) + ((c[0] + c[1]) + (c[2] + c[3])) + ((d[0] + d[1]) + (d[2] + d[3])); }
            else if constexpr (NS == 16) { const f32x4 a = *(const f32x4*)(p + fq * 4); t = (a[0] + a[1]) + (a[2] + a[3]); }
            else { const f32x2 a = *(const f32x2*)(p + fq * 2); t = a[0] + a[1]; }
            t += __shfl_xor(t, 16); t += __shfl_xor(t, 32);
            rs[ai][m] = rsqrtf(t * inv_n + NORM_EPS); }
}
__device__ __forceinline__ void rows_rstd_tab(float (&rs)[2][4], const PG8_LAS float* tab, int tab_row0, int row0) {
#pragma unroll
    for (int ai = 0; ai < 2; ++ai)
#pragma unroll
        for (int m = 0; m < 4; ++m) rs[ai][m] = tab[row0 + ai * HALF + m * 16 - tab_row0];
}
__device__ __forceinline__ u32x4 pack8(const f32x4 v0, const f32x4 v1) { u32x4 w; w.x = cvt_pk_bf16(v0[0], v0[1]); w.y = cvt_pk_bf16(v0[2], v0[3]); w.z = cvt_pk_bf16(v1[0], v1[1]); w.w = cvt_pk_bf16(v1[2], v1[3]); return w; }

__device__ __forceinline__ float xsum_rows(float q) {
    { auto r = __builtin_amdgcn_permlane16_swap(__float_as_uint(q), __float_as_uint(q), false, false); q = __uint_as_float(r[0]) + __uint_as_float(r[1]); }
    { auto r = __builtin_amdgcn_permlane32_swap(__float_as_uint(q), __float_as_uint(q), false, false); q = __uint_as_float(r[0]) + __uint_as_float(r[1]); }
    return q;
}
struct EpiStore {
    static constexpr bool PERM = true, AFTER_DRAIN = false, INPLACE = false, B0ONLY = false;
    bf16_t* O; int ldc;
    __device__ __forceinline__ void operator()(const f32x4 (&acc)[2][2][4][2], const Unit& u, int wr, int wc, int fr, int fq) const {
        const int row0 = u.pm * BM + wr * 64 + fr, col0 = u.pn * BM + wc * 32 + 8 * fq;
#pragma unroll
        for (int ai = 0; ai < 2; ++ai)
#pragma unroll
            for (int m = 0; m < 4; ++m) { bf16_t* rowp = O + (size_t)(row0 + ai * HALF + m * 16) * ldc + col0;
#pragma unroll
                for (int bj = 0; bj < 2; ++bj) *(u32x4*)(rowp + bj * HALF) = pack8(acc[ai][bj][m][0], acc[ai][bj][m][1]); }
    }
};
struct EpiStoreScaled {
    static constexpr bool PERM = true, AFTER_DRAIN = false, INPLACE = false, B0ONLY = false;
    bf16_t* O; int ldc; const PG8_LAS float* tab; int tab_row0;
    __device__ __forceinline__ void operator()(const f32x4 (&acc)[2][2][4][2], const Unit& u, int wr, int wc, int fr, int fq) const {
        const int row0 = u.pm * BM + wr * 64 + fr, col0 = u.pn * BM + wc * 32 + 8 * fq;
        float rs[2][4]; rows_rstd_tab(rs, tab, tab_row0, row0);
#pragma unroll
        for (int ai = 0; ai < 2; ++ai)
#pragma unroll
            for (int m = 0; m < 4; ++m) { bf16_t* rowp = O + (size_t)(row0 + ai * HALF + m * 16) * ldc + col0;
#pragma unroll
                for (int bj = 0; bj < 2; ++bj) *(u32x4*)(rowp + bj * HALF) = pack8(acc[ai][bj][m][0] * rs[ai][m], acc[ai][bj][m][1] * rs[ai][m]); }
    }
};
struct EpiG1 {
    static constexpr bool PERM = true, AFTER_DRAIN = false, INPLACE = false, B0ONLY = false;
    bf16_t* PROJ; const PG8_LAS float* tab; int tab_row0; float* ssq2;
    __device__ __forceinline__ void operator()(const f32x4 (&acc)[2][2][4][2], const Unit& u, int wr, int wc, int fr, int fq) const {
        const int row0 = u.pm * BM + wr * 64 + fr, col0 = u.pn * BM + wc * 32 + 8 * fq;
        float rs[2][4]; rows_rstd_tab(rs, tab, tab_row0, row0);
        const bool stats = u.pn >= 22; const int slot = (u.pn < 26 ? (u.pn - 22) * 4 : 16 + (u.pn - 26) * 4) + wc;
#pragma unroll
        for (int ai = 0; ai < 2; ++ai)
#pragma unroll
            for (int m = 0; m < 4; ++m) { const int row = row0 + ai * HALF + m * 16; bf16_t* rowp = PROJ + (size_t)row * D_INP + col0; float q = 0.f;
#pragma unroll
                for (int bj = 0; bj < 2; ++bj) { const f32x4 v0 = acc[ai][bj][m][0] * rs[ai][m], v1 = acc[ai][bj][m][1] * rs[ai][m];
                    q += ((v0[0] * v0[0] + v0[1] * v0[1]) + (v0[2] * v0[2] + v0[3] * v0[3])) + ((v1[0] * v1[0] + v1[1] * v1[1]) + (v1[2] * v1[2] + v1[3] * v1[3]));
                    *(u32x4*)(rowp + bj * HALF) = pack8(v0, v1); }
                if (stats) { q = xsum_rows(q); if (fq == 0) ssq2[(size_t)row * 24 + slot] = q; } }
    }
};
struct EpiCkr {
    static constexpr bool PERM = true, AFTER_DRAIN = false, INPLACE = false, B0ONLY = true;
    float* slab;
    __device__ __forceinline__ void operator()(const f32x4 (&acc)[2][2][4][2], const Unit& u, int wr, int wc, int fr, int fq) const {
        if (wc >= 2) return;
        const int row0 = u.pm * BM + wr * 64 + fr; float* base = slab + (size_t)u.pn * MTOK * 64 + 32 * wc + 8 * fq;
#pragma unroll
        for (int ai = 0; ai < 2; ++ai)
#pragma unroll
            for (int m = 0; m < 4; ++m) { float* p = base + (size_t)(row0 + ai * HALF + m * 16) * 64; *(f32x4*)p = acc[ai][0][m][0]; *(f32x4*)(p + 4) = acc[ai][0][m][1]; }
    }
};
struct EpiQRope {
    static constexpr bool PERM = true, AFTER_DRAIN = false, INPLACE = false, B0ONLY = false;
    bf16_t* O; const float* cs; const float* sn; const float* ssq2;
    __device__ __forceinline__ void operator()(const f32x4 (&acc)[2][2][4][2], const Unit& u, int wr, int wc, int fr, int fq) const {
        const int row0 = u.pm * BM + wr * 64 + fr;
        float rs[2][4]; rows_rstd<16>(rs, ssq2, 24, row0, fq, 1.f / QRANK);
#pragma unroll
        for (int bj = 0; bj < 2; ++bj) {
            const int cg = u.pn * BM + bj * HALF + wc * 32;
            const int hc = cg % CQK;
            const bool rope = hc >= 128;
            const int i0 = ((hc - 128) >> 1) + 4 * fq;
#pragma unroll
            for (int ai = 0; ai < 2; ++ai)
#pragma unroll
                for (int m = 0; m < 4; ++m) { const int row = row0 + ai * HALF + m * 16;
                    f32x4 v0 = acc[ai][bj][m][0] * (rs[ai][m] * QSC_C), v1 = acc[ai][bj][m][1] * (rs[ai][m] * QSC_C);
                    if (rope) { const int pos = row & (SEQ - 1); const f32x4 c = *(const f32x4*)(cs + pos * 32 + i0), s = *(const f32x4*)(sn + pos * 32 + i0);
                        const f32x4 a0 = v0, a1 = v1;
                        v0[0] = a0[0] * c[0] - a0[1] * s[0]; v0[1] = a0[0] * s[0] + a0[1] * c[0];
                        v0[2] = a0[2] * c[1] - a0[3] * s[1]; v0[3] = a0[2] * s[1] + a0[3] * c[1];
                        v1[0] = a1[0] * c[2] - a1[1] * s[2]; v1[1] = a1[0] * s[2] + a1[1] * c[2];
                        v1[2] = a1[2] * c[3] - a1[3] * s[3]; v1[3] = a1[2] * s[3] + a1[3] * c[3]; }
                    *(u32x4*)(O + (size_t)row * QCW + cg + 8 * fq) = pack8(v0, v1); }
        }
    }
};
struct EpiKV {
    static constexpr bool PERM = true, AFTER_DRAIN = false, INPLACE = false, B0ONLY = false;
    bf16_t* KC; bf16_t* VC; const float* ssq2;
    __device__ __forceinline__ void operator()(const f32x4 (&acc)[2][2][4][2], const Unit& u, int wr, int wc, int fr, int fq) const {
        const int row0 = u.pm * BM + wr * 64 + fr, cl = wc * 32 + 8 * fq;
        float rs[2][4]; rows_rstd<8>(rs, ssq2 + 16, 24, row0, fq, 1.f / KVRANK);
#pragma unroll
        for (int ai = 0; ai < 2; ++ai)
#pragma unroll
            for (int m = 0; m < 4; ++m) { const int row = row0 + ai * HALF + m * 16;
#pragma unroll
                for (int bj = 0; bj < 2; ++bj) {
                    bf16_t* dst = bj == 0 ? KC + (size_t)row * QCW + u.pn * CQK + cl : VC + (size_t)row * VCW + u.pn * 128 + cl;
                    *(u32x4*)dst = pack8(acc[ai][bj][m][0] * rs[ai][m], acc[ai][bj][m][1] * rs[ai][m]); } }
    }
};
struct EpiRes {
    static constexpr bool PERM = true, AFTER_DRAIN = false, INPLACE = true, B0ONLY = false;
    const bf16_t* base; bf16_t* out; float* ssq;
    __device__ __forceinline__ void operator()(const f32x4 (&acc)[2][2][4][2], const Unit& u, int wr, int wc, int fr, int fq) const {
        const int row0 = u.pm * BM + wr * 64 + fr, col0 = u.pn * BM + wc * 32 + 8 * fq;
#pragma unroll
        for (int ai = 0; ai < 2; ++ai) {
            u32x4 b[4][2];
#pragma unroll
            for (int m = 0; m < 4; ++m) { const size_t off = (size_t)(row0 + ai * HALF + m * 16) * DM + col0;
#pragma unroll
                for (int bj = 0; bj < 2; ++bj) b[m][bj] = *(const u32x4*)(base + off + bj * HALF); }
            asm volatile("" ::: "memory");
#pragma unroll
            for (int m = 0; m < 4; ++m) { const int row = row0 + ai * HALF + m * 16; const size_t off = (size_t)row * DM + col0;
                f32x4 q4 = {0.f, 0.f, 0.f, 0.f};
#pragma unroll
                for (int bj = 0; bj < 2; ++bj) { const u32x4 w = b[m][bj];
                    const f32x4 r0 = {__uint_as_float(w.x << 16), __uint_as_float(w.x & 0xffff0000u), __uint_as_float(w.y << 16), __uint_as_float(w.y & 0xffff0000u)};
                    const f32x4 r1 = {__uint_as_float(w.z << 16), __uint_as_float(w.z & 0xffff0000u), __uint_as_float(w.w << 16), __uint_as_float(w.w & 0xffff0000u)};
                    const f32x4 v0 = r0 + acc[ai][bj][m][0], v1 = r1 + acc[ai][bj][m][1];
                    q4 += v0 * v0; q4 += v1 * v1;
                    *(u32x4*)(out + off + bj * HALF) = pack8(v0, v1); }
                float q = (q4[0] + q4[1]) + (q4[2] + q4[3]);
                q = xsum_rows(q); if (fq == 0) ssq[(size_t)row * 64 + u.pn * 4 + wc] = q; }
            asm volatile("" ::: "memory"); }
    }
};
struct EpiSwiglu {
    static constexpr bool PERM = true, AFTER_DRAIN = false, INPLACE = false, B0ONLY = false;
    bf16_t* O; int ldc; const PG8_LAS float* tab; int tab_row0;
    __device__ __forceinline__ f32x4 sw4(const f32x4 g, const f32x4 u, float k1, float r2) const {
        f32x4 e = g * k1;
#pragma unroll
        for (int c = 0; c < 4; ++c) e[c] = __builtin_amdgcn_exp2f(e[c]);
        f32x4 d = e + 1.0f;
#pragma unroll
        for (int c = 0; c < 4; ++c) d[c] = __builtin_amdgcn_rcpf(d[c]);
        return ((g * u) * r2) * d;
    }
    __device__ __forceinline__ void operator()(const f32x4 (&acc)[2][2][4][2], const Unit& u, int wr, int wc, int fr, int fq) const {
        const int row0 = u.pm * BM + wr * 64 + fr, col0 = u.pn * HALF + wc * 32 + 8 * fq;
        float rs[2][4]; rows_rstd_tab(rs, tab, tab_row0, row0);
#pragma unroll
        for (int ai = 0; ai < 2; ++ai)
#pragma unroll
            for (int m = 0; m < 4; ++m) { const float r = rs[ai][m], r2 = r * r, k1 = -1.4426950408889634f * r;
                const f32x4 o0 = sw4(acc[ai][0][m][0], acc[ai][1][m][0], k1, r2), o1 = sw4(acc[ai][0][m][1], acc[ai][1][m][1], k1, r2);
                *(u32x4*)(O + (size_t)(row0 + ai * HALF + m * 16) * ldc + col0) = pack8(o0, o1); }
    }
};

template <class Epi, class Sched, bool ALIGN_EPI = false, bool SP2 = false>
__device__ __forceinline__ void gemm_phase(PG8_LAS unsigned char* lds, const Gemm g, const Sched& S, const Epi& E) {
    int tid_o = threadIdx.x; asm volatile("" : "+v"(tid_o));
    const int tid = tid_o, wid = __builtin_amdgcn_readfirstlane(tid >> 6), lane = tid & 63, wr = wid >> 2, wc = wid & 3, fr = lane & 15, fq = lane >> 4;
    const int K = g.K, nt = K / BK;
    unsigned voffA[2], voffB[2];
#pragma unroll
    for (int i = 0; i < 2; ++i) { int R, C; stage_rc(tid * 16 + i * 8192, R, C); const int Rb = Epi::PERM ? ((R & ~31) + perm32(R & 31)) : R;
        voffA[i] = (unsigned)(R * g.lda + C) * 2u; voffB[i] = (unsigned)(Rb * g.ldb + C) * 2u; }
    const size_t kstep = (size_t)(BK * 2);
    const size_t hstepA = (size_t)HALF * g.lda * 2, hstepB = (size_t)HALF * g.ldb * 2;
    const size_t tstepA = 2 * hstepA, tstepB = 2 * hstepB;
    const unsigned ldsw = (unsigned)wid * 1024u;
    const int aoff = lds_byte(wr * 64 + fr, fq * 8), boff = lds_byte(wc * 32 + fr, fq * 8);
#define PG8_SA(b, h) (((b) * 2 + (h)) * HTB)
#define PG8_SB(b, h) ((4 + (b) * 2 + (h)) * HTB)
#define PG8_STAGE(bufoff, gbase, voff) do { _Pragma("unroll") for (int _i = 0; _i < 2; ++_i) \
        __builtin_amdgcn_global_load_lds((const unsigned*)((const char*)(gbase) + (voff)[_i]), (PG8_LAS unsigned*)(lds + (bufoff) + ldsw + _i * 8192), 16, 0, 0); } while (0)
#define PG8_LDA(dst, b, h) do { _Pragma("unroll") for (int m = 0; m < 4; ++m) _Pragma("unroll") for (int k = 0; k < 2; ++k) dst[m][k] = *(const PG8_LAS bf16x8*)(lds + PG8_SA(b, h) + aoff + m * 2048 + k * 1024); } while (0)
#define PG8_LDB(dst, b, h) do { _Pragma("unroll") for (int n = 0; n < 2; ++n) _Pragma("unroll") for (int k = 0; k < 2; ++k) dst[n][k] = *(const PG8_LAS bf16x8*)(lds + PG8_SB(b, h) + boff + n * 2048 + k * 1024); } while (0)
#define PG8_MMA(ai, bj, At, Bt) do { __builtin_amdgcn_s_setprio(3); _Pragma("unroll") for (int m = 0; m < 4; ++m) _Pragma("unroll") for (int n = 0; n < 2; ++n) _Pragma("unroll") for (int k = 0; k < 2; ++k) \
        acc[ai][bj][m][n] = __builtin_amdgcn_mfma_f32_16x16x32_bf16(Bt[n][k], At[m][k], acc[ai][bj][m][n], 0, 0, 0); __builtin_amdgcn_s_setprio(0); } while (0)
#define PG8_WAIT_V(n) asm volatile("s_waitcnt vmcnt(" #n ")" ::: "memory")
#define PG8_WAIT_L(n) asm volatile("s_waitcnt lgkmcnt(" #n ")" ::: "memory")
#define PG8_BAR __builtin_amdgcn_s_barrier()
#define PG8_SCHED __builtin_amdgcn_sched_barrier(0)
    Unit cur, nxt; int ui = 0;
    if (!S.next(0, cur)) return;
    f32x4 acc[2][2][4][2];
#pragma unroll
    for (int a = 0; a < 2; ++a)
#pragma unroll
        for (int b = 0; b < 2; ++b)
#pragma unroll
            for (int m = 0; m < 4; ++m)
#pragma unroll
                for (int n = 0; n < 2; ++n) acc[a][b][m][n] = (f32x4){0.f, 0.f, 0.f, 0.f};
    bf16x8 At[4][2], B0[2][2], B1[2][2];
#define PG8_UA(u) ((const char*)g.A + (size_t)(u).pm * tstepA + (size_t)((u).pn / g.nNc) * g.ksplit_bytes)
#define PG8_UB(u) ((const char*)g.Bt + (size_t)((u).pn % g.nNc) * tstepB + (size_t)((u).pn / g.nNc) * g.ksplit_bytes)
    const char* cA = PG8_UA(cur); const char* cB = PG8_UB(cur);
    S.a_ready(cur);
    if constexpr (SP2) {
        PG8_STAGE(PG8_SB(0, 0), cB, voffB); PG8_STAGE(PG8_SB(0, 1), cB + hstepB, voffB); PG8_STAGE(PG8_SA(0, 0), cA, voffA); PG8_STAGE(PG8_SA(0, 1), cA + hstepA, voffA);
        if (wr == 1) PG8_BAR;
        PG8_WAIT_V(2); PG8_BAR;
        PG8_STAGE(PG8_SB(1, 0), cB + kstep, voffB); PG8_STAGE(PG8_SA(1, 0), cA + kstep, voffA); PG8_STAGE(PG8_SB(1, 1), cB + hstepB + kstep, voffB);
        PG8_WAIT_V(6); PG8_BAR;
    } else {
        PG8_STAGE(PG8_SB(0, 0), cB, voffB); PG8_STAGE(PG8_SA(0, 0), cA, voffA); PG8_STAGE(PG8_SB(0, 1), cB + hstepB, voffB); PG8_STAGE(PG8_SA(0, 1), cA + hstepA, voffA);
        if (wr == 1) PG8_BAR;
        PG8_WAIT_V(4); PG8_BAR;
        PG8_STAGE(PG8_SB(1, 0), cB + kstep, voffB); PG8_STAGE(PG8_SA(1, 0), cA + kstep, voffA); PG8_STAGE(PG8_SB(1, 1), cB + hstepB + kstep, voffB);
        PG8_WAIT_V(6); PG8_BAR;
    }
    for (;;) {
        const bool has_next = S.next(ui + 1, nxt);
        const char* nA = has_next ? PG8_UA(nxt) : cA; const char* nB = has_next ? PG8_UB(nxt) : cB;
        for (int t = 0; t < nt; t += 2) {
            const bool last = (t == nt - 2);
            const char* a1 = cA + (size_t)(t + 1) * kstep;
            const char* a2 = last ? nA : cA + (size_t)(t + 2) * kstep; const char* b2 = last ? nB : cB + (size_t)(t + 2) * kstep;
            const char* a3 = a2 + kstep; const char* b3 = b2 + kstep;
            if (last && has_next) S.a_ready(nxt);
            if constexpr (SP2) {
#define PG8_MM(ai) do { if constexpr (Epi::B0ONLY) { if (wc < 2) PG8_MMA(ai, 0, At, B0); } else { PG8_MMA(ai, 0, At, B0); PG8_MMA(ai, 1, At, B1); } } while (0)
#define PG8_LB1(b) do { if constexpr (!Epi::B0ONLY) PG8_LDB(B1, b, 1); } while (0)
#define PG8_LB0(b) do { if (!Epi::B0ONLY || wc < 2) PG8_LDB(B0, b, 0); } while (0)
#define PG8_LA(b, h) do { if (!Epi::B0ONLY || wc < 2) PG8_LDA(At, b, h); } while (0)
            PG8_LB0(0); PG8_LB1(0); PG8_SCHED; PG8_LA(0, 0); PG8_STAGE(PG8_SA(1, 1), a1 + hstepA, voffA);
            PG8_WAIT_V(8); PG8_WAIT_L(0); PG8_BAR; PG8_MM(0); PG8_BAR; PG8_SCHED;
            PG8_LA(0, 1); PG8_STAGE(PG8_SB(0, 0), b2, voffB); PG8_STAGE(PG8_SB(0, 1), b2 + hstepB, voffB); PG8_STAGE(PG8_SA(0, 0), a2, voffA);
            PG8_WAIT_V(8); PG8_WAIT_L(0); PG8_BAR; PG8_MM(1); PG8_BAR; PG8_SCHED;
            PG8_LB0(1); PG8_LB1(1); PG8_SCHED; PG8_LA(1, 0); PG8_STAGE(PG8_SA(0, 1), a2 + hstepA, voffA);
            PG8_WAIT_V(8); PG8_WAIT_L(0); PG8_BAR; PG8_MM(0); PG8_BAR; PG8_SCHED;
            PG8_LA(1, 1); PG8_STAGE(PG8_SB(1, 0), b3, voffB); PG8_STAGE(PG8_SB(1, 1), b3 + hstepB, voffB); PG8_STAGE(PG8_SA(1, 0), a3, voffA);
            PG8_WAIT_V(8); PG8_WAIT_L(0); PG8_BAR; PG8_MM(1); PG8_BAR; PG8_SCHED;
#undef PG8_MM
#undef PG8_LB1
#undef PG8_LB0
#undef PG8_LA
            } else {
            PG8_LDB(B0, 0, 0); PG8_SCHED; PG8_LDA(At, 0, 0); PG8_STAGE(PG8_SA(1, 1), a1 + hstepA, voffA);
            PG8_WAIT_L(8); PG8_BAR; PG8_WAIT_L(0); PG8_MMA(0, 0, At, B0); PG8_BAR; PG8_SCHED;
            PG8_LDB(B1, 0, 1); PG8_STAGE(PG8_SB(0, 0), b2, voffB);
            PG8_BAR; PG8_WAIT_L(0); PG8_MMA(0, 1, At, B1); PG8_BAR;
            PG8_LDA(At, 0, 1); PG8_STAGE(PG8_SA(0, 0), a2, voffA);
            PG8_BAR; PG8_WAIT_L(0); PG8_MMA(1, 0, At, B0); PG8_BAR; PG8_SCHED;
            PG8_STAGE(PG8_SB(0, 1), b2 + hstepB, voffB);
            PG8_WAIT_V(6); PG8_BAR; PG8_MMA(1, 1, At, B1); PG8_BAR;
            PG8_LDB(B0, 1, 0); PG8_SCHED; PG8_LDA(At, 1, 0); PG8_STAGE(PG8_SA(0, 1), a2 + hstepA, voffA);
            PG8_WAIT_L(8); PG8_BAR; PG8_WAIT_L(0); PG8_MMA(0, 0, At, B0); PG8_BAR; PG8_SCHED;
            PG8_LDB(B1, 1, 1); PG8_STAGE(PG8_SB(1, 0), b3, voffB);
            PG8_BAR; PG8_WAIT_L(0); PG8_MMA(0, 1, At, B1); PG8_BAR;
            PG8_LDA(At, 1, 1); PG8_STAGE(PG8_SA(1, 0), a3, voffA);
            PG8_BAR; PG8_WAIT_L(0); PG8_MMA(1, 0, At, B0); PG8_BAR; PG8_SCHED;
            PG8_STAGE(PG8_SB(1, 1), b3 + hstepB, voffB);
            PG8_WAIT_V(6); PG8_BAR; PG8_MMA(1, 1, At, B1); PG8_BAR;
            }
        }
        if constexpr (ALIGN_EPI) { if (wr == 0) PG8_BAR; }
#ifndef EPIX
#define EPIX 0
#endif
        if constexpr (!Epi::AFTER_DRAIN) { E(acc, cur, wr, wc, fr, fq); if constexpr (EPIX && !Epi::INPLACE) { asm volatile("" ::: "memory"); E(acc, cur, wr, wc, fr, fq); } S.done(cur); }
        if (!has_next) break;
#pragma unroll
        for (int a = 0; a < 2; ++a)
#pragma unroll
            for (int b = 0; b < 2; ++b)
#pragma unroll
                for (int m = 0; m < 4; ++m)
#pragma unroll
                    for (int n = 0; n < 2; ++n) acc[a][b][m][n] = (f32x4){0.f, 0.f, 0.f, 0.f};
        cur = nxt; cA = nA; cB = nB; ++ui;
        if constexpr (ALIGN_EPI) { if (wr == 1) PG8_BAR; }
    }
    PG8_WAIT_V(0);
    if constexpr (!ALIGN_EPI) { if (wr == 0) PG8_BAR; }
    PG8_BAR;
#undef PG8_UA
#undef PG8_UB
#undef PG8_SA
#undef PG8_SB
#undef PG8_STAGE
#undef PG8_LDA
#undef PG8_LDB
#undef PG8_MMA
#undef PG8_WAIT_V
#undef PG8_WAIT_L
#undef PG8_BAR
#undef PG8_SCHED
}
}

namespace att {
using bf16x8 = __attribute__((ext_vector_type(8))) short;
using s16x4 = __attribute__((ext_vector_type(4))) short;
using f32x16 = __attribute__((ext_vector_type(16))) float;
using u32x4 = __attribute__((ext_vector_type(4))) unsigned;
constexpr int NW = 8, QBLK = 32, KVBLK = 64;
constexpr float THR = 8.f;
constexpr int L_V = 0, SHM_V = 16384, L_K = 32768, SHM_KMAX = 24576, L_WS = 81920, L_TAB = 83968, L_QS = 86016, L_END = L_QS + 8 * 4096;
static_assert(L_END <= 131072, "attention LDS fits the ring region");
constexpr int OST_PITCH = 272, OST_WAVE = 32 * OST_PITCH;
static_assert(NW * OST_WAVE <= L_WS, "O staging fits under the scratch");
#define SBAR() __builtin_amdgcn_sched_barrier(0)
__device__ __forceinline__ int crow(int r, int hi) { return (r & 3) + 8 * (r >> 2) + 4 * hi; }
__device__ __forceinline__ unsigned cvtpk(float lo, float hi) { unsigned r; asm volatile("v_cvt_pk_bf16_f32 %0, %1, %2" : "=v"(r) : "v"(lo), "v"(hi)); return r; }

__device__ __forceinline__ void partialSM(f32x16& p0, f32x16& p1, float& m_reg, float& mn, float& alpha, const float C, const float thr_raw) {
  float pmax = p0[0];
#pragma unroll
  for (int r = 1; r < 16; ++r) pmax = fmaxf(pmax, p0[r]);
#pragma unroll
  for (int r = 0; r < 16; ++r) pmax = fmaxf(pmax, p1[r]);
  { auto rr = __builtin_amdgcn_permlane32_swap(__float_as_uint(pmax), __float_as_uint(pmax), false, false);
    pmax = fmaxf(__uint_as_float(rr[0]), __uint_as_float(rr[1])); }
  if (__builtin_expect(__all(pmax - m_reg <= thr_raw), 1)) { mn = m_reg; alpha = 1.f; }
  else { mn = fmaxf(m_reg, pmax); alpha = __builtin_amdgcn_exp2f((m_reg - mn) * C); m_reg = mn; }
  const float mnC = -mn * C;
#pragma unroll
  for (int r = 0; r < 16; ++r) p0[r] = fmaf(p0[r], C, mnC);
#pragma unroll
  for (int r = 0; r < 16; ++r) p1[r] = fmaf(p1[r], C, mnC);
#pragma unroll
  for (int r = 0; r < 16; ++r) p0[r] = __builtin_amdgcn_exp2f(p0[r]);
}
__device__ __forceinline__ void finishSM(f32x16& p0, f32x16& p1, float alpha, float& l_reg, bf16x8& pa0, bf16x8& pa1, bf16x8& pa2, bf16x8& pa3) {
#pragma unroll
  for (int r = 0; r < 16; ++r) p1[r] = __builtin_amdgcn_exp2f(p1[r]);
  float ps = 0;
#pragma unroll
  for (int r = 0; r < 16; ++r) ps += p0[r];
#pragma unroll
  for (int r = 0; r < 16; ++r) ps += p1[r];
  { auto rr = __builtin_amdgcn_permlane32_swap(__float_as_uint(ps), __float_as_uint(ps), false, false);
    ps = __uint_as_float(rr[0]) + __uint_as_float(rr[1]); }
  l_reg = l_reg * alpha + ps;
#define PK4(P, BASE, OUT) do { unsigned a0 = cvtpk(P[BASE + 0], P[BASE + 1]), a1 = cvtpk(P[BASE + 2], P[BASE + 3]);   \
    unsigned b0 = cvtpk(P[BASE + 4], P[BASE + 5]), b1 = cvtpk(P[BASE + 6], P[BASE + 7]);                              \
    auto r0 = __builtin_amdgcn_permlane32_swap(a0, b0, false, false); auto r1 = __builtin_amdgcn_permlane32_swap(a1, b1, false, false); \
    u32x4 w = {r0[0], r1[0], r0[1], r1[1]}; OUT = *reinterpret_cast<bf16x8*>(&w); } while (0)
  PK4(p0, 0, pa0); PK4(p0, 8, pa1); PK4(p1, 0, pa2); PK4(p1, 8, pa3);
#undef PK4
}
template <int DQK, int NQR> __device__ __forceinline__ void qkt(f32x16& p0, f32x16& p1, const char* Ks, const int (&kb)[4], const bf16x8* qr, const char* qs, int r32, int hi) {
  p0 = f32x16{}; p1 = f32x16{};
  constexpr int ROWB = DQK * 2;
#pragma unroll
  for (int d0 = 0; d0 < DQK / 16; ++d0) {
    bf16x8 b0 = *reinterpret_cast<const bf16x8*>(Ks + kb[d0 & 3] + (d0 >> 2) * 128);
    bf16x8 b1 = *reinterpret_cast<const bf16x8*>(Ks + kb[d0 & 3] + (d0 >> 2) * 128 + 32 * ROWB);
    bf16x8 qf; if (d0 < NQR) qf = qr[d0]; else qf = *reinterpret_cast<const bf16x8*>(qs + ((d0 - NQR) * 2 + hi) * 512 + r32 * 16);
    p0 = __builtin_amdgcn_mfma_f32_32x32x16_bf16(b0, qf, p0, 0, 0, 0);
    p1 = __builtin_amdgcn_mfma_f32_32x32x16_bf16(b1, qf, p1, 0, 0, 0); }
}
template <int DQK, int NQR> __device__ __forceinline__ void qkt_acc(f32x16& p0, f32x16& p1, const char* Ks, const int (&kb)[4], const bf16x8* qr, int r32, int hi) {
  constexpr int ROWB = DQK * 2; (void)r32; (void)hi;
#pragma unroll
  for (int d0 = 0; d0 < DQK / 16; ++d0) {
    bf16x8 b0 = *reinterpret_cast<const bf16x8*>(Ks + kb[d0 & 3] + (d0 >> 2) * 128);
    bf16x8 b1 = *reinterpret_cast<const bf16x8*>(Ks + kb[d0 & 3] + (d0 >> 2) * 128 + 32 * ROWB);
    p0 = __builtin_amdgcn_mfma_f32_32x32x16_bf16(b0, qr[d0], p0, 0, 0, 0);
    p1 = __builtin_amdgcn_mfma_f32_32x32x16_bf16(b1, qr[d0], p1, 0, 0, 0); }
}
__device__ __forceinline__ int v_st(int k, int c) { const int kk = (k & ~0xC) | ((k & 4) << 1) | ((k & 8) >> 1); return ((kk >> 3) * 4 + (c >> 5)) * 512 + ((kk & 7) * 32 + (c & 31)) * 2; }
__device__ __forceinline__ int v_rd_base(int lane) { return ((lane & 3) << 3) | (((lane >> 2) & 3) << 6) | (((lane >> 4) & 1) << 5) | (((lane >> 5) & 1) << 8); }
constexpr int v_rd_off(int d0, int ks, int half) { return d0 * 512 + ks * 4096 + half * 2048; }
template <int OFF> __device__ __forceinline__ s16x4 tr_read(int vb) {
  s16x4 r; asm volatile("ds_read_b64_tr_b16 %0, %1 offset:%2" : "=&v"(r) : "v"(vb), "i"(OFF) : "memory"); return r;
}
typedef short v4i16_t __attribute__((ext_vector_type(4)));
__device__ __forceinline__ s16x4 vtr(LAS const unsigned char* p) { return __builtin_bit_cast(s16x4, __builtin_amdgcn_ds_read_tr16_b64_v4i16((LAS v4i16_t*)p)); }
__device__ __forceinline__ void pv_d0v(f32x16* o, LAS const unsigned char* vp, bf16x8 pa0, bf16x8 pa1, bf16x8 pa2, bf16x8 pa3) {
#define PKV(L, H) (bf16x8){L[0], L[1], L[2], L[3], H[0], H[1], H[2], H[3]}
#pragma unroll
  for (int d0 = 0; d0 < 4; ++d0) {
    const s16x4 l0 = vtr(vp + v_rd_off(d0, 0, 0)), h0 = vtr(vp + v_rd_off(d0, 0, 1)), l1 = vtr(vp + v_rd_off(d0, 1, 0)), h1 = vtr(vp + v_rd_off(d0, 1, 1));
    const s16x4 l2 = vtr(vp + v_rd_off(d0, 2, 0)), h2 = vtr(vp + v_rd_off(d0, 2, 1)), l3 = vtr(vp + v_rd_off(d0, 3, 0)), h3 = vtr(vp + v_rd_off(d0, 3, 1));
    o[d0] = __builtin_amdgcn_mfma_f32_32x32x16_bf16(pa0, PKV(l0, h0), o[d0], 0, 0, 0);
    o[d0] = __builtin_amdgcn_mfma_f32_32x32x16_bf16(pa1, PKV(l1, h1), o[d0], 0, 0, 0);
    o[d0] = __builtin_amdgcn_mfma_f32_32x32x16_bf16(pa2, PKV(l2, h2), o[d0], 0, 0, 0);
    o[d0] = __builtin_amdgcn_mfma_f32_32x32x16_bf16(pa3, PKV(l3, h3), o[d0], 0, 0, 0); }
#undef PKV
}
template <int D0> __device__ __forceinline__ void pv_one(f32x16& od, int vb, bf16x8 pa0, bf16x8 pa1, bf16x8 pa2, bf16x8 pa3) {
  const s16x4 l0 = tr_read<v_rd_off(D0, 0, 0)>(vb), h0 = tr_read<v_rd_off(D0, 0, 1)>(vb), l1 = tr_read<v_rd_off(D0, 1, 0)>(vb), h1 = tr_read<v_rd_off(D0, 1, 1)>(vb);
  const s16x4 l2 = tr_read<v_rd_off(D0, 2, 0)>(vb), h2 = tr_read<v_rd_off(D0, 2, 1)>(vb), l3 = tr_read<v_rd_off(D0, 3, 0)>(vb), h3 = tr_read<v_rd_off(D0, 3, 1)>(vb);
  asm volatile("s_waitcnt lgkmcnt(0)" ::: "memory"); SBAR();
#define PK(L, H) (bf16x8){L[0], L[1], L[2], L[3], H[0], H[1], H[2], H[3]}
  od = __builtin_amdgcn_mfma_f32_32x32x16_bf16(pa0, PK(l0, h0), od, 0, 0, 0);
  od = __builtin_amdgcn_mfma_f32_32x32x16_bf16(pa1, PK(l1, h1), od, 0, 0, 0);
  od = __builtin_amdgcn_mfma_f32_32x32x16_bf16(pa2, PK(l2, h2), od, 0, 0, 0);
  od = __builtin_amdgcn_mfma_f32_32x32x16_bf16(pa3, PK(l3, h3), od, 0, 0, 0);
#undef PK
}
__device__ __forceinline__ void pv_d0(f32x16* o, int vb, bf16x8 pa0, bf16x8 pa1, bf16x8 pa2, bf16x8 pa3) {
  pv_one<0>(o[0], vb, pa0, pa1, pa2, pa3); pv_one<1>(o[1], vb, pa0, pa1, pa2, pa3); pv_one<2>(o[2], vb, pa0, pa1, pa2, pa3); pv_one<3>(o[3], vb, pa0, pa1, pa2, pa3);
}

struct MaskNone { __device__ __forceinline__ void apply(f32x16&, f32x16&, int, int) const {} __device__ __forceinline__ bool active(int, int) const { return true; } };
struct MaskA {
  int qoff, lo, hi_; float sl;
  __device__ __forceinline__ bool active(int t, int w) const { return 64 * t + 63 >= 32 * w && 64 * t <= 32 * w + 287; }
  __device__ __forceinline__ void apply(f32x16& p0, f32x16& p1, int kt, int hi) const {
    int base = qoff + 64 * kt + 4 * hi; asm volatile("" : "+v"(base));
    const float bf = (float)base, bm = bf - 0.5f * (float)(lo + hi_), hw = 0.5f * (float)(hi_ - lo);
#pragma unroll
    for (int r = 0; r < 16; ++r) { const float c0 = (float)((r & 3) + 8 * (r >> 2)), c1 = c0 + 32.f;
      const float v0 = __builtin_fmaf(-sl, __builtin_fabsf(bf + c0), p0[r]), v1 = __builtin_fmaf(-sl, __builtin_fabsf(bf + c1), p1[r]);
      p0[r] = __builtin_fabsf(bm + c0) <= hw ? v0 : -1e30f; p1[r] = __builtin_fabsf(bm + c1) <= hw ? v1 : -1e30f; }
  }
};
struct MaskB {
  int qr, qc, kr0, rs, cs; const float* tab;
  __device__ __forceinline__ bool active(int t, int) const { const int kr = kr0 + t; return __builtin_amdgcn_readfirstlane((int)(kr >= rs && kr <= rs + 7)) != 0; }
  __device__ __forceinline__ void apply(f32x16& p0, f32x16& p1, int kt, int hi) const {
    const int dr = kr0 + kt - qr + 7;
    int dbase = 4 * hi - qc + 15; asm volatile("" : "+v"(dbase));
    int cb = 4 * hi - cs; asm volatile("" : "+v"(cb));
    const float* tp = tab + dr * 31 + dbase;
    float t0[16], t1[16];
#pragma unroll
    for (int r = 0; r < 16; ++r) { const int c = (r & 3) + 8 * (r >> 2); t0[r] = tp[c]; t1[r] = tp[c + 32]; }
#pragma unroll
    for (int r = 0; r < 16; ++r) asm volatile("" : "+v"(t0[r]), "+v"(t1[r]));
#pragma unroll
    for (int r = 0; r < 16; ++r) { const int c = (r & 3) + 8 * (r >> 2);
      p0[r] = (unsigned)(cb + c) < 16u ? p0[r] + t0[r] : -1e30f; p1[r] = (unsigned)(cb + c + 32) < 16u ? p1[r] + t1[r] : -1e30f; }
  }
};

template <int DQK, class MK>
__device__ __forceinline__ void attn_unit(const bf16_t* __restrict__ Q, long q_row0, int ldq, const bf16_t* __restrict__ K, int ldk, const bf16_t* __restrict__ V, int ldv,
                                          long k_row0, long kmin, long kmax, int NT, bf16_t* __restrict__ O, int ldo, const float Cs, const float m0, const float l0, const MK& mk, char* lds) {
  int tid_o = threadIdx.x; asm volatile("" : "+v"(tid_o));
  const int tid = tid_o, wid = tid >> 6, lane = tid & 63, r32 = lane & 31, hi = lane >> 5;
  constexpr int ROWB = DQK * 2, SHM_K = 64 * ROWB, KN = DQK / 64, CPR = DQK / 8;
  char* V_lds = lds + L_V; char* K_lds = lds + L_K;
  float* ws = (float*)(lds + L_WS) + wid * 64; float* li_l = ws; float* al_l = ws + 32;
  const float thr_raw = THR / (Cs * 0.6931471805599453f);
  constexpr int NQR = DQK / 16;
  float m_reg = m0, l_reg = l0; f32x16 o[4] = {}; bf16x8 qr[NQR];
  char* qs = lds + L_QS + wid * 4096;
  const bf16_t* Qw = Q + (q_row0 + wid * QBLK + r32) * ldq + hi * 8;
#pragma unroll
  for (int d0 = 0; d0 < NQR; ++d0) qr[d0] = *reinterpret_cast<const bf16x8*>(Qw + d0 * 16);
  if constexpr (NQR < DQK / 16) {
#pragma unroll
    for (int d0 = NQR; d0 < DQK / 16; ++d0) *reinterpret_cast<bf16x8*>(qs + ((d0 - NQR) * 2 + hi) * 512 + r32 * 16) = *reinterpret_cast<const bf16x8*>(Qw + d0 * 16);
  }
  const int sr = tid >> 4, sc = (tid & 15) * 8, vst0 = v_st(sr, sc), vst1 = v_st(32 + sr, sc);
  const int voff0 = sr * ldv + sc, voff1 = (32 + sr) * ldv + sc;
  int koff[KN], kst[KN];
#pragma unroll
  for (int i = 0; i < KN; ++i) { const int id = tid + 512 * i, kr = id / CPR, kc = (id % CPR) * 8; koff[i] = kr * ldk + kc; kst[i] = kr * ROWB + ((kc * 2) ^ ((kr & 7) << 4)); }
  const int vb0 = (int)(uintptr_t)V_lds + v_rd_base(lane);
  int kb[4];
#pragma unroll
  for (int e = 0; e < 4; ++e) { kb[e] = r32 * ROWB + ((e * 32 + hi * 16) ^ ((r32 & 7) << 4)); asm volatile("" : "+v"(kb[e])); }
  bf16x8 vs0, vs1, ks[KN];
#define SLOAD(t) do { long _r0 = k_row0 + (long)(t) * KVBLK; _r0 = _r0 < kmin ? kmin : (_r0 > kmax - 63 ? kmax - 63 : _r0); \
    const bf16_t* _Vt = V + _r0 * ldv; const bf16_t* _Kt = K + _r0 * ldk; \
    vs0 = *reinterpret_cast<const bf16x8*>(_Vt + voff0); vs1 = *reinterpret_cast<const bf16x8*>(_Vt + voff1); \
    _Pragma("unroll") for (int _k = 0; _k < KN; ++_k) ks[_k] = *reinterpret_cast<const bf16x8*>(_Kt + koff[_k]); } while (0)
#define SWRITE(b) do { *(bf16x8*)(V_lds + (b) * SHM_V + vst0) = vs0; *(bf16x8*)(V_lds + (b) * SHM_V + vst1) = vs1; \
    _Pragma("unroll") for (int _k = 0; _k < KN; ++_k) *(bf16x8*)(K_lds + (b) * SHM_K + kst[_k]) = ks[_k]; } while (0)
  SLOAD(0); SWRITE(0); __syncthreads();
  for (int t = 0; t < NT; ++t) {
    const int cb = t & 1;
    if (t + 1 < NT) SLOAD(t + 1);
    if (mk.active(t, __builtin_amdgcn_readfirstlane(wid))) {
    f32x16 p0, p1;
    qkt<DQK, NQR>(p0, p1, K_lds + cb * SHM_K, kb, qr, qs, r32, hi);
    mk.apply(p0, p1, t, hi);
    float pmax = p0[0];
#pragma unroll
    for (int r = 1; r < 16; ++r) pmax = fmaxf(pmax, p0[r]);
#pragma unroll
    for (int r = 0; r < 16; ++r) pmax = fmaxf(pmax, p1[r]);
    { auto rr = __builtin_amdgcn_permlane32_swap(__float_as_uint(pmax), __float_as_uint(pmax), false, false);
      pmax = fmaxf(__uint_as_float(rr[0]), __uint_as_float(rr[1])); }
    if (!__all(pmax - m_reg <= thr_raw)) {
      const float mn = fmaxf(m_reg, pmax); const float alpha = __builtin_amdgcn_exp2f((m_reg - mn) * Cs); m_reg = mn; l_reg *= alpha;
      if (hi == 0) al_l[r32] = alpha; asm volatile("s_waitcnt lgkmcnt(0)" ::: "memory");
#pragma unroll
      for (int d = 0; d < 4; ++d)
#pragma unroll
        for (int r = 0; r < 16; ++r) o[d][r] *= al_l[crow(r, hi)];
    }
    const float mnC = -m_reg * Cs;
#pragma unroll
    for (int r = 0; r < 16; ++r) { p0[r] = __builtin_amdgcn_exp2f(fmaf(p0[r], Cs, mnC)); p1[r] = __builtin_amdgcn_exp2f(fmaf(p1[r], Cs, mnC)); }
    float ps = 0;
#pragma unroll
    for (int r = 0; r < 16; ++r) ps += p0[r] + p1[r];
    { auto rr = __builtin_amdgcn_permlane32_swap(__float_as_uint(ps), __float_as_uint(ps), false, false);
      ps = __uint_as_float(rr[0]) + __uint_as_float(rr[1]); }
    l_reg += ps;
    bf16x8 pa0, pa1, pa2, pa3;
#define PK4(P, BASE, OUT) do { unsigned a0 = cvtpk(P[BASE + 0], P[BASE + 1]), a1 = cvtpk(P[BASE + 2], P[BASE + 3]);   \
    unsigned b0 = cvtpk(P[BASE + 4], P[BASE + 5]), b1 = cvtpk(P[BASE + 6], P[BASE + 7]);                              \
    auto r0 = __builtin_amdgcn_permlane32_swap(a0, b0, false, false); auto r1 = __builtin_amdgcn_permlane32_swap(a1, b1, false, false); \
    u32x4 w = {r0[0], r1[0], r0[1], r1[1]}; OUT = *reinterpret_cast<bf16x8*>(&w); } while (0)
    PK4(p0, 0, pa0); PK4(p0, 8, pa1); PK4(p1, 0, pa2); PK4(p1, 8, pa3);
#undef PK4
    pv_d0(o, vb0 + cb * SHM_V, pa0, pa1, pa2, pa3);
    }
    if (t + 1 < NT) SWRITE(cb ^ 1);
    __syncthreads();
  }
  if (hi == 0) li_l[r32] = l_reg; asm volatile("s_waitcnt lgkmcnt(0)" ::: "memory");
  float rli[16];
#pragma unroll
  for (int r = 0; r < 16; ++r) rli[r] = __builtin_amdgcn_rcpf(li_l[crow(r, hi)]);
  char* ost = lds + wid * OST_WAVE;
  const bool odd = lane & 1;
#pragma unroll
  for (int d0 = 0; d0 < 4; ++d0)
#pragma unroll
    for (int r = 0; r < 16; r += 2) {
      const float a = o[d0][r] * rli[r], b = o[d0][r + 1] * rli[r + 1];
      const float snd = odd ? a : b; const float rcv = __builtin_bit_cast(float, __builtin_amdgcn_mov_dpp(__builtin_bit_cast(int, snd), 0xB1, 0xF, 0xF, true));
      const float wlo = odd ? rcv : a, whi = odd ? b : rcv;
      const unsigned w = cvtpk(wlo, whi);
      const int row = crow(r, hi) + (odd ? 1 : 0), col = d0 * 32 + (r32 & ~1);
      *(unsigned*)(ost + row * OST_PITCH + col * 2) = w; }
  asm volatile("s_waitcnt lgkmcnt(0)" ::: "memory");
  bf16_t* Ow = O + (q_row0 + wid * QBLK) * ldo;
#pragma unroll
  for (int it = 0; it < 8; ++it) { const int id = it * 64 + lane, row = id >> 4, c16 = id & 15;
    const u32x4 v = *(const u32x4*)(ost + row * OST_PITCH + c16 * 16);
    *(u32x4*)(Ow + (long)row * ldo + c16 * 8) = v; }
  __syncthreads();
#undef SLOAD
#undef SWRITE
}

__device__ __forceinline__ void glds16_asm(const void* gsrc, unsigned lds_dst) { unsigned keep;
  asm volatile("s_mov_b32 %0, m0\n\ts_mov_b32 m0, %2\n\ts_nop 0\n\tglobal_load_lds_dwordx4 %1, off\n\ts_mov_b32 m0, %0" : "=&s"(keep) : "v"(gsrc), "s"(lds_dst) : "memory"); }
template <int DQK, class MK>
__device__ __forceinline__ void attn_unit_dma(const bf16_t* __restrict__ Q, long q_row0, int ldq, const bf16_t* __restrict__ K, int ldk, const bf16_t* __restrict__ V, int ldv,
                                              long k_row0, long kmin, long kmax, int NT, bf16_t* __restrict__ O, int ldo, const float Cs, const float m0, const float l0, const MK& mk, char* lds, LAS unsigned char* ldsl) {
  int tid_o = threadIdx.x; asm volatile("" : "+v"(tid_o));
  const int tid = tid_o, wid = tid >> 6, lane = tid & 63, r32 = lane & 31, hi = lane >> 5;
  const int widu = __builtin_amdgcn_readfirstlane(wid);
  constexpr int ROWB = DQK * 2, SHM_K = 64 * ROWB, KN = SHM_K / 8192, CPR = DQK / 8;
  constexpr int D_V = 0, D_K = 3 * SHM_V, D_WS = 122880;
  static_assert(D_K + 3 * SHM_K <= D_WS, "rings fit");
  char* V_lds = lds + D_V; char* K_lds = lds + D_K; const unsigned lds0 = (unsigned)(uintptr_t)ldsl;
  float* ws = (float*)(lds + D_WS) + wid * 64; float* li_l = ws; float* al_l = ws + 32;
  const float thr_raw = THR / (Cs * 0.6931471805599453f);
  constexpr int NQR = DQK / 16;
  float m_reg = m0, l_reg = l0; f32x16 o[4] = {}; bf16x8 qr[NQR];
  int ksrc[KN], vsrc[2];
#pragma unroll
  for (int i = 0; i < KN; ++i) { const int c = (wid * KN + i) * 64 + lane, row = c / CPR, ccd = c % CPR, cc = (ccd & ~7) | ((ccd & 7) ^ (row & 7)); ksrc[i] = row * ldk + cc * 8; }
#pragma unroll
  for (int i = 0; i < 2; ++i) { const int ci = (wid * 2 + i) * 64 + lane, sub = ci >> 5, within = ci & 31, kk = (sub >> 2) * 8 + (within >> 2), k = (kk & ~0xC) | ((kk & 4) << 1) | ((kk & 8) >> 1), c = (sub & 3) * 32 + (within & 3) * 8;
    vsrc[i] = k * ldv + c; }
#define DMA(t, b) do { long _r0 = k_row0 + (long)(t) * KVBLK; _r0 = _r0 < kmin ? kmin : (_r0 > kmax - 63 ? kmax - 63 : _r0); \
    const bf16_t* _Vt = V + _r0 * ldv; const bf16_t* _Kt = K + _r0 * ldk; \
    _Pragma("unroll") for (int _k = 0; _k < KN; ++_k) glds16_asm(_Kt + ksrc[_k], (unsigned)__builtin_amdgcn_readfirstlane((int)(lds0 + D_K + (b) * SHM_K + (widu * KN + _k) * 1024))); \
    _Pragma("unroll") for (int _k = 0; _k < 2; ++_k) glds16_asm(_Vt + vsrc[_k], (unsigned)__builtin_amdgcn_readfirstlane((int)(lds0 + D_V + (b) * SHM_V + (widu * 2 + _k) * 1024))); } while (0)
  DMA(0, 0); DMA(1, 1);
  const bf16_t* Qw = Q + (q_row0 + wid * QBLK + r32) * ldq + hi * 8;
#pragma unroll
  for (int d0 = 0; d0 < NQR; ++d0) qr[d0] = *reinterpret_cast<const bf16x8*>(Qw + d0 * 16);
  LAS const unsigned char* vpl = ldsl + D_V + v_rd_base(lane);
  int kb[4];
#pragma unroll
  for (int e = 0; e < 4; ++e) { kb[e] = r32 * ROWB + ((e * 32 + hi * 16) ^ ((r32 & 7) << 4)); asm volatile("" : "+v"(kb[e])); }
#pragma unroll
  for (int d0 = 0; d0 < NQR; ++d0) asm volatile("" : "+v"(qr[d0]));
  asm volatile("s_waitcnt vmcnt(0) lgkmcnt(0)" ::: "memory"); __builtin_amdgcn_s_barrier(); asm volatile("" ::: "memory");
  if (widu >= 4) __builtin_amdgcn_s_setprio(1);
  int cb = 0;
  for (int t = 0; t < NT; ++t) {
    const bool more = t + 2 < NT; int nb = cb + 2; nb = nb >= 3 ? nb - 3 : nb;
    if (more) DMA(t + 2, nb);
    if (mk.active(t, widu)) {
    f32x16 p0, p1;
    qkt<DQK, NQR>(p0, p1, K_lds + cb * SHM_K, kb, qr, nullptr, r32, hi);
    mk.apply(p0, p1, t, hi);
    float pmax = p0[0];
#pragma unroll
    for (int r = 1; r < 16; ++r) pmax = fmaxf(pmax, p0[r]);
#pragma unroll
    for (int r = 0; r < 16; ++r) pmax = fmaxf(pmax, p1[r]);
    { auto rr = __builtin_amdgcn_permlane32_swap(__float_as_uint(pmax), __float_as_uint(pmax), false, false);
      pmax = fmaxf(__uint_as_float(rr[0]), __uint_as_float(rr[1])); }
    if (!__all(pmax - m_reg <= thr_raw)) {
      const float mn = fmaxf(m_reg, pmax); const float alpha = __builtin_amdgcn_exp2f((m_reg - mn) * Cs); m_reg = mn; l_reg *= alpha;
      if (hi == 0) al_l[r32] = alpha; asm volatile("s_waitcnt lgkmcnt(0)" ::: "memory");
#pragma unroll
      for (int d = 0; d < 4; ++d)
#pragma unroll
        for (int r = 0; r < 16; ++r) o[d][r] *= al_l[crow(r, hi)];
    }
    const float mnC = -m_reg * Cs;
#pragma unroll
    for (int r = 0; r < 16; ++r) { p0[r] = __builtin_amdgcn_exp2f(fmaf(p0[r], Cs, mnC)); p1[r] = __builtin_amdgcn_exp2f(fmaf(p1[r], Cs, mnC)); }
    float ps = 0;
#pragma unroll
    for (int r = 0; r < 16; ++r) ps += p0[r] + p1[r];
    { auto rr = __builtin_amdgcn_permlane32_swap(__float_as_uint(ps), __float_as_uint(ps), false, false);
      ps = __uint_as_float(rr[0]) + __uint_as_float(rr[1]); }
    l_reg += ps;
    bf16x8 pa0, pa1, pa2, pa3;
#define PK4(P, BASE, OUT) do { unsigned a0 = cvtpk(P[BASE + 0], P[BASE + 1]), a1 = cvtpk(P[BASE + 2], P[BASE + 3]);   \
    unsigned b0 = cvtpk(P[BASE + 4], P[BASE + 5]), b1 = cvtpk(P[BASE + 6], P[BASE + 7]);                              \
    auto r0 = __builtin_amdgcn_permlane32_swap(a0, b0, false, false); auto r1 = __builtin_amdgcn_permlane32_swap(a1, b1, false, false); \
    u32x4 w = {r0[0], r1[0], r0[1], r1[1]}; OUT = *reinterpret_cast<bf16x8*>(&w); } while (0)
    PK4(p0, 0, pa0); PK4(p0, 8, pa1); PK4(p1, 0, pa2); PK4(p1, 8, pa3);
#undef PK4
    pv_d0v(o, vpl + cb * SHM_V, pa0, pa1, pa2, pa3);
    }
    if (more) { if constexpr (KN == 3) asm volatile("s_waitcnt vmcnt(5)" ::: "memory"); else asm volatile("s_waitcnt vmcnt(4)" ::: "memory"); }
    else asm volatile("s_waitcnt vmcnt(0)" ::: "memory");
    asm volatile("s_waitcnt lgkmcnt(0)" ::: "memory"); __builtin_amdgcn_s_barrier(); asm volatile("" ::: "memory");
    cb = cb == 2 ? 0 : cb + 1;
  }
  __builtin_amdgcn_s_setprio(0);
  if (hi == 0) li_l[r32] = l_reg; asm volatile("s_waitcnt lgkmcnt(0)" ::: "memory");
  float rli[16];
#pragma unroll
  for (int r = 0; r < 16; ++r) rli[r] = __builtin_amdgcn_rcpf(li_l[crow(r, hi)]);
  char* ost = lds + wid * OST_WAVE;
  const bool odd = lane & 1;
#pragma unroll
  for (int d0 = 0; d0 < 4; ++d0)
#pragma unroll
    for (int r = 0; r < 16; r += 2) {
      const float a = o[d0][r] * rli[r], b = o[d0][r + 1] * rli[r + 1];
      const float snd = odd ? a : b; const float rcv = __builtin_bit_cast(float, __builtin_amdgcn_mov_dpp(__builtin_bit_cast(int, snd), 0xB1, 0xF, 0xF, true));
      const float wlo = odd ? rcv : a, whi = odd ? b : rcv;
      const unsigned w = cvtpk(wlo, whi);
      const int row = crow(r, hi) + (odd ? 1 : 0), col = d0 * 32 + (r32 & ~1);
      *(unsigned*)(ost + row * OST_PITCH + col * 2) = w; }
  asm volatile("s_waitcnt lgkmcnt(0)" ::: "memory");
  bf16_t* Ow = O + (q_row0 + wid * QBLK) * ldo;
#pragma unroll
  for (int it = 0; it < 8; ++it) { const int id = it * 64 + lane, row = id >> 4, c16 = id & 15;
    const u32x4 v = *(const u32x4*)(ost + row * OST_PITCH + c16 * 16);
    *(u32x4*)(Ow + (long)row * ldo + c16 * 8) = v; }
  asm volatile("s_waitcnt lgkmcnt(0)" ::: "memory"); __builtin_amdgcn_s_barrier(); asm volatile("" ::: "memory");
#undef DMA
}

typedef __bf16 bf16x2_t __attribute__((ext_vector_type(2)));
typedef float f32x2_t __attribute__((ext_vector_type(2)));
__device__ __forceinline__ unsigned cvtpk_v(float lo, float hi) { f32x2_t v = {lo, hi}; bf16x2_t b = __builtin_convertvector(v, bf16x2_t); return __builtin_bit_cast(unsigned, b); }
#define PINV(x) asm volatile("" : "+v"(x))
#define MX3(a, b, c) __builtin_fmaxf(__builtin_fmaxf((a), (b)), (c))
template <int DQK, class MK>
__device__ __forceinline__ void attn_unit_c(const bf16_t* __restrict__ Q, long q_row0, int ldq, const bf16_t* __restrict__ K, int ldk, const bf16_t* __restrict__ V, int ldv,
                                              long k_row0, long kmin, long kmax, int NT, bf16_t* __restrict__ O, int ldo, const float Cs, const float m0, const float l0, const MK& mk, char* lds, LAS unsigned char* ldsl) {
  int tid_o = threadIdx.x; asm volatile("" : "+v"(tid_o));
  const int tid = tid_o, wid = tid >> 6, lane = tid & 63, r32 = lane & 31, hi = lane >> 5;
  const int widu = __builtin_amdgcn_readfirstlane(wid);
  constexpr int ROWB = DQK * 2, SHM_K = 64 * ROWB, KN = SHM_K / 8192, CPR = DQK / 8;
  constexpr int D_V = 0, D_K = 3 * SHM_V, D_WS = 122880;
  static_assert(D_K + 3 * SHM_K <= D_WS, "rings fit"); static_assert(DQK == 192, "the gap schedule below is written for 12 Q fragments");
  char* K_lds = lds + D_K; const unsigned lds0 = (unsigned)(uintptr_t)ldsl;
  float* ws = (float*)(lds + D_WS) + wid * 64; float* li_l = ws; float* al_l = ws + 32;
  constexpr int NQR = DQK / 16;
  (void)m0; (void)l0; (void)Cs; (void)mk; float m_reg = 0.f, l_reg = 0.f; f32x16 o[4] = {}; f32x16 negm = {}; bf16x8 qr[NQR];
  const float thr2 = THR * 1.4426950408889634f;
  int ksrc[KN], vsrc[2];
#pragma unroll
  for (int i = 0; i < KN; ++i) { const int c = (wid * KN + i) * 64 + lane, row = c / CPR, ccd = c % CPR, cc = (ccd & ~7) | ((ccd & 7) ^ (row & 7)); ksrc[i] = row * ldk + cc * 8; }
#pragma unroll
  for (int i = 0; i < 2; ++i) { const int ci = (wid * 2 + i) * 64 + lane, sub = ci >> 5, within = ci & 31, kk = (sub >> 2) * 8 + (within >> 2), k = (kk & ~0xC) | ((kk & 4) << 1) | ((kk & 8) >> 1), c = (sub & 3) * 32 + (within & 3) * 8;
    vsrc[i] = k * ldv + c; }
#define DMA(t, b) do { long _r0 = k_row0 + (long)(t) * KVBLK; _r0 = _r0 < kmin ? kmin : (_r0 > kmax - 63 ? kmax - 63 : _r0); \
    const bf16_t* _Vt = V + _r0 * ldv; const bf16_t* _Kt = K + _r0 * ldk; \
    _Pragma("unroll") for (int _k = 0; _k < KN; ++_k) glds16_asm(_Kt + ksrc[_k], (unsigned)__builtin_amdgcn_readfirstlane((int)(lds0 + D_K + (b) * SHM_K + (widu * KN + _k) * 1024))); \
    _Pragma("unroll") for (int _k = 0; _k < 2; ++_k) glds16_asm(_Vt + vsrc[_k], (unsigned)__builtin_amdgcn_readfirstlane((int)(lds0 + D_V + (b) * SHM_V + (widu * 2 + _k) * 1024))); } while (0)
  DMA(0, 0); DMA(1, 1);
  const bf16_t* Qw = Q + (q_row0 + wid * QBLK + r32) * ldq + hi * 8;
#pragma unroll
  for (int d0 = 0; d0 < NQR; ++d0) qr[d0] = *reinterpret_cast<const bf16x8*>(Qw + d0 * 16);
  LAS const unsigned char* vp0 = ldsl + D_V + v_rd_base(lane);
  int kb[4];
#pragma unroll
  for (int e = 0; e < 4; ++e) { kb[e] = r32 * ROWB + ((e * 32 + hi * 16) ^ ((r32 & 7) << 4)); asm volatile("" : "+v"(kb[e])); }
#pragma unroll
  for (int d0 = 0; d0 < NQR; ++d0) asm volatile("" : "+v"(qr[d0]));
  asm volatile("s_waitcnt vmcnt(0) lgkmcnt(0)" ::: "memory"); __builtin_amdgcn_s_barrier(); asm volatile("" ::: "memory");
#define MF(a, b, c) __builtin_amdgcn_mfma_f32_32x32x16_bf16(a, b, c, 0, 0, 0)
#define KFR(i) (*reinterpret_cast<const bf16x8*>(Kc + kb[((i) % 12) & 3] + (((i) % 12) >> 2) * 128 + ((i) >= 12 ? 32 * ROWB : 0)))
#define KFRN(i) (*reinterpret_cast<const bf16x8*>(Kn + kb[(i) & 3]))
#define GQ(i, CH, CIN, FILL) do { if ((i) + 3 < 24) kf[((i) + 3) & 3] = KFR((i) + 3); CH = MF(kf[(i) & 3], qr[(i) % 12], CIN); FILL; SBAR(); } while (0)
#define VFR(s) (bf16x8){vl[s][0], vl[s][1], vl[s][2], vl[s][3], vh[s][0], vh[s][1], vh[s][2], vh[s][3]}
#define VRD(j) do { vl[(j) % 3] = vtr(vpc + v_rd_off((j) & 3, (j) >> 2, 0)); vh[(j) % 3] = vtr(vpc + v_rd_off((j) & 3, (j) >> 2, 1)); } while (0)
#define GP(j, PA, FILL) do { if ((j) + 2 < 16) VRD((j) + 2); o[(j) & 3] = MF(PA, VFR((j) % 3), o[(j) & 3]); FILL; SBAR(); } while (0)
#define EX2(x) __builtin_amdgcn_exp2f(x)
#define PREP(P, B, W) do { P[B] = EX2(P[B]); P[(B) + 1] = EX2(P[(B) + 1]); rs += P[B]; rs += P[(B) + 1]; W = cvtpk_v(P[B], P[(B) + 1]); PINV(rs); PINV(W); } while (0)
#define PKSW(OUT) do { auto r0_ = __builtin_amdgcn_permlane32_swap(wa0, wb0, false, false); auto r1_ = __builtin_amdgcn_permlane32_swap(wa1, wb1, false, false); \
    u32x4 w_ = {r0_[0], r1_[0], r0_[1], r1_[1]}; OUT = *reinterpret_cast<bf16x8*>(&w_); PINV(OUT); } while (0)
  if (widu >= 4) __builtin_amdgcn_s_setprio(1);
  int cb = 0;
  bf16x8 kf[4];
  { const char* Kc = K_lds; kf[0] = KFR(0); kf[1] = KFR(1); kf[2] = KFR(2); }
  for (int t = 0; t < NT; ++t) {
    const bool more = t + 2 < NT; int nb = cb + 2; nb = nb >= 3 ? nb - 3 : nb; int n1 = cb + 1; n1 = n1 >= 3 ? n1 - 3 : n1;
    if (more) DMA(t + 2, nb);
    const char* Kc = K_lds + cb * SHM_K; const char* Kn = K_lds + n1 * SHM_K; LAS const unsigned char* vpc = vp0 + cb * SHM_V;
    f32x16 p0, p1; s16x4 vl[3], vh[3]; float mx;
    SBAR();
    GQ(0, p0, negm, ); GQ(1, p0, p0, ); GQ(2, p0, p0, ); GQ(3, p0, p0, ); GQ(4, p0, p0, ); GQ(5, p0, p0, );
    GQ(6, p0, p0, ); GQ(7, p0, p0, ); GQ(8, p0, p0, ); GQ(9, p0, p0, ); GQ(10, p0, p0, ); GQ(11, p0, p0, );
    GQ(12, p1, negm, );
    GQ(13, p1, p1, mx = MX3(p0[0], p0[1], p0[2]); PINV(mx));
    GQ(14, p1, p1, mx = MX3(mx, p0[3], p0[4]); PINV(mx));   GQ(15, p1, p1, mx = MX3(mx, p0[5], p0[6]); PINV(mx));
    GQ(16, p1, p1, mx = MX3(mx, p0[7], p0[8]); PINV(mx));   GQ(17, p1, p1, mx = MX3(mx, p0[9], p0[10]); PINV(mx));
    GQ(18, p1, p1, mx = MX3(mx, p0[11], p0[12]); PINV(mx)); GQ(19, p1, p1, mx = MX3(mx, p0[13], p0[14]); PINV(mx));
    GQ(20, p1, p1, mx = __builtin_fmaxf(mx, p0[15]); PINV(mx));
    GQ(21, p1, p1, ); GQ(22, p1, p1, );
    GQ(23, p1, p1, VRD(0); VRD(1));
    float pmax = MX3(mx, p1[0], p1[1]);
#pragma unroll
    for (int r = 2; r < 16; r += 2) pmax = MX3(pmax, p1[r], p1[r + 1]);
    { auto rr = __builtin_amdgcn_permlane32_swap(__float_as_uint(pmax), __float_as_uint(pmax), false, false);
      pmax = fmaxf(__uint_as_float(rr[0]), __uint_as_float(rr[1])); }
    const bool first = (t == 0);
    if (first || !__all(pmax <= thr2)) {
      const float d = first ? pmax : fmaxf(pmax, 0.f); const float alpha = first ? 1.f : __builtin_amdgcn_exp2f(-d); m_reg += d; l_reg *= alpha;
      if (hi == 0) al_l[r32] = alpha; asm volatile("s_waitcnt lgkmcnt(0)" ::: "memory");
#pragma unroll
      for (int r = 0; r < 16; ++r) { const float a = al_l[crow(r, hi)]; o[0][r] *= a; o[1][r] *= a; o[2][r] *= a; o[3][r] *= a; p0[r] -= d; p1[r] -= d; }
#pragma unroll
      for (int r = 0; r < 16; ++r) negm[r] = -m_reg;
    }
    SBAR();
    float rs = 0.f; unsigned wa0, wa1, wb0, wb1; bf16x8 pa0, pa1, pa2, pa3;
    PREP(p0, 0, wa0); PREP(p0, 2, wa1); PREP(p0, 4, wb0); PREP(p0, 6, wb1); PKSW(pa0); SBAR();
    GP(0, pa0, PREP(p0, 8, wa0));   GP(1, pa0, PREP(p0, 10, wa1)); GP(2, pa0, PREP(p0, 12, wb0));  GP(3, pa0, PREP(p0, 14, wb1); PKSW(pa1));
    GP(4, pa1, PREP(p1, 0, wa0));   GP(5, pa1, PREP(p1, 2, wa1));  GP(6, pa1, PREP(p1, 4, wb0));   GP(7, pa1, PREP(p1, 6, wb1); PKSW(pa2));
    GP(8, pa2, PREP(p1, 8, wa0));   GP(9, pa2, PREP(p1, 10, wa1)); GP(10, pa2, PREP(p1, 12, wb0)); GP(11, pa2, PREP(p1, 14, wb1); PKSW(pa3));
    GP(12, pa3, kf[0] = KFRN(0)); GP(13, pa3, kf[1] = KFRN(1)); GP(14, pa3, kf[2] = KFRN(2)); GP(15, pa3, );
    l_reg += rs;
    if (more) asm volatile("s_waitcnt vmcnt(2)" ::: "memory"); else asm volatile("s_waitcnt vmcnt(0)" ::: "memory");
    asm volatile("s_waitcnt lgkmcnt(0)" ::: "memory"); __builtin_amdgcn_s_barrier(); asm volatile("" ::: "memory");
    cb = cb == 2 ? 0 : cb + 1;
  }
  __builtin_amdgcn_s_setprio(0);
#undef MF
#undef KFR
#undef KFRN
#undef GQ
#undef VFR
#undef VRD
#undef GP
#undef EX2
#undef PREP
#undef PKSW
#undef DMA
  { auto rr = __builtin_amdgcn_permlane32_swap(__float_as_uint(l_reg), __float_as_uint(l_reg), false, false); l_reg = __uint_as_float(rr[0]) + __uint_as_float(rr[1]); }
  if (hi == 0) li_l[r32] = l_reg; asm volatile("s_waitcnt lgkmcnt(0)" ::: "memory");
  float rli[16];
#pragma unroll
  for (int r = 0; r < 16; ++r) rli[r] = __builtin_amdgcn_rcpf(li_l[crow(r, hi)]);
  char* ost = lds + wid * OST_WAVE;
  const bool odd = lane & 1;
#pragma unroll
  for (int d0 = 0; d0 < 4; ++d0)
#pragma unroll
    for (int r = 0; r < 16; r += 2) {
      const float a = o[d0][r] * rli[r], b = o[d0][r + 1] * rli[r + 1];
      const float snd = odd ? a : b; const float rcv = __builtin_bit_cast(float, __builtin_amdgcn_mov_dpp(__builtin_bit_cast(int, snd), 0xB1, 0xF, 0xF, true));
      const float wlo = odd ? rcv : a, whi = odd ? b : rcv;
      const unsigned w = cvtpk(wlo, whi);
      const int row = crow(r, hi) + (odd ? 1 : 0), col = d0 * 32 + (r32 & ~1);
      *(unsigned*)(ost + row * OST_PITCH + col * 2) = w; }
  asm volatile("s_waitcnt lgkmcnt(0)" ::: "memory");
  bf16_t* Ow = O + (q_row0 + wid * QBLK) * ldo;
#pragma unroll
  for (int it = 0; it < 8; ++it) { const int id = it * 64 + lane, row = id >> 4, c16 = id & 15;
    const u32x4 v = *(const u32x4*)(ost + row * OST_PITCH + c16 * 16);
    *(u32x4*)(Ow + (long)row * ldo + c16 * 8) = v; }
  asm volatile("s_waitcnt lgkmcnt(0)" ::: "memory"); __builtin_amdgcn_s_barrier(); asm volatile("" ::: "memory");
}
}

#define XB_TMO      128
#define XB_XCNT(j)  (256  + 64 * (j))
#define XB_XSUB(j)  (1280 + 64 * (j))
#define XB_XGEN(j)  (2304 + 64 * (j))
#define XB_TOP      3328
#define XB_TOPGEN   3392
#define XCD_BAR_WORDS 3456
#define XB_SPIN_CAP (1u << 18)

__device__ __forceinline__ unsigned xb_ld(unsigned* p)              { return __hip_atomic_load(p, __ATOMIC_RELAXED, __HIP_MEMORY_SCOPE_AGENT); }
__device__ __forceinline__ unsigned xb_add(unsigned* p, unsigned v) { return __hip_atomic_fetch_add(p, v, __ATOMIC_RELAXED, __HIP_MEMORY_SCOPE_AGENT); }
__device__ __forceinline__ unsigned xb_xcc_id() { return (unsigned)__builtin_amdgcn_s_getreg((3 << 11) | 20) & 0xFu; }
#define XB_SPIN(cond, bar) do { unsigned _sp = 0; while (cond) { __builtin_amdgcn_s_sleep(1); \
    if ((++_sp & 255u) == 0u) { if (xb_ld(&(bar)[XB_TMO])) break; if (_sp > XB_SPIN_CAP) { atomicAdd(&(bar)[XB_TMO], 1u); break; } } } } while (0)

struct XcdBarrier {
    unsigned* bar; unsigned x;
    volatile LAS unsigned* st;
};
__device__ __forceinline__ XcdBarrier xcd_barrier_post(unsigned* bar, volatile LAS unsigned* st) {
    XcdBarrier b; b.bar = bar; b.x = xb_xcc_id(); b.st = st;
    if (threadIdx.x == 0) (void)xb_add(&bar[XB_XCNT(b.x)], 1u);
    return b;
}
__device__ __forceinline__ void xcd_barrier_complete(unsigned* bar, unsigned x, unsigned& nloc, unsigned& nx) {
    const unsigned G = gridDim.x * gridDim.y * gridDim.z;
    unsigned sum, cnt, mine, sp = 0u;
    for (;;) {
        sum = 0u; cnt = 0u; mine = 0u;
#pragma unroll
        for (unsigned j = 0; j < 16; ++j) { const unsigned c = xb_ld(&bar[XB_XCNT(j)]); sum += c; cnt += (c > 0u) ? 1u : 0u; mine = (j == x) ? c : mine; }
        if (sum == G) break;
        __builtin_amdgcn_s_sleep(1);
        if ((++sp & 255u) == 0u) { if (xb_ld(&bar[XB_TMO])) break; if (sp > XB_SPIN_CAP) { atomicAdd(&bar[XB_TMO], 1u); break; } }
    }
    nloc = mine > 0u ? mine : 1u; nx = cnt > 0u ? cnt : 1u;
}
__device__ __forceinline__ void xcd_barrier(const XcdBarrier& b) {
    asm volatile("s_waitcnt vmcnt(0)" ::: "memory");
    __syncthreads();
    if (threadIdx.x == 0) {
        unsigned* bar = b.bar;
        __builtin_amdgcn_s_waitcnt(0);
        unsigned nloc = b.st[0], nx = b.st[1];
        if (nloc == 0u) { xcd_barrier_complete(bar, b.x, nloc, nx); b.st[0] = nloc; b.st[1] = nx; }
        const unsigned old = xb_add(&bar[XB_XSUB(b.x)], 1u);
        const unsigned gen = old / nloc;
        if (old + 1u == (gen + 1u) * nloc) {
            __builtin_amdgcn_fence(__ATOMIC_RELEASE, "agent");
            asm volatile("s_waitcnt vmcnt(0)" ::: "memory");
            const unsigned og = xb_add(&bar[XB_TOP], 1u);
            const unsigned tg = og / nx;
            if (og + 1u == (tg + 1u) * nx) xb_add(&bar[XB_TOPGEN], 1u);
            else XB_SPIN(xb_ld(&bar[XB_TOPGEN]) == tg, bar);
            __builtin_amdgcn_fence(__ATOMIC_ACQUIRE, "agent");
            xb_add(&bar[XB_XGEN(b.x)], 1u);
            asm volatile("s_waitcnt vmcnt(0)" ::: "memory");
        } else {
            XB_SPIN(xb_ld(&bar[XB_XGEN(b.x)]) == gen, bar);
            __builtin_amdgcn_fence(__ATOMIC_ACQUIRE, "agent");
            asm volatile("s_waitcnt vmcnt(0)" ::: "memory");
        }
    }
    __syncthreads();
}

#ifndef WGM_G7
#define WGM_G7 4
#endif
constexpr int NWAVES = 8;
constexpr int N_PHASES = 20;
struct Args { const float* in[22]; float* out; unsigned char* ws; float inv[32]; int ph_lo, ph_hi, use_bar, pad; };

typedef float f32x4 __attribute__((ext_vector_type(4)));
typedef unsigned u32x4v __attribute__((ext_vector_type(4)));
typedef unsigned u32x2v __attribute__((ext_vector_type(2)));

template <bool HASG> __device__ __forceinline__ void transpose_item(const float* W, const float* gain, int K, int Nsrc, int k0, int srccol_lane, bf16_t* WTrow0, LAS float* scr, int lane) {
    const int c = lane & 7;
    f32x4 g0 = {1.f, 1.f, 1.f, 1.f}, g1 = {1.f, 1.f, 1.f, 1.f};
    if constexpr (HASG) { g0 = *(const f32x4*)(gain + k0 + 8 * c); g1 = *(const f32x4*)(gain + k0 + 8 * c + 4); }
#pragma unroll 8
    for (int i = 0; i < 32; ++i) { const int kk = 2 * i + (lane >> 5); scr[kk * 33 + (lane & 31)] = W[(size_t)(k0 + kk) * Nsrc + srccol_lane]; }
    asm volatile("s_waitcnt lgkmcnt(0)" ::: "memory");
#pragma unroll
    for (int j = 0; j < 4; ++j) { const int n = (lane >> 3) + 8 * j; const LAS float* s = scr + (8 * c) * 33 + n;
        u32x4v o; o.x = cvt_pk_bf16(s[0 * 33] * g0[0], s[1 * 33] * g0[1]); o.y = cvt_pk_bf16(s[2 * 33] * g0[2], s[3 * 33] * g0[3]); o.z = cvt_pk_bf16(s[4 * 33] * g1[0], s[5 * 33] * g1[1]); o.w = cvt_pk_bf16(s[6 * 33] * g1[2], s[7 * 33] * g1[3]);
        *(u32x4v*)(WTrow0 + (size_t)n * K + k0 + 8 * c) = o; }
    asm volatile("s_waitcnt lgkmcnt(0)" ::: "memory");
}
template <int MAP, bool HASG> __device__ __forceinline__ bool tr_job(int& r, const float* W, const float* W2, const float* gain, int K, int Nsrc, int ndst, bf16_t* WT, LAS float* scr, int lane) {
    const int nblk = ndst / 32, items = (K / 64) * nblk;
    if (r >= items) { r -= items; return false; }
    const int kb = r / nblk, nb = r % nblk, n0 = nb * 32, nl = n0 + (lane & 31);
    int sc = nl; const float* Ws = W;
    if (MAP == 1) { const int h = nl / CQK, hc = nl % CQK; if (hc >= 128) { const int p = hc - 128, i = p >> 1; sc = h * CQK + 128 + ((p & 1) ? i + 32 : i); } }
    if (MAP == 2) { const int pn = nl >> 8, rr = nl & 255; sc = pn * 128 + (rr & 127); if (rr >= 128) Ws = W2; }
    if (MAP == 3) { if (nl >= OFF_CKR) { const int p = nl - OFF_CKR, i = p >> 1; sc = OFF_CKR + ((p & 1) ? i + 32 : i); } }
    transpose_item<HASG>(Ws, gain, K, Nsrc, kb * 64, sc, WT + (size_t)n0 * K, scr, lane);
    return true;
}

template <bool RAW> __device__ __forceinline__ void row_to_bf16(const float* xrow, bf16_t* orow, float* ssq_row, int lane) {
    const f32x4* xr = (const f32x4*)xrow + lane; f32x4 v[16]; float s = 0.f;
#pragma unroll
    for (int j = 0; j < 16; ++j) { v[j] = xr[64 * j]; s += (v[j].x * v[j].x + v[j].y * v[j].y) + (v[j].z * v[j].z + v[j].w * v[j].w); }
    float sc = 1.f;
    if (RAW) ssq_row[lane] = s; else sc = rsqrtf(wave_sum(s) * (1.f / DM) + NORM_EPS);
    u32x2v* o8 = (u32x2v*)orow + lane;
#pragma unroll
    for (int j = 0; j < 16; ++j) { u32x2v w; w.x = cvt_pk_bf16(v[j].x * sc, v[j].y * sc); w.y = cvt_pk_bf16(v[j].z * sc, v[j].w * sc); o8[64 * j] = w; }
}
__device__ __forceinline__ void rms_row_4096_bf(const bf16_t* xrow, const float* g, float* orow, int lane) {
    const u32x4v* xr = (const u32x4v*)xrow + lane; float v[8][8]; float s = 0.f;
#pragma unroll
    for (int j = 0; j < 8; ++j) { const u32x4v w = xr[64 * j];
#pragma unroll
        for (int e = 0; e < 4; ++e) { v[j][2 * e] = __uint_as_float(w[e] << 16); v[j][2 * e + 1] = __uint_as_float(w[e] & 0xffff0000u); s += v[j][2 * e] * v[j][2 * e] + v[j][2 * e + 1] * v[j][2 * e + 1]; } }
    const float rstd = rsqrtf(wave_sum(s) * (1.f / DM) + NORM_EPS);
#pragma unroll
    for (int j = 0; j < 8; ++j) { const int c0 = (64 * j + lane) * 8; const f32x4 g0 = *(const f32x4*)(g + c0), g1 = *(const f32x4*)(g + c0 + 4);
        f32x4 o0, o1;
#pragma unroll
        for (int e = 0; e < 4; ++e) { o0[e] = v[j][e] * rstd * g0[e]; o1[e] = v[j][4 + e] * rstd * g1[e]; }
        *(f32x4*)(orow + c0) = o0; *(f32x4*)(orow + c0 + 4) = o1; }
}

template <class Sched> __device__ __forceinline__ void build_rstd_table(const Sched& S, const float* ssq, int row0, LAS float* tab) {
    int tid = threadIdx.x; asm volatile("" : "+v"(tid)); const int lane = tid & 63, wave = tid >> 6, sub = lane >> 4, piece = lane & 15;
    int lo = 1 << 30, hi = -1; { pg8::Unit u; for (int i = 0; S.next(i, u); ++i) { lo = u.pm < lo ? u.pm : lo; hi = u.pm > hi ? u.pm : hi; } }
    for (int pm = lo; pm <= hi; ++pm) {
#pragma unroll
        for (int j = 0; j < 8; ++j) { const int r = pm * pg8::BM + wave * 32 + j * 4 + sub;
            const f32x4 a = *(const f32x4*)(ssq + (size_t)r * 64 + piece * 4);
            float t = (a[0] + a[1]) + (a[2] + a[3]); t += __shfl_xor(t, 1); t += __shfl_xor(t, 2); t += __shfl_xor(t, 4); t += __shfl_xor(t, 8);
            if (piece == 0) tab[r - row0] = rsqrtf(t * (1.f / DM) + NORM_EPS); } }
    __syncthreads();
}

__global__ void __launch_bounds__(NWAVES * 64, 2) fwd_kernel(Args args) {
    extern __shared__ __attribute__((aligned(16))) unsigned char lds[];
    LAS unsigned char* ldsl = (LAS unsigned char*)lds;
    volatile LAS unsigned* MISC = (volatile LAS unsigned*)(ldsl + MISC_OFF);
    const int G = gridDim.x, bid = blockIdx.x;
#define PH_TID() int tid = threadIdx.x; asm volatile("" : "+v"(tid)); const int lane = tid & 63, wave = __builtin_amdgcn_readfirstlane(tid >> 6); const int gw = bid * NWAVES + wave, NGW = G * NWAVES; (void)lane; (void)gw; (void)NGW
    unsigned char* ws = args.ws;
    gu32* ctl = (gu32*)(ws + WS_CTL);
    for (int u = threadIdx.x; u < (LDS_BYTES - LDSCTL_OFF) / 4; u += NWAVES * 64) ((LAS unsigned*)(ldsl + LDSCTL_OFF))[u] = 0u;
    __syncthreads();
    XcdBarrier bar; bar.bar = (unsigned*)ctl + CW_BAR; bar.x = 0; bar.st = nullptr;
    if (args.use_bar) bar = xcd_barrier_post((unsigned*)ctl + CW_BAR, MISC + 8);
#ifndef BARX
#define BARX 0
#endif
#define GRID_BAR() do { if (args.use_bar) { xcd_barrier(bar); if (BARX) xcd_barrier(bar); } } while (0)
    const int lo = args.ph_lo, hi = args.ph_hi;
#ifndef PHM
#define PHM 0xFFFFFFFFu
#endif
#define IN(k) (lo <= (k) && (k) < hi)
#define PH(j) ((PHM >> (j)) & 1)
#ifndef REPM
#define REPM 0u
#endif
#define NREP(j) (1 + (int)((REPM >> (j)) & 1u))
#define REPLOOP(j) _Pragma("unroll") for (int rep = 0; rep < NREP(j); ++rep)
#define BOTH(k) (IN(k) && IN((k) + 1))

    float* cosT = (float*)(ws + WS_COS); float* sinT = (float*)(ws + WS_SIN);
    bf16_t* MEMN = (bf16_t*)(ws + WS_MEMN); bf16_t* MEMKV = (bf16_t*)(ws + WS_MEMKV);
    bf16_t* XQ = (bf16_t*)(ws + WS_XQ); bf16_t* XO = (bf16_t*)(ws + WS_XO);
    bf16_t* XB = (bf16_t*)(ws + WS_H); bf16_t* PROJ = (bf16_t*)(ws + WS_PROJ);
    bf16_t* QC = (bf16_t*)(ws + WS_QC); bf16_t* KC = (bf16_t*)(ws + WS_KC); bf16_t* VC = (bf16_t*)(ws + WS_VC);
    bf16_t* MIX = (bf16_t*)(ws + WS_MIX); bf16_t* ACT = (bf16_t*)(ws + WS_ACT);
    float* SSQ = (float*)(ws + WS_SSQ); float* SSQ2 = (float*)(ws + WS_SSQ2); float* CKRS = (float*)(ws + WS_CKR);

#ifndef NPASS
#define NPASS 1
#endif
    for (int pass = 0; pass < NPASS; ++pass) {
    if (PH(13) && IN(0)) { PH_TID(); REPLOOP(13) {
        LAS float* scr = (LAS float*)(ldsl + wave * 16384);
        constexpr int I_IN = (DM / 64) * (D_IN / 32), I_QB = (QRANK / 64) * (QCW / 32), I_KVB = (KVRANK / 64) * (KVW / 32), I_OUT = (DM / 64) * (DM / 32), I_XQ = (DM / 64) * (XD / 32),
                      I_XO = (XD / 64) * (DM / 32), I_GU = (DM / 64) * (GUW / 32), I_DOWN = (DFF / 64) * (DM / 32);
        constexpr int I_LAYER = I_IN + I_QB + I_KVB + I_OUT + 3 * I_XQ + I_XO + I_GU + I_DOWN;
        for (int it = gw; it < DEPTH * I_LAYER; it += NGW) {
            const int l = it / I_LAYER; int r = it % I_LAYER;
            unsigned char* wl = ws + WS_W + (size_t)l * W_LAYER;
            if (tr_job<3, true>(r, args.in[3] + (size_t)l * DM * D_IN, nullptr, args.in[2] + (size_t)l * DM, DM, D_IN, D_IN, (bf16_t*)(wl + WO_IN), scr, lane)) continue;
            if (tr_job<1, true>(r, args.in[7] + (size_t)l * QRANK * QCW, nullptr, args.in[6] + (size_t)l * QRANK, QRANK, QCW, QCW, (bf16_t*)(wl + WO_QB), scr, lane)) continue;
            if (tr_job<0, true>(r, args.in[9] + (size_t)l * KVRANK * KVW, nullptr, args.in[8] + (size_t)l * KVRANK, KVRANK, KVW, KVW, (bf16_t*)(wl + WO_KVB), scr, lane)) continue;
            if (tr_job<0, false>(r, args.in[10] + (size_t)l * DM * DM, nullptr, nullptr, DM, DM, DM, (bf16_t*)(wl + WO_OUT), scr, lane)) continue;
            if (tr_job<0, true>(r, args.in[13] + (size_t)l * DM * XD, nullptr, args.in[11] + (size_t)l * DM, DM, XD, XD, (bf16_t*)(wl + WO_XQ), scr, lane)) continue;
            if (tr_job<0, true>(r, args.in[14] + (size_t)l * DM * XD, nullptr, args.in[12] + (size_t)l * DM, DM, XD, XD, (bf16_t*)(wl + WO_XKV), scr, lane)) continue;
            if (tr_job<0, true>(r, args.in[15] + (size_t)l * DM * XD, nullptr, args.in[12] + (size_t)l * DM, DM, XD, XD, (bf16_t*)(wl + WO_XKV) + (size_t)XD * DM, scr, lane)) continue;
            if (tr_job<0, false>(r, args.in[16] + (size_t)l * XD * DM, nullptr, nullptr, XD, DM, DM, (bf16_t*)(wl + WO_XO), scr, lane)) continue;
            if (tr_job<2, true>(r, args.in[18] + (size_t)l * DM * DFF, args.in[19] + (size_t)l * DM * DFF, args.in[17] + (size_t)l * DM, DM, DFF, GUW, (bf16_t*)(wl + WO_GU), scr, lane)) continue;
            tr_job<0, false>(r, args.in[20] + (size_t)l * DFF * DM, nullptr, nullptr, DFF, DM, DM, (bf16_t*)(wl + WO_DOWN), scr, lane);
        }
        for (int e = bid * 512 + tid; e < SEQ * 32; e += G * 512) { const int pos = e >> 5, i = e & 31; const float ang = (float)pos * args.inv[i];
            double rev = (double)ang * 0.15915494309189533577; rev -= __builtin_rint(rev); const float rf = (float)rev;
            cosT[e] = __builtin_amdgcn_cosf(rf); sinT[e] = __builtin_amdgcn_sinf(rf); }
        for (int m = gw; m < MTOK + MEMROWS; m += NGW) {
            if (m < MTOK) row_to_bf16<true>(args.in[0] + (size_t)m * DM, XB + (size_t)m * DM, SSQ + (size_t)m * 64, lane);
            else row_to_bf16<false>(args.in[1] + (size_t)(m - MTOK) * DM, MEMN + (size_t)(m - MTOK) * DM, nullptr, lane);
        }
            }
        if (BOTH(0)) GRID_BAR();
    }

    for (int l = 0; l < DEPTH; ++l) {
        const int pb = 1 + 9 * l;
        unsigned char* wl = ws + WS_W + (size_t)l * W_LAYER;

        if (PH(1) && IN(pb + 0)) { REPLOOP(1) {
            LAS float* tab = (LAS float*)(ldsl + RSTD_OFF); const int trow0 = (bid & 7) * 2048;
            { pg8::Gemm g{XB, (const bf16_t*)(wl + WO_IN), MTOK, OFF_CKR, DM, DM, DM, OFF_CKR / 256, 0u}; pg8::StaticOrder S; S.init(MTOK, OFF_CKR, G, bid); build_rstd_table(S, SSQ, trow0, tab);
              pg8::EpiG1 E{PROJ, tab, trow0, SSQ2};
              pg8::gemm_phase<pg8::EpiG1, pg8::StaticOrder, true, true>(ldsl, g, S, E); }
            { pg8::Gemm g{XB, (const bf16_t*)(wl + WO_IN) + (size_t)OFF_CKR * DM, MTOK, 4 * 256, DM / 4, DM, DM, 1, (unsigned)(DM / 4 * 2)}; pg8::StaticOrder S; S.init(MTOK, 4 * 256, G, bid);
              pg8::EpiCkr E{CKRS};
              pg8::gemm_phase<pg8::EpiCkr, pg8::StaticOrder, true, true>(ldsl, g, S, E); }
            }
            if (BOTH(pb + 0)) GRID_BAR();
        }
        if (PH(3) && IN(pb + 1)) { REPLOOP(3) {
            { PH_TID();
              for (int m = gw; m < MTOK; m += NGW) {
                  const float rstd = rsqrtf(wave_sum(SSQ[(size_t)m * 64 + lane]) * (1.f / DM) + NORM_EPS);
                  const float* p = CKRS + (size_t)m * 64 + lane; const float v = ((p[0] + p[(size_t)MTOK * 64]) + (p[(size_t)2 * MTOK * 64] + p[(size_t)3 * MTOK * 64])) * rstd;
                  const float o = __shfl_xor(v, 1); const int pos = m & (SEQ - 1), i = lane >> 1; const float c = cosT[pos * 32 + i], sn = sinT[pos * 32 + i];
                  const float r = (lane & 1) ? (o * sn + v * c) : (v * c - o * sn);
                  const unsigned short w = (unsigned short)(cvt_pk_bf16(r, r) & 0xffffu); bf16_t* dst = KC + (size_t)m * QCW + 128 + lane;
#pragma unroll
                  for (int h = 0; h < CH; ++h) dst[h * CQK] = w; } }
            { pg8::Gemm g{PROJ + OFF_CQ, (const bf16_t*)(wl + WO_QB), MTOK, QCW, QRANK, D_INP, QRANK, (QCW) / 256, 0u}; pg8::StaticOrder S; S.init(MTOK, QCW, G, bid);
              pg8::EpiQRope E{QC, cosT, sinT, SSQ2};
              pg8::gemm_phase<pg8::EpiQRope, pg8::StaticOrder, true, true>(ldsl, g, S, E); }
            { pg8::Gemm g{PROJ + OFF_CKV, (const bf16_t*)(wl + WO_KVB), MTOK, KVW, KVRANK, D_INP, KVRANK, (KVW) / 256, 0u}; pg8::StaticOrder S; S.init(MTOK, KVW, G, bid);
              pg8::EpiKV E{KC, VC, SSQ2};
              pg8::gemm_phase<pg8::EpiKV, pg8::StaticOrder, true, true>(ldsl, g, S, E); }
            }
            if (BOTH(pb + 1)) GRID_BAR();
        }
        if (PH(4) && IN(pb + 2)) { PH_TID(); REPLOOP(4) {
#ifndef REPS
#define REPS 7
#endif
            if (PH(16) && (rep == NREP(4) - 1 || (REPS & 1))) for (int u = bid; u < BATCH * CH * 32; u += G) {
                const int x = u & 7, qb = (u >> 3) & 31, bh = (u >> 8) * 8 + x, b = bh / CH, h = bh % CH;
                att::MaskNone mk;
                att::attn_unit_c<192, att::MaskNone>(QC + h * CQK, (long)b * SEQ + qb * 256, QCW, KC + h * CQK, QCW, VC + h * 128, VCW, (long)b * SEQ, (long)b * SEQ, (long)b * SEQ + SEQ - 1, SEQ / 64,
                                                   MIX + MIX_C + h * 128, DM, 0.07216878364870322f * 1.4426950408889634f, -1e5f, 0.f, mk, (char*)lds, ldsl);
            }
            if (PH(17) && (rep == NREP(4) - 1 || (REPS & 2))) for (int u = bid; u < BATCH * AH * 32; u += G) {
                const int x = u & 7, qb = (u >> 3) & 31, bh = (u >> 8) * 8 + x, b = bh / AH, hq = bh % AH, gk = hq / 3;
                const float scale = 0.08838834764831845f, slope = exp2f(-8.f * (float)(hq + 1) / 12.f), sink = args.in[4][l * AH + hq];
                att::MaskA mk; { const int qpos = qb * 256 + (tid >> 6) * 32 + (lane & 31); mk.qoff = qb * 256 - 128 - qpos; mk.lo = -qpos > -128 ? -qpos : -128; mk.hi_ = SEQ - 1 - qpos < 128 ? SEQ - 1 - qpos : 128; } mk.sl = slope / scale;
                att::attn_unit_dma<128, att::MaskA>(PROJ + OFF_AQ + hq * 128, (long)b * SEQ + qb * 256, D_INP, PROJ + OFF_AK + gk * 128, D_INP, PROJ + OFF_AV + gk * 128, D_INP,
                                                (long)b * SEQ + qb * 256 - 128, (long)b * SEQ, (long)b * SEQ + SEQ - 1, 8,
                                                MIX + MIX_A + hq * 128, DM, scale * 1.4426950408889634f, sink / scale, 1.f, mk, (char*)lds, ldsl);
            }
            if (PH(18) && (rep == NREP(4) - 1 || (REPS & 4))) for (int u = bid; u < BATCH * BH * 32; u += G) {
                const int x = u & 7, qb = (u >> 3) & 31, bh = (u >> 8) * 8 + x, b = bh / BH, h = bh % BH;
                const float scale = 0.08838834764831845f;
                float* tab = (float*)(lds + 124928);
                if (tid < 15 * 31) tab[tid] = args.in[5][((size_t)l * BH + h) * 465 + tid] * (1.f / scale);
                const int r0 = qb * 4; int kr0 = r0 - 4; kr0 = kr0 < 0 ? 0 : (kr0 > 117 ? 117 : kr0);
                const int tq = qb * 256 + (tid >> 6) * 32 + (lane & 31);
                att::MaskB mk; mk.qr = tq >> 6; mk.qc = tq & 63; mk.kr0 = kr0; { int rs = mk.qr - 4; mk.rs = rs < 0 ? 0 : (rs > 120 ? 120 : rs); int cs = mk.qc - 8; mk.cs = cs < 0 ? 0 : (cs > 48 ? 48 : cs); } mk.tab = tab;
                att::attn_unit_dma<128, att::MaskB>(PROJ + OFF_BQ + h * 128, (long)b * SEQ + qb * 256, D_INP, PROJ + OFF_BK + h * 128, D_INP, PROJ + OFF_BV + h * 128, D_INP,
                                                (long)b * SEQ + kr0 * 64, (long)b * SEQ, (long)b * SEQ + SEQ - 1, 11,
                                                MIX + MIX_B + h * 128, DM, scale * 1.4426950408889634f, -1e5f, 0.f, mk, (char*)lds, ldsl);
            }
            }
            if (BOTH(pb + 2)) GRID_BAR();
        }
        if (PH(5) && IN(pb + 3)) { REPLOOP(5) {
            pg8::Gemm g{MIX, (const bf16_t*)(wl + WO_OUT), MTOK, DM, DM, DM, DM, (DM) / 256, 0u}; pg8::StaticOrder S; S.init(MTOK, DM, G, bid);
            pg8::EpiRes E{XB, (NREP(5) == 2 && rep == 0) ? (bf16_t*)(ws + 168 * MiB) : XB, SSQ};
            pg8::gemm_phase<pg8::EpiRes, pg8::StaticOrder, true, true>(ldsl, g, S, E);
            }
            if (BOTH(pb + 3)) GRID_BAR();
        }
        if (PH(7) && IN(pb + 4)) { REPLOOP(7) {
            const int half = G / 2;
            if (bid < half) { pg8::Gemm g{XB, (const bf16_t*)(wl + WO_XQ), MTOK, XD, DM, DM, DM, (XD) / 256, 0u}; pg8::StaticOrder S; S.init(MTOK, XD, half, bid);
                LAS float* tab = (LAS float*)(ldsl + RSTD_OFF); const int trow0 = (bid & 7) * 2048; build_rstd_table(S, SSQ, trow0, tab);
                pg8::EpiStoreScaled E{XQ, XD, tab, trow0};
                pg8::gemm_phase<pg8::EpiStoreScaled, pg8::StaticOrder, true, true>(ldsl, g, S, E); }
            else { pg8::Gemm g{MEMN, (const bf16_t*)(wl + WO_XKV), MEMROWS, 2 * XD, DM, DM, DM, (2 * XD) / 256, 0u}; pg8::StaticOrder S; S.init(MEMROWS, 2 * XD, G - half, bid - half);
                pg8::EpiStore E{MEMKV, 2 * XD};
                pg8::gemm_phase<pg8::EpiStore, pg8::StaticOrder, true, true>(ldsl, g, S, E); }
            }
            if (BOTH(pb + 4)) GRID_BAR();
        }
        if (PH(8) && IN(pb + 5)) { REPLOOP(8) {
            for (int u = bid; u < BATCH * 4 * 32; u += G) {
                const int x = u & 7, qb = (u >> 3) & 31, b = x >> 2, h = x & 3;
                att::MaskNone mk;
                att::attn_unit_dma<128, att::MaskNone>(XQ + h * 128, (long)b * SEQ + qb * 256, XD, MEMKV + h * 128, 2 * XD, MEMKV + XD + h * 128, 2 * XD, (long)b * NMEM, (long)b * NMEM, (long)b * NMEM + NMEM - 1, NMEM / 64,
                                                   XO + h * 128, XD, 0.08838834764831845f * 1.4426950408889634f, -1e5f, 0.f, mk, (char*)lds, ldsl);
            }
            }
            if (BOTH(pb + 5)) GRID_BAR();
        }
        if (PH(9) && IN(pb + 6)) { REPLOOP(9) {
            pg8::Gemm g{XO, (const bf16_t*)(wl + WO_XO), MTOK, DM, XD, XD, XD, (DM) / 256, 0u}; pg8::StaticOrder S; S.init(MTOK, DM, G, bid);
            pg8::EpiRes E{XB, (NREP(9) == 2 && rep == 0) ? (bf16_t*)(ws + 168 * MiB) : XB, SSQ};
            pg8::gemm_phase<pg8::EpiRes, pg8::StaticOrder, true, true>(ldsl, g, S, E);
            }
            if (BOTH(pb + 6)) GRID_BAR();
        }
        if (PH(11) && IN(pb + 7)) { REPLOOP(11) {
            pg8::Gemm g{XB, (const bf16_t*)(wl + WO_GU), MTOK, GUW, DM, DM, DM, (GUW) / 256, 0u}; pg8::StaticOrder S; S.init(MTOK, GUW, G, bid);
            LAS float* tab = (LAS float*)(ldsl + RSTD_OFF); const int trow0 = (bid & 7) * 2048; build_rstd_table(S, SSQ, trow0, tab);
            pg8::EpiSwiglu E{ACT, DFF, tab, trow0};
            pg8::gemm_phase<pg8::EpiSwiglu, pg8::StaticOrder, true, true>(ldsl, g, S, E);
            }
            if (BOTH(pb + 7)) GRID_BAR();
        }
        if (PH(12) && IN(pb + 8)) { REPLOOP(12) {
            pg8::Gemm g{ACT, (const bf16_t*)(wl + WO_DOWN), MTOK, DM, DFF, DFF, DFF, (DM) / 256, 0u}; pg8::StaticOrder S; S.init(MTOK, DM, G, bid, WGM_G7);
            pg8::EpiRes E{XB, (NREP(12) == 2 && rep == 0) ? (bf16_t*)(ws + 512 * MiB) : XB, SSQ};
            pg8::gemm_phase<pg8::EpiRes, pg8::StaticOrder, true, true>(ldsl, g, S, E);
            }
            if (BOTH(pb + 8)) GRID_BAR();
        }
    }
    if (PH(14) && IN(19)) { PH_TID();
        for (int m = gw; m < MTOK; m += NGW) rms_row_4096_bf(XB + (size_t)m * DM, args.in[21], args.out + (size_t)m * DM, lane);
    }
    if (NPASS > 1 && pass + 1 < NPASS) GRID_BAR();
    }
#undef IN
#undef BOTH
#undef GRID_BAR
}

#if DBG
constexpr int DBG_NS = 128;
struct DbgBuf { unsigned fail[64]; float snap[64][DBG_NS]; float tol[64][DBG_NS]; };
__device__ __forceinline__ unsigned dhash(unsigned x) { x ^= x >> 16; x *= 0x7feb352dU; x ^= x >> 15; x *= 0x846ca68bU; x ^= x >> 16; return x; }
__device__ __forceinline__ float rbf(float f) { unsigned u = __float_as_uint(f); u += 0x7fffu + ((u >> 16) & 1u); return __uint_as_float(u & 0xffff0000u); }
__device__ __forceinline__ float wave_max(float v) { for (int o = 1; o < 64; o <<= 1) v = fmaxf(v, __shfl_xor(v, o)); return v; }
__device__ void wdot(const bf16_t* a, const float* W, const float* gain, int N, int n, int K, int lane, float& dot, float& sabs) {
    float d = 0.f, sa = 0.f; for (int k = lane; k < K; k += 64) { const float x = bf2f(a[k]) * rbf(W[(size_t)k * N + n] * (gain ? gain[k] : 1.f)); d += x; sa += fabsf(x); } dot = wave_sum(d); sabs = wave_sum(sa); }
__device__ float row_rstd_f32(const float* x, int n, int lane) { float ss = 0.f; for (int k = lane; k < n; k += 64) ss += x[k] * x[k]; return rsqrtf(wave_sum(ss) / n + NORM_EPS); }
__device__ float row_rstd_bf(const bf16_t* x, int n, int lane) { float ss = 0.f; for (int k = lane; k < n; k += 64) ss += bf2f(x[k]) * bf2f(x[k]); return rsqrtf(wave_sum(ss) / n + NORM_EPS); }
__device__ void dsincos(float ang, float& c, float& s) { double x = (double)ang; const double tp = 6.283185307179586476925; x -= tp * __builtin_rint(x / tp);
    double sn = 0.0, cs = 0.0, term = 1.0; for (int k = 0; k < 30; ++k) { if (k & 1) { sn += ((k >> 1) & 1) ? -term : term; } else { cs += ((k >> 1) & 1) ? -term : term; } term *= x / (double)(k + 1); } c = (float)cs; s = (float)sn; }
__device__ void dchk(DbgBuf* D, int cid, float got, float exp, float tol, int lane) { if (lane == 0 && !(fabsf(got - exp) <= tol)) D->fail[cid] = 1u; }

__global__ void __launch_bounds__(64) dbg_check(Args a, int l, int kind, int cid, int pre) {
    const int lane = threadIdx.x, s = blockIdx.x; unsigned char* ws = a.ws; DbgBuf* D = (DbgBuf*)(ws + WS_DBG);
    const unsigned h1 = dhash(cid * 1000003u + s * 7919u + 12345u), h2 = dhash(h1 + 0x9e3779b9u), h3 = dhash(h2 + 0x85ebca6bu);
    bf16_t* MEMN = (bf16_t*)(ws + WS_MEMN); bf16_t* MEMKV = (bf16_t*)(ws + WS_MEMKV); bf16_t* XQ = (bf16_t*)(ws + WS_XQ); bf16_t* XO = (bf16_t*)(ws + WS_XO);
    bf16_t* XB = (bf16_t*)(ws + WS_H); bf16_t* PROJ = (bf16_t*)(ws + WS_PROJ);
    bf16_t* QC = (bf16_t*)(ws + WS_QC); bf16_t* KC = (bf16_t*)(ws + WS_KC); bf16_t* VC = (bf16_t*)(ws + WS_VC); bf16_t* MIX = (bf16_t*)(ws + WS_MIX); bf16_t* ACT = (bf16_t*)(ws + WS_ACT);
    float* SSQ = (float*)(ws + WS_SSQ); float* SSQ2 = (float*)(ws + WS_SSQ2);
    const int m = h1 % MTOK;
    if (kind == 41) {
        const int c = h2 % DM;
        if (s < 64) { const float e = a.in[0][(size_t)m * DM + c]; dchk(D, cid, bf2f(XB[(size_t)m * DM + c]), e, 0.005f * fabsf(e) + 1e-6f, lane); }
        else if (s < 96) { float ss = 0.f; for (int k = lane; k < DM; k += 64) { const float v = a.in[0][(size_t)m * DM + k]; ss += v * v; } ss = wave_sum(ss); const float g = wave_sum(SSQ[(size_t)m * 64 + lane]); dchk(D, cid, g, ss, 1e-4f * ss, lane); }
        else { const int r = h1 % MEMROWS; const float e = a.in[1][(size_t)r * DM + c] * row_rstd_f32(a.in[1] + (size_t)r * DM, DM, lane); dchk(D, cid, bf2f(MEMN[(size_t)r * DM + c]), e, 0.01f * fabsf(e) + 1e-3f, lane); }
    } else if (kind == 40) {
        const int c = h2 % DM;
        if (pre) return; const float exp = bf2f(XB[(size_t)m * DM + c]) * row_rstd_bf(XB + (size_t)m * DM, DM, lane) * a.in[21][c];
        dchk(D, cid, a.out[(size_t)m * DM + c], exp, 1e-4f * fabsf(exp) + 1e-5f, lane);
    } else if (kind == 2) {
        const float rstd = row_rstd_bf(XB + (size_t)m * DM, DM, lane); const float* W = a.in[3] + (size_t)l * DM * D_IN; const float* g = a.in[2] + (size_t)l * DM; const bf16_t* ar = XB + (size_t)m * DM;
        const int sub = s & 7;
        if (false) {}
        else if (sub == 5) { float ss = 0.f; for (int k = lane; k < QRANK; k += 64) { const float v = bf2f(PROJ[(size_t)m * D_INP + OFF_CQ + k]); ss += v * v; } ss = wave_sum(ss); const float gs = wave_sum(lane < 16 ? SSQ2[(size_t)m * 24 + lane] : 0.f); dchk(D, cid, gs, ss, 0.01f * ss, lane); }
        else if (sub == 1) { float ss = 0.f; for (int k = lane; k < KVRANK; k += 64) { const float v = bf2f(PROJ[(size_t)m * D_INP + OFF_CKV + k]); ss += v * v; } ss = wave_sum(ss); const float gs = wave_sum(lane < 8 ? SSQ2[(size_t)m * 24 + 16 + lane] : 0.f); dchk(D, cid, gs, ss, 0.01f * ss, lane); }
        else { const int n = h2 % OFF_CKR; float d, sa; wdot(ar, W, g, D_IN, n, DM, lane, d, sa); d *= rstd; dchk(D, cid, bf2f(PROJ[(size_t)m * D_INP + n]), d, 0.02f * fabsf(d) + 2e-4f * sa * rstd, lane); }
    } else if (kind == 4) {
        const int hh = h2 % CH; const float* W = a.in[7] + (size_t)l * QRANK * QCW; const float* g = a.in[6] + (size_t)l * QRANK; const bf16_t* ar = PROJ + (size_t)m * D_INP + OFF_CQ; const float rstd = row_rstd_bf(ar, QRANK, lane);
        if (s & 1) { const int d0 = h3 % 128; float d, sa; wdot(ar, W, g, QCW, hh * CQK + d0, QRANK, lane, d, sa); d *= rstd * QSC_C; dchk(D, cid, bf2f(QC[(size_t)m * QCW + hh * CQK + d0]), d, 0.02f * fabsf(d) + 2e-4f * sa * rstd * QSC_C, lane); }
        else { const int i = h3 % 32; float x1, s1, x2, s2; wdot(ar, W, g, QCW, hh * CQK + 128 + i, QRANK, lane, x1, s1); wdot(ar, W, g, QCW, hh * CQK + 128 + i + 32, QRANK, lane, x2, s2); x1 *= rstd * QSC_C; x2 *= rstd * QSC_C;
            float c, sn; dsincos((float)(m % SEQ) * a.inv[i], c, sn); const float e1 = x1 * c - x2 * sn, e2 = x1 * sn + x2 * c; const bf16_t* q = QC + (size_t)m * QCW + hh * CQK + 128 + 2 * i;
            const float tol = 2e-4f * (s1 + s2) * rstd * QSC_C; dchk(D, cid, bf2f(q[0]), e1, 0.02f * fabsf(e1) + tol, lane); dchk(D, cid, bf2f(q[1]), e2, 0.02f * fabsf(e2) + tol, lane); }
    } else if (kind == 5 && (s & 3) == 2) {
        const float rstd = row_rstd_bf(XB + (size_t)m * DM, DM, lane); const float* W = a.in[3] + (size_t)l * DM * D_IN; const float* g = a.in[2] + (size_t)l * DM; const bf16_t* ar = XB + (size_t)m * DM;
        const int i = h2 % 32, hh = h3 % CH; float x1, s1, x2, s2; wdot(ar, W, g, D_IN, OFF_CKR + i, DM, lane, x1, s1); wdot(ar, W, g, D_IN, OFF_CKR + i + 32, DM, lane, x2, s2); x1 *= rstd; x2 *= rstd;
        float c, sn; dsincos((float)(m % SEQ) * a.inv[i], c, sn); const float e1 = x1 * c - x2 * sn, e2 = x1 * sn + x2 * c; const bf16_t* kc = KC + (size_t)m * QCW + hh * CQK + 128 + 2 * i; const float tol = 2e-4f * (s1 + s2) * rstd;
        dchk(D, cid, bf2f(kc[0]), e1, 0.02f * fabsf(e1) + tol, lane); dchk(D, cid, bf2f(kc[1]), e2, 0.02f * fabsf(e2) + tol, lane);
    } else if (kind == 5) {
        const int hh = h2 % CH, part = s & 1, d0 = h3 % 128; const bf16_t* ar = PROJ + (size_t)m * D_INP + OFF_CKV; const float rstd = row_rstd_bf(ar, KVRANK, lane); float d, sa;
        wdot(ar, a.in[9] + (size_t)l * KVRANK * KVW, a.in[8] + (size_t)l * KVRANK, KVW, hh * 256 + part * 128 + d0, KVRANK, lane, d, sa); d *= rstd;
        const float got = part ? bf2f(VC[(size_t)m * VCW + hh * 128 + d0]) : bf2f(KC[(size_t)m * QCW + hh * CQK + d0]); dchk(D, cid, got, d, 0.02f * fabsf(d) + 2e-4f * sa * rstd, lane);
    } else if (kind == 6 || kind == 7 || kind == 8 || kind == 12) {
        const int b = m / SEQ, pos = m % SEQ, d0 = h3 % 128; int nk, hh; float scale; const bf16_t *qp, *kp0, *vp0; int ldk, ldv, dqk; float got; float sinkv = 0.f; bool has_sink = false;
        int rs = 0, cs = 0, qr = pos >> 6, qc = pos & 63; float slope = 0.f; const float* rpb = nullptr;
        if (kind == 6) { hh = h2 % CH; nk = SEQ; scale = 0.6931471805599453f;     dqk = 192; qp = QC + (size_t)m * QCW + hh * CQK; kp0 = KC + (size_t)b * SEQ * QCW + hh * CQK; ldk = QCW; vp0 = VC + (size_t)b * SEQ * VCW + hh * 128 + d0; ldv = VCW; got = bf2f(MIX[(size_t)m * DM + MIX_C + hh * 128 + d0]); }
        else if (kind == 7) { hh = h2 % AH; nk = 257; scale = 0.08838834764831845f; dqk = 128; qp = PROJ + (size_t)m * D_INP + OFF_AQ + hh * 128; kp0 = PROJ + (size_t)b * SEQ * D_INP + OFF_AK + (hh / 3) * 128; ldk = D_INP; vp0 = PROJ + (size_t)b * SEQ * D_INP + OFF_AV + (hh / 3) * 128 + d0; ldv = D_INP;
            got = bf2f(MIX[(size_t)m * DM + MIX_A + hh * 128 + d0]); slope = exp2f(-8.f * (float)(hh + 1) / 12.f); sinkv = a.in[4][l * AH + hh]; has_sink = true; }
        else if (kind == 8) { hh = h2 % BH; nk = 128; scale = 0.08838834764831845f; dqk = 128; qp = PROJ + (size_t)m * D_INP + OFF_BQ + hh * 128; kp0 = PROJ + (size_t)b * SEQ * D_INP + OFF_BK + hh * 128; ldk = D_INP; vp0 = PROJ + (size_t)b * SEQ * D_INP + OFF_BV + hh * 128 + d0; ldv = D_INP;
            got = bf2f(MIX[(size_t)m * DM + MIX_B + hh * 128 + d0]); rs = qr - 4; rs = rs < 0 ? 0 : (rs > 120 ? 120 : rs); cs = qc - 8; cs = cs < 0 ? 0 : (cs > 48 ? 48 : cs); rpb = a.in[5] + ((size_t)l * BH + hh) * 465; }
        else { hh = h2 % 4; nk = NMEM; scale = 0.08838834764831845f; dqk = 128; qp = XQ + (size_t)m * XD + hh * 128; kp0 = MEMKV + (size_t)b * NMEM * 2 * XD + hh * 128; ldk = 2 * XD; vp0 = MEMKV + (size_t)b * NMEM * 2 * XD + XD + hh * 128 + d0; ldv = 2 * XD; got = bf2f(XO[(size_t)m * XD + hh * 128 + d0]); }
        float mx = has_sink ? sinkv : -1e30f, den = 0.f, acc = 0.f, vmax = 0.f;
        for (int pass = 0; pass < 2; ++pass) {
            if (pass == 1) mx = wave_max(mx);
            for (int j = lane; j < nk; j += 64) { int key; float bias = 0.f;
                if (kind == 7) { key = pos - 128 + j; if (key < 0 || key >= SEQ) continue; const int ar = key > pos ? key - pos : pos - key; bias = -slope * (float)ar; }
                else if (kind == 8) { const int kr = rs + (j >> 4), kcn = cs + (j & 15); key = kr * 64 + kcn; bias = rpb[(kr - qr + 7) * 31 + (kcn - qc + 15)]; }
                else key = j;
                float dt = 0.f; const bf16_t* kp = kp0 + (size_t)key * ldk; for (int e = 0; e < dqk; ++e) dt += bf2f(qp[e]) * bf2f(kp[e]);
                const float sc = dt * scale + bias;
                if (pass == 0) mx = fmaxf(mx, sc); else { const float p = __expf(sc - mx); const float v = bf2f(vp0[(size_t)key * ldv]); den += p; acc += p * v; vmax = fmaxf(vmax, fabsf(v)); } } }
        den = wave_sum(den); acc = wave_sum(acc); vmax = wave_max(vmax); if (has_sink) den += __expf(sinkv - mx);
        const float exp = acc / den; dchk(D, cid, got, exp, 0.03f * fabsf(exp) + 0.01f * vmax, lane);
    } else if (kind == 9 || kind == 13 || kind == 16) {
        const int n = h2 % DM;
        if (!pre) { const float e = D->snap[cid][s], t = D->tol[cid][s]; dchk(D, cid, bf2f(XB[(size_t)m * DM + n]), e, t + 0.005f * fabsf(e), lane);
            if ((s & 3) == 0) { float ss = 0.f; for (int k = lane; k < DM; k += 64) { const float v = bf2f(XB[(size_t)m * DM + k]); ss += v * v; } ss = wave_sum(ss); const float g = wave_sum(SSQ[(size_t)m * 64 + lane]); dchk(D, cid, g, ss, 5e-3f * ss, lane); }
            return; }
        float d, sa; const float xo = bf2f(XB[(size_t)m * DM + n]);
        if (kind == 9) wdot(MIX + (size_t)m * DM, a.in[10] + (size_t)l * DM * DM, nullptr, DM, n, DM, lane, d, sa);
        else if (kind == 13) wdot(XO + (size_t)m * XD, a.in[16] + (size_t)l * XD * DM, nullptr, DM, n, XD, lane, d, sa);
        else wdot(ACT + (size_t)m * DFF, a.in[20] + (size_t)l * DFF * DM, nullptr, DM, n, DFF, lane, d, sa);
        if (lane == 0) { D->snap[cid][s] = xo + d; D->tol[cid][s] = 0.02f * fabsf(d) + 2e-4f * sa + 1e-5f * fabsf(xo); }
    } else if (kind == 11) {
        float d, sa;
        if (s < 96) { const int n = h2 % XD; const float rstd = row_rstd_bf(XB + (size_t)m * DM, DM, lane); wdot(XB + (size_t)m * DM, a.in[13] + (size_t)l * DM * XD, a.in[11] + (size_t)l * DM, XD, n, DM, lane, d, sa); d *= rstd;
            dchk(D, cid, bf2f(XQ[(size_t)m * XD + n]), d, 0.02f * fabsf(d) + 2e-4f * sa * rstd, lane); }
        else { const int r = h1 % MEMROWS, n = h2 % (2 * XD); wdot(MEMN + (size_t)r * DM, (n < XD ? a.in[14] : a.in[15]) + (size_t)l * DM * XD, a.in[12] + (size_t)l * DM, XD, n % XD, DM, lane, d, sa); dchk(D, cid, bf2f(MEMKV[(size_t)r * 2 * XD + n]), d, 0.02f * fabsf(d) + 2e-4f * sa, lane); }
    } else if (kind == 15) {
        const int j = h2 % DFF; float g, sg, u, su; const float rstd = row_rstd_bf(XB + (size_t)m * DM, DM, lane); const float* gn = a.in[17] + (size_t)l * DM;
        wdot(XB + (size_t)m * DM, a.in[18] + (size_t)l * DM * DFF, gn, DFF, j, DM, lane, g, sg); wdot(XB + (size_t)m * DM, a.in[19] + (size_t)l * DM * DFF, gn, DFF, j, DM, lane, u, su); g *= rstd; u *= rstd;
        const float exp = g / (1.f + __expf(-g)) * u; dchk(D, cid, bf2f(ACT[(size_t)m * DFF + j]), exp, 0.03f * fabsf(exp) + 4e-3f, lane);
    }
}
__global__ void dbg_final(Args a) {
    DbgBuf* D = (DbgBuf*)(a.ws + WS_DBG); int id1 = 0, id2 = 0;
    for (int i = 1; i < 64; ++i) if (D->fail[i]) { if (!id1) id1 = i; else if (!id2) id2 = i; }
    if (!id1) return; if (id2 > 33) id2 = 33;
    const float c = sqrtf((10.f + (float)id1) / 10.f) * __powf(10.f, 0.5f * (float)(4 + id2));
    for (size_t i = (size_t)blockIdx.x * blockDim.x + threadIdx.x; i < (size_t)MTOK * DM; i += (size_t)gridDim.x * blockDim.x) a.out[i] = c;
}
static void dbg_run(Args a, int grid, hipStream_t stream) {
    (void)hipMemsetAsync(a.ws + WS_DBG, 0, sizeof(DbgBuf), stream);
    auto chk = [&](int l, int kind, int pre) { hipLaunchKernelGGL(dbg_check, dim3(DBG_NS), dim3(64), 0, stream, a, l, kind, kind >= 40 ? kind : 20 * l + kind, pre); };
    for (int p = 0; p < N_PHASES; ++p) {
        const int l = (p - 1) / 9, j = (p - 1) % 9;
        if (p >= 1 && p <= 18) { if (j == 3) chk(l, 9, 1); if (j == 6) chk(l, 13, 1); if (j == 8) chk(l, 16, 1); }
        if (p == 19) chk(0, 40, 1);
        a.ph_lo = p; a.ph_hi = p + 1; a.use_bar = 0; a.pad = 0;
        hipLaunchKernelGGL(fwd_kernel, dim3(grid), dim3(NWAVES * 64), LDS_BYTES, stream, a);
        if (p == 0) chk(0, 41, 0);
        if (p >= 1 && p <= 18) {
            switch (j) { case 0: chk(l, 2, 0); break; case 1: chk(l, 4, 0); chk(l, 5, 0); break; case 2: chk(l, 6, 0); chk(l, 7, 0); chk(l, 8, 0); break;
                case 3: chk(l, 9, 0); break; case 4: chk(l, 11, 0); break; case 5: chk(l, 12, 0); break; case 6: chk(l, 13, 0); break; case 7: chk(l, 15, 0); break; case 8: chk(l, 16, 0); break; }
        }
        if (p == 19) chk(0, 40, 0);
    }
    hipLaunchKernelGGL(dbg_final, dim3(2048), dim3(256), 0, stream, a);
}
#endif

extern "C" void kernel_launch(void* const* d_in, const int* in_sizes, int n_in, void* d_out, int out_size, void* d_ws, size_t ws_size, hipStream_t stream) {
    static int grid = 0;
    if (grid == 0) {
        if (n_in != 22 || out_size != MTOK * DM || ws_size < WS_END) { fprintf(stderr, "kernel_launch: unexpected shapes: n_in %d out %d ws %zu (need %zu)\n", n_in, out_size, ws_size, (size_t)WS_END); grid = -1; return; }
        int dev = 0, cus = 0, per_cu = 0;
        if (hipGetDevice(&dev) != hipSuccess || hipDeviceGetAttribute(&cus, hipDeviceAttributeMultiprocessorCount, dev) != hipSuccess) { grid = -1; return; }
        if (hipFuncSetAttribute((const void*)fwd_kernel, hipFuncAttributeMaxDynamicSharedMemorySize, LDS_BYTES) != hipSuccess) { fprintf(stderr, "kernel_launch: hipFuncSetAttribute failed\n"); grid = -1; return; }
        if (hipOccupancyMaxActiveBlocksPerMultiprocessor(&per_cu, (const void*)fwd_kernel, NWAVES * 64, LDS_BYTES) != hipSuccess || per_cu < 1) { fprintf(stderr, "kernel_launch: occupancy query says %d blocks per CU\n", per_cu); (void)hipGetLastError(); grid = -1; return; }
        grid = cus;
    }
    if (grid < 0) return;
    (void)hipMemsetAsync((char*)d_ws + WS_CTL, 0, CTL_ZERO_BYTES, stream);
    Args a{};
    for (int i = 0; i < 22; ++i) a.in[i] = (const float*)d_in[i];
    a.out = (float*)d_out; a.ws = (unsigned char*)d_ws;
    for (int i = 0; i < 32; ++i) { const float p = powf(10000.0f, (float)(2 * i) / 64.0f); a.inv[i] = 1.0f / p; }
#if DBG
    dbg_run(a, grid, stream);
#else
    a.ph_lo = 0; a.ph_hi = N_PHASES; a.use_bar = 1; a.pad = 0;
    hipLaunchKernelGGL(fwd_kernel, dim3(grid), dim3(NWAVES * 64), LDS_BYTES, stream, a);
#endif
}
```
